# Optimizing an MI355X kernel written in HIP

```python
import jax, jax.numpy as jnp
from jax import lax
import numpy as np

D_MODEL = 1024
BATCH = 2
SEQ = 8192
DEPTH = 1

NSA_HEADS = 8
NSA_KV_GROUPS = 2
NSA_HEAD_DIM = 64
NSA_HEADS_PER_GROUP = NSA_HEADS // NSA_KV_GROUPS
NSA_WIDTH = NSA_HEADS * NSA_HEAD_DIM
NSA_KV_WIDTH = NSA_KV_GROUPS * NSA_HEAD_DIM
CMP_LEN = 32
CMP_STRIDE = 16
SLC_LEN = 64
SLC_TOPN = 16
WINDOW = 512
Q_BLOCK = 128
ROPE_THETA = 500000.0
ROPE_DIM = NSA_HEAD_DIM // 4
HG_HEADS = 4
HG_KEY_DIM = 128
HG_VAL_DIM = 128
HG_WIDTH = HG_HEADS * HG_VAL_DIM
HG_CHUNK = 64
N_GROUPS = 4
EXPERTS_PER_GROUP = 8
N_EXPERTS = N_GROUPS * EXPERTS_PER_GROUP
TOP_K_IN_GROUP = 2
D_FF_EXPERT = 512
RMS_EPS = 1e-6
NEG_INF = -1e30
FORCE_SCORE = 1e4

IN_SPLITS = [NSA_WIDTH, 6 * NSA_KV_WIDTH, 3 * NSA_HEADS,
             HG_HEADS * HG_KEY_DIM, HG_HEADS * HG_KEY_DIM, HG_WIDTH, HG_WIDTH, 2 * D_MODEL]
IN_COLS = sum(IN_SPLITS)

kernel_name = 'hybrid_nsa_hgrn2_hmoe'


def rmsnorm(x, g):
    x32 = x.astype(jnp.float32)
    y = x32 * lax.rsqrt(jnp.mean(x32 * x32, axis=-1, keepdims=True) + RMS_EPS)
    return (y * g.astype(jnp.float32)).astype(x.dtype)


def partial_rope(t, pos):
    half = ROPE_DIM // 2
    inv_freq = ROPE_THETA ** (-jnp.arange(half, dtype=jnp.float32) / half)
    ang = pos.astype(jnp.float32)[:, None] * inv_freq[None, :]
    cos = jnp.cos(ang)[:, None, :]
    sin = jnp.sin(ang)[:, None, :]
    t1 = t[..., :half]
    t2 = t[..., half:ROPE_DIM]
    return jnp.concatenate([t1 * cos - t2 * sin, t2 * cos + t1 * sin, t[..., ROPE_DIM:]], axis=-1)


def masked_softmax(s, mask):
    s = jnp.where(mask, s, NEG_INF)
    return jax.nn.softmax(s, axis=-1) * mask


def nsa_mixer(q, k_cmp_in, v_cmp_in, k_slc, v_slc, k_win, v_win, gate_logits, w_cmp_k, w_cmp_v, cmp_pos):
    f32 = jnp.float32
    b, s = q.shape[0], q.shape[1]
    G, R, dk = NSA_KV_GROUPS, NSA_HEADS_PER_GROUP, NSA_HEAD_DIM
    pos = jnp.arange(s)
    scale = dk ** -0.5
    q = partial_rope(q.astype(f32), pos).reshape(b, s, G, R, dk)
    k_slc = partial_rope(k_slc.astype(f32), pos)
    k_win = partial_rope(k_win.astype(f32), pos)
    v_slc = v_slc.astype(f32)
    v_win = v_win.astype(f32)
    gates = jax.nn.sigmoid(gate_logits.astype(f32)).reshape(b, s, G, R, 3)

    n_cmp = (s - CMP_LEN) // CMP_STRIDE + 1
    cmp_start = jnp.arange(n_cmp) * CMP_STRIDE
    cmp_end = cmp_start + CMP_LEN - 1
    cmp_idx = cmp_start[:, None] + jnp.arange(CMP_LEN)[None, :]

    def compress(t, w):
        blk = t.astype(f32)[:, cmp_idx] + cmp_pos.astype(f32)[None, None, :, None, :]
        blk = blk.transpose(0, 1, 3, 2, 4).reshape(b, n_cmp, G, CMP_LEN * dk)
        return jnp.einsum('bngc,cd->bngd', blk, w.astype(f32))

    k_cmp = partial_rope(compress(k_cmp_in, w_cmp_k), cmp_start)
    v_cmp = compress(v_cmp_in, w_cmp_v)

    n_sel = s // SLC_LEN
    top_n = min(SLC_TOPN, n_sel)
    sel_start = jnp.arange(n_sel) * SLC_LEN
    blk_ids = jnp.arange(n_sel)
    overlap = ((cmp_start[:, None] < sel_start[None, :] + SLC_LEN) &
               (cmp_end[:, None] >= sel_start[None, :])).astype(f32)
    k_sel_blocks = k_slc.reshape(b, n_sel, SLC_LEN, G, dk).transpose(0, 3, 1, 2, 4)
    v_sel_blocks = v_slc.reshape(b, n_sel, SLC_LEN, G, dk).transpose(0, 3, 1, 2, 4)
    gather_blocks = jax.vmap(jax.vmap(lambda blocks, ids: blocks[ids]))
    slc_offsets = jnp.arange(SLC_LEN)

    k_win_pad = jnp.pad(k_win, ((0, 0), (WINDOW, 0), (0, 0), (0, 0)))
    v_win_pad = jnp.pad(v_win, ((0, 0), (WINDOW, 0), (0, 0), (0, 0)))
    win_offsets = jnp.arange(WINDOW + Q_BLOCK) - WINDOW
    q_offsets = jnp.arange(Q_BLOCK)

    def query_block(c):
        t0 = c * Q_BLOCK
        tpos = t0 + q_offsets
        qb = lax.dynamic_slice_in_dim(q, t0, Q_BLOCK, axis=1)
        gb = lax.dynamic_slice_in_dim(gates, t0, Q_BLOCK, axis=1)
        cmask = cmp_end[None, :] <= tpos[:, None]
        p_cmp = masked_softmax(jnp.einsum('bqgrd,bngd->bgrqn', qb, k_cmp) * scale, cmask)
        o_cmp = jnp.einsum('bgrqn,bngd->bqgrd', p_cmp, v_cmp)
        imp = jnp.einsum('bgrqn,nj->bgqj', p_cmp, overlap)
        force = (blk_ids[None, :] == (tpos // SLC_LEN)[:, None]) | (blk_ids[None, :] == 0)
        valid = sel_start[None, :] <= tpos[:, None]
        score = jnp.where(force, FORCE_SCORE, jnp.where(valid, imp, -1.0))
        _, sel_idx = lax.top_k(score, top_n)
        k_sel = gather_blocks(k_sel_blocks, sel_idx).reshape(b, G, Q_BLOCK, top_n * SLC_LEN, dk)
        v_sel = gather_blocks(v_sel_blocks, sel_idx).reshape(b, G, Q_BLOCK, top_n * SLC_LEN, dk)
        sel_pos = (sel_idx[..., None] * SLC_LEN + slc_offsets).reshape(b, G, Q_BLOCK, top_n * SLC_LEN)
        smask = (sel_pos <= tpos[None, None, :, None])[:, :, None]
        p_slc = masked_softmax(jnp.einsum('bqgrd,bgqmd->bgrqm', qb, k_sel) * scale, smask)
        o_slc = jnp.einsum('bgrqm,bgqmd->bqgrd', p_slc, v_sel)
        kw = lax.dynamic_slice_in_dim(k_win_pad, t0, WINDOW + Q_BLOCK, axis=1)
        vw = lax.dynamic_slice_in_dim(v_win_pad, t0, WINDOW + Q_BLOCK, axis=1)
        kpos = t0 + win_offsets
        rel = tpos[:, None] - kpos[None, :]
        wmask = (rel >= 0) & (rel < WINDOW) & (kpos[None, :] >= 0)
        p_win = masked_softmax(jnp.einsum('bqgrd,bmgd->bgrqm', qb, kw) * scale, wmask)
        o_win = jnp.einsum('bgrqm,bmgd->bqgrd', p_win, vw)
        return gb[..., 0:1] * o_cmp + gb[..., 1:2] * o_slc + gb[..., 2:3] * o_win

    out = lax.map(query_block, jnp.arange(s // Q_BLOCK))
    return out.transpose(1, 0, 2, 3, 4, 5).reshape(b, s, NSA_WIDTH)


def hgrn2_mixer(q, f_logit, i_in, lb):
    f32 = jnp.float32
    b, s = q.shape[0], q.shape[1]
    q = q.astype(f32).reshape(b, s, HG_HEADS, HG_KEY_DIM)
    f = lb + (1.0 - lb) * jax.nn.sigmoid(f_logit.astype(f32).reshape(b, s, HG_HEADS, HG_KEY_DIM))
    log_f = jnp.log(f)
    k = 1.0 - f
    v = i_in.astype(f32).reshape(b, s, HG_HEADS, HG_VAL_DIM)
    n_ch = s // HG_CHUNK

    def to_chunks(t):
        return t.reshape(b, n_ch, HG_CHUNK, HG_HEADS, t.shape[-1]).transpose(1, 0, 3, 2, 4)

    causal = jnp.tril(jnp.ones((HG_CHUNK, HG_CHUNK), dtype=bool))

    def chunk_step(state, inp):
        qc, kc, vc, gc = inp
        bcum = jnp.cumsum(gc, axis=2)
        o_inter = jnp.einsum('bhtk,bhkv->bhtv', qc * jnp.exp(bcum), state)
        rel = jnp.where(causal[:, :, None], bcum[:, :, :, None, :] - bcum[:, :, None, :, :], -jnp.inf)
        attn = jnp.einsum('bhtk,bhsk,bhtsk->bhts', qc, kc, jnp.exp(rel))
        o_intra = jnp.einsum('bhts,bhsv->bhtv', attn, vc)
        b_last = bcum[:, :, -1:, :]
        new_state = (jnp.exp(b_last[:, :, 0, :])[..., None] * state +
                     jnp.einsum('bhsk,bhsv->bhkv', kc * jnp.exp(b_last - bcum), vc))
        return new_state, o_inter + o_intra

    state0 = jnp.zeros((b, HG_HEADS, HG_KEY_DIM, HG_VAL_DIM), f32)
    _, o = lax.scan(chunk_step, state0, (to_chunks(q), to_chunks(k), to_chunks(v), to_chunks(log_f)))
    return o.transpose(1, 0, 3, 2, 4).reshape(b, s, HG_HEADS, HG_VAL_DIM)


def hier_moe(h, w_grp, b_grp, w_rtr, b_rtr, w_gate, w_up, w_down):
    f32 = jnp.float32
    b, s, d = h.shape
    t = h.reshape(b * s, d)
    grp_logits = (t @ w_grp).astype(f32) + b_grp.astype(f32)
    grp_sel = jnp.argmax(grp_logits, axis=-1)
    grp_prob = jnp.take_along_axis(jax.nn.softmax(grp_logits, axis=-1), grp_sel[:, None], axis=1)
    exp_logits = ((t @ w_rtr).astype(f32) + b_rtr.astype(f32)).reshape(-1, N_GROUPS, EXPERTS_PER_GROUP)
    in_grp = jnp.take_along_axis(exp_logits, grp_sel[:, None, None], axis=1)[:, 0]
    top_logits, top_idx = lax.top_k(in_grp, TOP_K_IN_GROUP)
    top_w = jax.nn.softmax(top_logits, axis=-1) * grp_prob
    expert_ids = grp_sel[:, None] * EXPERTS_PER_GROUP + top_idx
    combine = jnp.sum(jax.nn.one_hot(expert_ids, N_EXPERTS, dtype=f32) * top_w[..., None], axis=1)
    out = jnp.zeros((b * s, d), f32)
    for e in range(N_EXPERTS):
        hid = jax.nn.silu(t @ w_gate[e]) * (t @ w_up[e])
        out = out + combine[:, e:e + 1] * (hid @ w_down[e]).astype(f32)
    return out.reshape(b, s, d).astype(h.dtype)


def setup_inputs(seed: int = 0) -> dict:
    key = jax.random.key(seed)
    ks = jax.random.split(key, 24)
    f32 = jnp.float32
    nrm = lambda k, shape, scale: jax.random.normal(k, shape, f32) * scale
    return {
        'x': nrm(ks[0], (BATCH, SEQ, D_MODEL), 1.0),
        'attn_norm': 1.0 + nrm(ks[1], (DEPTH, D_MODEL), 0.01),
        'w_in': nrm(ks[2], (DEPTH, D_MODEL, IN_COLS), D_MODEL ** -0.5),
        'w_cmp_k': nrm(ks[3], (DEPTH, CMP_LEN * NSA_HEAD_DIM, NSA_HEAD_DIM), (CMP_LEN * NSA_HEAD_DIM) ** -0.5),
        'w_cmp_v': nrm(ks[4], (DEPTH, CMP_LEN * NSA_HEAD_DIM, NSA_HEAD_DIM), (CMP_LEN * NSA_HEAD_DIM) ** -0.5),
        'cmp_pos': nrm(ks[5], (DEPTH, CMP_LEN, NSA_HEAD_DIM), 0.02),
        'hg_lb_logits': nrm(ks[6], (DEPTH + 1, HG_HEADS * HG_KEY_DIM), 0.5),
        'hg_norm': 1.0 + nrm(ks[7], (DEPTH, HG_VAL_DIM), 0.01),
        'w_br_nsa': nrm(ks[8], (DEPTH, NSA_WIDTH, D_MODEL), NSA_WIDTH ** -0.5),
        'w_br_hg': nrm(ks[9], (DEPTH, HG_WIDTH, D_MODEL), HG_WIDTH ** -0.5),
        'w_out': nrm(ks[10], (DEPTH, D_MODEL, D_MODEL), D_MODEL ** -0.5),
        'ffn_norm': 1.0 + nrm(ks[11], (DEPTH, D_MODEL), 0.01),
        'w_grp': nrm(ks[12], (DEPTH, D_MODEL, N_GROUPS), D_MODEL ** -0.5),
        'b_grp': nrm(ks[13], (DEPTH, N_GROUPS), 0.01),
        'w_rtr': nrm(ks[14], (DEPTH, D_MODEL, N_EXPERTS), D_MODEL ** -0.5),
        'b_rtr': nrm(ks[15], (DEPTH, N_EXPERTS), 0.01),
        'w_gate': nrm(ks[16], (DEPTH, N_EXPERTS, D_MODEL, D_FF_EXPERT), D_MODEL ** -0.5),
        'w_up': nrm(ks[17], (DEPTH, N_EXPERTS, D_MODEL, D_FF_EXPERT), D_MODEL ** -0.5),
        'w_down': nrm(ks[18], (DEPTH, N_EXPERTS, D_FF_EXPERT, D_MODEL), D_FF_EXPERT ** -0.5),
        'final_norm': 1.0 + nrm(ks[19], (D_MODEL,), 0.01),
    }


def reference(x, attn_norm, w_in, w_cmp_k, w_cmp_v, cmp_pos, hg_lb_logits, hg_norm, w_br_nsa, w_br_hg,
              w_out, ffn_norm, w_grp, b_grp, w_rtr, b_rtr, w_gate, w_up, w_down, final_norm):
    b, s, _ = x.shape
    lower_bounds = jnp.cumsum(jax.nn.softmax(hg_lb_logits.astype(jnp.float32), axis=0), axis=0)
    split_points = np.cumsum(IN_SPLITS)[:-1].tolist()
    for layer in range(DEPTH):
        h = rmsnorm(x, attn_norm[layer])
        proj = h @ w_in[layer]
        nsa_q, nsa_kv, nsa_gate, hg_q, hg_f, hg_i, hg_g, merge_logits = jnp.split(proj, split_points, axis=-1)
        kv = nsa_kv.reshape(b, s, 6, NSA_KV_GROUPS, NSA_HEAD_DIM)
        o_nsa = nsa_mixer(nsa_q.reshape(b, s, NSA_HEADS, NSA_HEAD_DIM),
                          kv[:, :, 0], kv[:, :, 1], kv[:, :, 2], kv[:, :, 3], kv[:, :, 4], kv[:, :, 5],
                          nsa_gate.reshape(b, s, NSA_HEADS, 3),
                          w_cmp_k[layer], w_cmp_v[layer], cmp_pos[layer])
        lb = lower_bounds[layer].reshape(HG_HEADS, HG_KEY_DIM)
        o_hg = hgrn2_mixer(hg_q, hg_f, hg_i, lb)
        o_hg = rmsnorm(o_hg, hg_norm[layer]) * jax.nn.silu(
            hg_g.astype(jnp.float32).reshape(b, s, HG_HEADS, HG_VAL_DIM))
        o_hg = o_hg.reshape(b, s, HG_WIDTH).astype(x.dtype)
        gate_nsa, gate_hg = jnp.split(jax.nn.sigmoid(merge_logits), 2, axis=-1)
        mixed = (gate_nsa * (o_nsa.astype(x.dtype) @ w_br_nsa[layer]) +
                 gate_hg * (o_hg @ w_br_hg[layer]))
        x = x + mixed @ w_out[layer]
        x = x + hier_moe(rmsnorm(x, ffn_norm[layer]), w_grp[layer], b_grp[layer], w_rtr[layer], b_rtr[layer],
                         w_gate[layer], w_up[layer], w_down[layer])
    return rmsnorm(x, final_norm)
```

```cpp
#include <hip/hip_runtime.h>
#include <cstdio>
#include <cstdint>
namespace pg8 {
#define PG8_LAS __attribute__((address_space(3)))
typedef unsigned short bf16_t;
typedef short bf16x8 __attribute__((ext_vector_type(8)));
typedef float f32x4 __attribute__((ext_vector_type(4)));
typedef unsigned u32x4 __attribute__((ext_vector_type(4)));
constexpr int BM = 256, BK = 64, HALF = 128, HTB = HALF * BK * 2  , STAGE_BYTES = 8 * HTB, NXCD = 8, WGM = 8;

__host__ __device__ __forceinline__ int lds_byte(int r, int c) { const int st = (r >> 4) * 2 + (c >> 5), rr = r & 15, cc = c & 31, ob = rr * 64 + cc * 2; return st * 1024 + (ob ^ (((ob >> 9) & 1) << 5)); }
__host__ __device__ __forceinline__ void stage_rc(int b, int& R, int& C) { const int st = b / 1024, sb = b % 1024, swz = sb ^ (((sb >> 9) & 1) << 5); R = (st >> 1) * 16 + swz / 64; C = (st & 1) * 32 + (swz % 64) / 2; }
__host__ __device__ __forceinline__ int perm32(int rho) { const int n = rho >> 4, i = rho & 15; return 8 * (i >> 2) + 4 * n + (i & 3); }

struct Unit { int pm, pn; };
struct Gemm { const bf16_t* A; const bf16_t* Bt; int M, N, K; };

struct StaticOrder {
    int nM, nN, nwg, G, c;
    __host__ __device__ void init(int M, int N, int G_, int c_) { nM = M / BM; nN = N / BM; nwg = nM * nN; G = G_; c = c_; }
    __host__ __device__ bool next(int i, Unit& u) const {
        const long L = (long)i * G + c; if (L >= nwg) return false;
        int wgid = (int)L; { const int q = nwg / NXCD, r = nwg % NXCD, xcd = wgid % NXCD, off = wgid / NXCD; wgid = (xcd < r ? xcd * (q + 1) : r * (q + 1) + (xcd - r) * q) + off; }
        const int nig = WGM * nN, gid = wgid / nig, fm = gid * WGM, gsz = (nM - fm) < WGM ? (nM - fm) : WGM;
        u.pm = fm + ((wgid % nig) % gsz); u.pn = (wgid % nig) / gsz; return true;
    }
    __device__ __forceinline__ void a_ready(const Unit&) const {}
    __device__ __forceinline__ void done(const Unit&) const {}
};

__device__ __forceinline__ unsigned cvt_pk_bf16(float lo, float hi) { unsigned r; asm volatile("v_cvt_pk_bf16_f32 %0, %1, %2" : "=v"(r) : "v"(lo), "v"(hi)); return r; }
__device__ __forceinline__ float sigm(float x) { return 1.0f / (1.0f + __expf(-x)); }
__device__ __forceinline__ void rot2(float& a, float& b, float c, float s) { const float t1 = a, t2 = b; a = t1 * c - t2 * s; b = t2 * c + t1 * s; }
__device__ __forceinline__ void st_bf16x8(bf16_t* dst, const float (&v)[8]) { u32x4 w; w.x = cvt_pk_bf16(v[0], v[1]); w.y = cvt_pk_bf16(v[2], v[3]); w.z = cvt_pk_bf16(v[4], v[5]); w.w = cvt_pk_bf16(v[6], v[7]); *(u32x4*)dst = w; }
struct EpiProj {
    static constexpr bool PERM = true, AFTER_DRAIN = false;
    bf16_t *Q, *KV, *HQ, *HI, *HGs, *MG; float *HF, *GT; const float* lb; const float* rope;
    __device__ __forceinline__ void operator()(const f32x4 (&acc)[2][2][4][2], const Unit& u, int wr, int wc, int fr, int fq) const {
        const int pn = u.pn; const int row0 = u.pm * BM + wr * 64 + fr; const int cw = wc * 32 + 8 * fq;
#pragma unroll
        for (int ai = 0; ai < 2; ++ai)
#pragma unroll
            for (int m = 0; m < 4; ++m) {
                const int row = row0 + ai * HALF + m * 16; const int pos = row & 8191;
#pragma unroll
                for (int bj = 0; bj < 2; ++bj) {
                    float v[8];
#pragma unroll
                    for (int e = 0; e < 4; ++e) { v[e] = acc[ai][bj][m][0][e]; v[4 + e] = acc[ai][bj][m][1][e]; }
                    const int c = bj * HALF + cw;
                    if (pn < 5) {
                        bool dorope; bf16_t* dst; float sc; int col;
                        if (pn < 2) { col = pn * 256 + c; dorope = (col & 63) < 16; dst = Q + (size_t)row * 512 + col; sc = 0.125f; }
                        else { col = (pn - 2) * 256 + c; const int j = col >> 7; dorope = ((col & 63) < 16) && (j == 2 || j == 4); dst = KV + (size_t)row * 768 + col; sc = 1.0f; }
                        if (dorope) { const int i0 = (col & 63) >> 1; const float* rp = rope + (size_t)pos * 16 + i0 * 2;
                            const f32x4 r0 = *(const f32x4*)rp; const f32x4 r1 = *(const f32x4*)(rp + 4);
                            rot2(v[0], v[1], r0[0], r0[1]); rot2(v[2], v[3], r0[2], r0[3]); rot2(v[4], v[5], r1[0], r1[1]); rot2(v[6], v[7], r1[2], r1[3]); }
#pragma unroll
                        for (int e = 0; e < 8; ++e) v[e] *= sc;
                        st_bf16x8(dst, v);
                    } else if (pn < 7) { st_bf16x8(HQ + (size_t)row * 512 + (pn - 5) * 256 + c, v);
                    } else if (pn < 9) { const int cc = (pn - 7) * 256 + c; const f32x4 l0 = *(const f32x4*)(lb + cc), l1 = *(const f32x4*)(lb + cc + 4);
                        f32x4 o0, o1;
#pragma unroll
                        for (int e = 0; e < 4; ++e) { o0[e] = __logf(l0[e] + (1.0f - l0[e]) * sigm(v[e])); o1[e] = __logf(l1[e] + (1.0f - l1[e]) * sigm(v[4 + e])); }
                        float* d = HF + (size_t)row * 512 + cc; *(f32x4*)d = o0; *(f32x4*)(d + 4) = o1;
                    } else if (pn < 11) { st_bf16x8(HI + (size_t)row * 512 + (pn - 9) * 256 + c, v);
                    } else if (pn < 13) {
#pragma unroll
                        for (int e = 0; e < 8; ++e) v[e] = v[e] * sigm(v[e]);
                        st_bf16x8(HGs + (size_t)row * 512 + (pn - 11) * 256 + c, v);
                    } else if (pn < 21) {
#pragma unroll
                        for (int e = 0; e < 8; ++e) v[e] = sigm(v[e]);
                        st_bf16x8(MG + (size_t)row * 2048 + (pn - 13) * 256 + c, v);
                    } else { if (c < 24) { f32x4 o0, o1;
#pragma unroll
                            for (int e = 0; e < 4; ++e) { o0[e] = sigm(v[e]); o1[e] = sigm(v[4 + e]); }
                            float* d = GT + (size_t)row * 24 + c; *(f32x4*)d = o0; *(f32x4*)(d + 4) = o1; } }
                }
            }
    }
};

template <class Epi, class Sched, bool ALIGN_EPI = false, bool SP2 = false>
__device__ __forceinline__ void gemm_phase(PG8_LAS unsigned char* lds, const Gemm g, const Sched& S, const Epi& E) {
    const int tid = threadIdx.x, wid = __builtin_amdgcn_readfirstlane(tid >> 6), lane = tid & 63, wr = wid >> 2, wc = wid & 3, fr = lane & 15, fq = lane >> 4;
    const int K = g.K, nt = K / BK;
    unsigned voffA[2], voffB[2];
#pragma unroll
    for (int i = 0; i < 2; ++i) { int R, C; stage_rc(tid * 16 + i * 8192, R, C); const int Rb = Epi::PERM ? ((R & ~31) + perm32(R & 31)) : R;
        voffA[i] = (unsigned)(R * K + C) * 2u; voffB[i] = (unsigned)(Rb * K + C) * 2u; }
    const size_t kstep = (size_t)(BK * 2);
    const size_t hstep = (size_t)HALF * K * 2;
    const size_t tstep = 2 * hstep;
    const unsigned ldsw = (unsigned)wid * 1024u;
    const int aoff = lds_byte(wr * 64 + fr, fq * 8), boff = lds_byte(wc * 32 + fr, fq * 8);
#define PG8_SA(b, h) (((b) * 2 + (h)) * HTB)
#define PG8_SB(b, h) ((4 + (b) * 2 + (h)) * HTB)
#define PG8_STAGE(bufoff, gbase, voff) do { _Pragma("unroll") for (int _i = 0; _i < 2; ++_i) \
        __builtin_amdgcn_global_load_lds((const unsigned*)((const char*)(gbase) + (voff)[_i]), (PG8_LAS unsigned*)(lds + (bufoff) + ldsw + _i * 8192), 16, 0, 0); } while (0)
#define PG8_LDA(dst, b, h) do { _Pragma("unroll") for (int m = 0; m < 4; ++m) _Pragma("unroll") for (int k = 0; k < 2; ++k) dst[m][k] = *(const PG8_LAS bf16x8*)(lds + PG8_SA(b, h) + aoff + m * 2048 + k * 1024); } while (0)
#define PG8_LDB(dst, b, h) do { _Pragma("unroll") for (int n = 0; n < 2; ++n) _Pragma("unroll") for (int k = 0; k < 2; ++k) dst[n][k] = *(const PG8_LAS bf16x8*)(lds + PG8_SB(b, h) + boff + n * 2048 + k * 1024); } while (0)
#define PG8_MMA(ai, bj, At, Bt) do { __builtin_amdgcn_s_setprio(1); _Pragma("unroll") for (int m = 0; m < 4; ++m) _Pragma("unroll") for (int n = 0; n < 2; ++n) _Pragma("unroll") for (int k = 0; k < 2; ++k) \
        acc[ai][bj][m][n] = __builtin_amdgcn_mfma_f32_16x16x32_bf16(Bt[n][k], At[m][k], acc[ai][bj][m][n], 0, 0, 0); __builtin_amdgcn_s_setprio(0); } while (0)
#define PG8_WAIT_V(n) asm volatile("s_waitcnt vmcnt(" #n ")" ::: "memory")
#define PG8_WAIT_L(n) asm volatile("s_waitcnt lgkmcnt(" #n ")" ::: "memory")
#define PG8_BAR __builtin_amdgcn_s_barrier()
#define PG8_SCHED __builtin_amdgcn_sched_barrier(0)
    Unit cur, nxt; int ui = 0;
    if (!S.next(0, cur)) return;
    f32x4 acc[2][2][4][2];
#pragma unroll
    for (int a = 0; a < 2; ++a)
#pragma unroll
        for (int b = 0; b < 2; ++b)
#pragma unroll
            for (int m = 0; m < 4; ++m)
#pragma unroll
                for (int n = 0; n < 2; ++n) acc[a][b][m][n] = (f32x4){0.f, 0.f, 0.f, 0.f};
    bf16x8 At[4][2], B0[2][2], B1[2][2];
    const char* cA = (const char*)g.A + (size_t)cur.pm * tstep; const char* cB = (const char*)g.Bt + (size_t)cur.pn * tstep;
    S.a_ready(cur);
    if constexpr (SP2) {
        PG8_STAGE(PG8_SB(0, 0), cB, voffB); PG8_STAGE(PG8_SB(0, 1), cB + hstep, voffB); PG8_STAGE(PG8_SA(0, 0), cA, voffA); PG8_STAGE(PG8_SA(0, 1), cA + hstep, voffA);
        if (wr == 1) PG8_BAR;
        PG8_WAIT_V(2); PG8_BAR;
        PG8_STAGE(PG8_SB(1, 0), cB + kstep, voffB); PG8_STAGE(PG8_SA(1, 0), cA + kstep, voffA); PG8_STAGE(PG8_SB(1, 1), cB + hstep + kstep, voffB);
        PG8_WAIT_V(6); PG8_BAR;
    } else {
        PG8_STAGE(PG8_SB(0, 0), cB, voffB); PG8_STAGE(PG8_SA(0, 0), cA, voffA); PG8_STAGE(PG8_SB(0, 1), cB + hstep, voffB); PG8_STAGE(PG8_SA(0, 1), cA + hstep, voffA);
        if (wr == 1) PG8_BAR;
        PG8_WAIT_V(4); PG8_BAR;
        PG8_STAGE(PG8_SB(1, 0), cB + kstep, voffB); PG8_STAGE(PG8_SA(1, 0), cA + kstep, voffA); PG8_STAGE(PG8_SB(1, 1), cB + hstep + kstep, voffB);
        PG8_WAIT_V(6); PG8_BAR;
    }
    for (;;) {
        const bool has_next = S.next(ui + 1, nxt);
        const char* nA = has_next ? (const char*)g.A + (size_t)nxt.pm * tstep : cA; const char* nB = has_next ? (const char*)g.Bt + (size_t)nxt.pn * tstep : cB;
        for (int t = 0; t < nt; t += 2) {
            const bool last = (t == nt - 2);
            const char* a1 = cA + (size_t)(t + 1) * kstep;
            const char* a2 = last ? nA : cA + (size_t)(t + 2) * kstep; const char* b2 = last ? nB : cB + (size_t)(t + 2) * kstep;
            const char* a3 = a2 + kstep; const char* b3 = b2 + kstep;
            if (last && has_next) S.a_ready(nxt);
            if constexpr (SP2) {
            PG8_LDB(B0, 0, 0); PG8_LDB(B1, 0, 1); PG8_SCHED; PG8_LDA(At, 0, 0); PG8_STAGE(PG8_SA(1, 1), a1 + hstep, voffA);
            PG8_WAIT_V(8); PG8_WAIT_L(0); PG8_BAR; PG8_MMA(0, 0, At, B0); PG8_MMA(0, 1, At, B1); PG8_BAR; PG8_SCHED;
            PG8_LDA(At, 0, 1); PG8_STAGE(PG8_SB(0, 0), b2, voffB); PG8_STAGE(PG8_SB(0, 1), b2 + hstep, voffB); PG8_STAGE(PG8_SA(0, 0), a2, voffA);
            PG8_WAIT_V(8); PG8_WAIT_L(0); PG8_BAR; PG8_MMA(1, 0, At, B0); PG8_MMA(1, 1, At, B1); PG8_BAR; PG8_SCHED;
            PG8_LDB(B0, 1, 0); PG8_LDB(B1, 1, 1); PG8_SCHED; PG8_LDA(At, 1, 0); PG8_STAGE(PG8_SA(0, 1), a2 + hstep, voffA);
            PG8_WAIT_V(8); PG8_WAIT_L(0); PG8_BAR; PG8_MMA(0, 0, At, B0); PG8_MMA(0, 1, At, B1); PG8_BAR; PG8_SCHED;
            PG8_LDA(At, 1, 1); PG8_STAGE(PG8_SB(1, 0), b3, voffB); PG8_STAGE(PG8_SB(1, 1), b3 + hstep, voffB); PG8_STAGE(PG8_SA(1, 0), a3, voffA);
            PG8_WAIT_V(8); PG8_WAIT_L(0); PG8_BAR; PG8_MMA(1, 0, At, B0); PG8_MMA(1, 1, At, B1); PG8_BAR; PG8_SCHED;
            } else {
            PG8_LDB(B0, 0, 0); PG8_SCHED; PG8_LDA(At, 0, 0); PG8_STAGE(PG8_SA(1, 1), a1 + hstep, voffA);
            PG8_WAIT_L(8); PG8_BAR; PG8_WAIT_L(0); PG8_MMA(0, 0, At, B0); PG8_BAR; PG8_SCHED;
            PG8_LDB(B1, 0, 1); PG8_STAGE(PG8_SB(0, 0), b2, voffB);
            PG8_BAR; PG8_WAIT_L(0); PG8_MMA(0, 1, At, B1); PG8_BAR;
            PG8_LDA(At, 0, 1); PG8_STAGE(PG8_SA(0, 0), a2, voffA);
            PG8_BAR; PG8_WAIT_L(0); PG8_MMA(1, 0, At, B0); PG8_BAR; PG8_SCHED;
            PG8_STAGE(PG8_SB(0, 1), b2 + hstep, voffB);
            PG8_WAIT_V(6); PG8_BAR; PG8_MMA(1, 1, At, B1); PG8_BAR;
            PG8_LDB(B0, 1, 0); PG8_SCHED; PG8_LDA(At, 1, 0); PG8_STAGE(PG8_SA(0, 1), a2 + hstep, voffA);
            PG8_WAIT_L(8); PG8_BAR; PG8_WAIT_L(0); PG8_MMA(0, 0, At, B0); PG8_BAR; PG8_SCHED;
            PG8_LDB(B1, 1, 1); PG8_STAGE(PG8_SB(1, 0), b3, voffB);
            PG8_BAR; PG8_WAIT_L(0); PG8_MMA(0, 1, At, B1); PG8_BAR;
            PG8_LDA(At, 1, 1); PG8_STAGE(PG8_SA(1, 0), a3, voffA);
            PG8_BAR; PG8_WAIT_L(0); PG8_MMA(1, 0, At, B0); PG8_BAR; PG8_SCHED;
            PG8_STAGE(PG8_SB(1, 1), b3 + hstep, voffB);
            PG8_WAIT_V(6); PG8_BAR; PG8_MMA(1, 1, At, B1); PG8_BAR;
            }
        }
        if constexpr (ALIGN_EPI) { if (wr == 0) PG8_BAR; }
        if constexpr (!Epi::AFTER_DRAIN) { E(acc, cur, wr, wc, fr, fq); S.done(cur); }
        if (!has_next) break;
#pragma unroll
        for (int a = 0; a < 2; ++a)
#pragma unroll
            for (int b = 0; b < 2; ++b)
#pragma unroll
                for (int m = 0; m < 4; ++m)
#pragma unroll
                    for (int n = 0; n < 2; ++n) acc[a][b][m][n] = (f32x4){0.f, 0.f, 0.f, 0.f};
        cur = nxt; cA = nA; cB = nB; ++ui;
        if constexpr (ALIGN_EPI) { if (wr == 1) PG8_BAR; }
    }
    PG8_WAIT_V(0);
    if constexpr (!ALIGN_EPI) { if (wr == 0) PG8_BAR; }
    PG8_BAR;
    if constexpr (Epi::AFTER_DRAIN) { E.fused(acc, cur, wr, wc, fr, fq, lds, wid, lane); S.done(cur); }
#undef PG8_SA
#undef PG8_SB
#undef PG8_STAGE
#undef PG8_LDA
#undef PG8_LDB
#undef PG8_MMA
#undef PG8_WAIT_V
#undef PG8_WAIT_L
#undef PG8_BAR
#undef PG8_SCHED
}
}

#define GAS __attribute__((address_space(1)))
#define LAS __attribute__((address_space(3)))
typedef unsigned short bf16;
typedef unsigned v4u __attribute__((ext_vector_type(4)));
typedef float f32x4 __attribute__((ext_vector_type(4)));
typedef short bf16x8 __attribute__((ext_vector_type(8)));
typedef GAS unsigned gu32;
typedef GAS unsigned long long gu64;
#define RLX_AGENT __ATOMIC_RELAXED, __HIP_MEMORY_SCOPE_AGENT
#define LDS_WAIT() asm volatile("s_waitcnt lgkmcnt(0)" ::: "memory")
#define VM_WAIT() asm volatile("s_waitcnt vmcnt(0)" ::: "memory")
__device__ __forceinline__ unsigned long long rt() { return __builtin_amdgcn_s_memrealtime(); }
__device__ __forceinline__ unsigned f2bf(float f) { unsigned u = __builtin_bit_cast(unsigned, f); return (u + 0x7fffu + ((u >> 16) & 1u)) >> 16; }
__device__ __forceinline__ unsigned pk2(float lo, float hi) { return f2bf(lo) | (f2bf(hi) << 16); }

#define XB_TMO      128
#define XB_XCNT(j)  (256  + 64 * (j))
#define XB_XSUB(j)  (1280 + 64 * (j))
#define XB_XGEN(j)  (2304 + 64 * (j))
#define XB_TOP      3328
#define XB_TOPGEN   3392
#define XCD_BAR_WORDS 3456
#define XB_SPIN_CAP (1u << 18)

__device__ __forceinline__ unsigned xb_ld(unsigned* p)              { return __hip_atomic_load(p, __ATOMIC_RELAXED, __HIP_MEMORY_SCOPE_AGENT); }
__device__ __forceinline__ unsigned xb_add(unsigned* p, unsigned v) { return __hip_atomic_fetch_add(p, v, __ATOMIC_RELAXED, __HIP_MEMORY_SCOPE_AGENT); }
__device__ __forceinline__ unsigned xb_xcc_id() { return (unsigned)__builtin_amdgcn_s_getreg((3 << 11) | 20) & 0xFu; }
#define XB_SPIN(cond, bar) do { unsigned _sp = 0; while (cond) { __builtin_amdgcn_s_sleep(1); \
    if ((++_sp & 255u) == 0u) { if (xb_ld(&(bar)[XB_TMO])) break; if (_sp > XB_SPIN_CAP) { atomicAdd(&(bar)[XB_TMO], 1u); break; } } } } while (0)

struct XcdBarrier {
    unsigned* bar; unsigned x;
    volatile LAS unsigned* st;
};

__device__ __forceinline__ XcdBarrier xcd_barrier_post(unsigned* bar, volatile LAS unsigned* st) {
    XcdBarrier b; b.bar = bar; b.x = xb_xcc_id(); b.st = st;
    if (threadIdx.x == 0) (void)xb_add(&bar[XB_XCNT(b.x)], 1u);
    return b;
}
__device__ __forceinline__ void xcd_barrier_complete(unsigned* bar, unsigned x, unsigned& nloc, unsigned& nx) {
    const unsigned G = gridDim.x * gridDim.y * gridDim.z;
    unsigned sum, cnt, mine, sp = 0u;
    for (;;) {
        sum = 0u; cnt = 0u; mine = 0u;
#pragma unroll
        for (unsigned j = 0; j < 16; ++j) { const unsigned c = xb_ld(&bar[XB_XCNT(j)]); sum += c; cnt += (c > 0u) ? 1u : 0u; mine = (j == x) ? c : mine; }
        if (sum == G) break;
        __builtin_amdgcn_s_sleep(1);
        if ((++sp & 255u) == 0u) { if (xb_ld(&bar[XB_TMO])) break; if (sp > XB_SPIN_CAP) { atomicAdd(&bar[XB_TMO], 1u); break; } }
    }
    nloc = mine > 0u ? mine : 1u; nx = cnt > 0u ? cnt : 1u;
}

__device__ __forceinline__ void xcd_barrier(const XcdBarrier& b) {
    asm volatile("s_waitcnt vmcnt(0)" ::: "memory");
    __syncthreads();
    if (threadIdx.x == 0) {
        unsigned* bar = b.bar;
        __builtin_amdgcn_s_waitcnt(0);
        unsigned nloc = b.st[0], nx = b.st[1];
        if (nloc == 0u) { xcd_barrier_complete(bar, b.x, nloc, nx); b.st[0] = nloc; b.st[1] = nx; }
        const unsigned old = xb_add(&bar[XB_XSUB(b.x)], 1u);
        const unsigned gen = old / nloc;
        if (old + 1u == (gen + 1u) * nloc) {
            __builtin_amdgcn_fence(__ATOMIC_RELEASE, "agent");
            asm volatile("s_waitcnt vmcnt(0)" ::: "memory");
            const unsigned og = xb_add(&bar[XB_TOP], 1u);
            const unsigned tg = og / nx;
            if (og + 1u == (tg + 1u) * nx) xb_add(&bar[XB_TOPGEN], 1u);
            else XB_SPIN(xb_ld(&bar[XB_TOPGEN]) == tg, bar);
            __builtin_amdgcn_fence(__ATOMIC_ACQUIRE, "agent");
            xb_add(&bar[XB_XGEN(b.x)], 1u);
            asm volatile("s_waitcnt vmcnt(0)" ::: "memory");
        } else {
            XB_SPIN(xb_ld(&bar[XB_XGEN(b.x)]) == gen, bar);
            __builtin_amdgcn_fence(__ATOMIC_ACQUIRE, "agent");
            asm volatile("s_waitcnt vmcnt(0)" ::: "memory");
        }
    }
    __syncthreads();
}
constexpr int NWAVES = 8;
constexpr int DM = 1024, NB = 2, SEQ = 8192, TOK = NB * SEQ;
constexpr int NC_IN = 5400, NPROJ = 5632;
constexpr int NCMP = 511, NSEL = 128, TOPN = 16, NE = 32, FF = 512;
constexpr size_t MiB = 1u << 20;
constexpr size_t WS_CTL = 0, CTL_ZERO_BYTES = 1 * MiB;
constexpr size_t WS_SMALL = 1 * MiB;
constexpr size_t WS_WIN = 2 * MiB;
constexpr size_t WS_WBRN = 13 * MiB, WS_WBRH = 14 * MiB, WS_WOUT = 15 * MiB, WS_WCMP = 17 * MiB;
constexpr size_t WS_WGU = 18 * MiB, WS_WD = 82 * MiB;
constexpr size_t WS_XN = 114 * MiB;
constexpr size_t WS_Q = 146 * MiB, WS_KV = 162 * MiB, WS_HQ = 186 * MiB, WS_HF = 202 * MiB, WS_HI = 234 * MiB, WS_HGS = 250 * MiB, WS_GT = 266 * MiB;
constexpr size_t WS_MISC = 276 * MiB;
constexpr size_t WS_END = 284 * MiB;
constexpr size_t WS_ONSA = 82 * MiB, WS_OHG = 114 * MiB, WS_BUF1 = 146 * MiB, WS_BUF2 = 210 * MiB;
constexpr size_t WS_H2 = 82 * MiB, WS_HU = 146 * MiB, WS_HGT = 210 * MiB, WS_Y = 82 * MiB;
constexpr int CW_BAR = 4096;
constexpr int CW_CNT = 16384;
constexpr int SCR_BYTES = 143360;
constexpr int MISC_OFF = SCR_BYTES;
constexpr int LDS_BYTES = 147456;

__device__ __forceinline__ float wave_sum(float v) {
#pragma unroll
    for (int o = 1; o < 64; o <<= 1) v += __shfl_xor(v, o);
    return v;
}
__device__ __forceinline__ float wave_max(float v) {
#pragma unroll
    for (int o = 1; o < 64; o <<= 1) v = fmaxf(v, __shfl_xor(v, o));
    return v;
}
__device__ __forceinline__ float bf2f(bf16 b) { return __builtin_bit_cast(float, (unsigned)b << 16); }
__device__ __forceinline__ float sigmoidf_(float x) { return 1.0f / (1.0f + expf(-x)); }
__device__ __forceinline__ int perm_d(int dp) { return dp < 16 ? ((dp >> 1) + 8 * (dp & 1)) : dp; }
#define WAVE_LDS_FENCE() asm volatile("s_waitcnt lgkmcnt(0)" ::: "memory")

struct Params {
    const float *x, *attn_norm, *w_in, *w_cmp_k, *w_cmp_v, *cmp_pos, *hg_lb, *hg_norm, *w_br_nsa, *w_br_hg, *w_out, *ffn_norm, *w_grp, *b_grp, *w_rtr, *b_rtr, *w_gate, *w_up, *w_down, *final_norm;
    float* out; unsigned char* ws;
};

template <class F> __device__ __forceinline__ void tr_item(F srcf, int K, bf16* WT, int n0, int k0, float* scr, int lane) {
#pragma unroll 8
    for (int i = 0; i < 32; ++i) { const int kk = 2 * i + (lane >> 5); scr[kk * 33 + (lane & 31)] = srcf(k0 + kk, n0 + (lane & 31)); }
    WAVE_LDS_FENCE();
    const int c = lane & 7;
#pragma unroll
    for (int j = 0; j < 4; ++j) { const int n = (lane >> 3) + 8 * j; const float* s = scr + (8 * c) * 33 + n;
        v4u o; o.x = pk2(s[0 * 33], s[1 * 33]); o.y = pk2(s[2 * 33], s[3 * 33]); o.z = pk2(s[4 * 33], s[5 * 33]); o.w = pk2(s[6 * 33], s[7 * 33]);
        *(v4u*)(WT + (size_t)(n0 + n) * K + k0 + 8 * c) = o; }
    WAVE_LDS_FENCE();
}
__device__ __forceinline__ int win_src_col(int n) {
    if (n < 512) return (n & ~63) + perm_d(n & 63);
    if (n < 1280) { const int j = (n - 512) >> 7; const int d = n & 63; return (n & ~63) + ((j == 2 || j == 4) ? perm_d(d) : d); }
    if (n < 5376) return n + 24;
    if (n < 5400) return 1280 + (n - 5376);
    return -1;
}
__device__ __forceinline__ void p0_prologue(const Params& p, unsigned char* lds, int wave, int lane, int gw, int NGW, int gtid, int NGT) {
    float* scr = (float*)(lds + wave * 8448);
    bf16* Win_t = (bf16*)(p.ws + WS_WIN); bf16* Wbrn_t = (bf16*)(p.ws + WS_WBRN); bf16* Wbrh_t = (bf16*)(p.ws + WS_WBRH); bf16* Wout_t = (bf16*)(p.ws + WS_WOUT); bf16* Wcmp_t = (bf16*)(p.ws + WS_WCMP);
    constexpr int I_IN = 16 * (NPROJ / 32), I_BR = 8 * 32, I_OUT = 16 * 32, I_CMP = 32 * 4;
    constexpr int NITEMS = I_IN + 2 * I_BR + I_OUT + I_CMP;
    for (int it = gw; it < NITEMS; it += NGW) {
        int r = it;
        if (r < I_IN) { const int nblk = NPROJ / 32, kb = r / nblk, nb = r % nblk; const float* W = p.w_in;
            tr_item([W](int k, int n) { const int c = win_src_col(n); return c >= 0 ? W[(size_t)k * NC_IN + c] : 0.0f; }, DM, Win_t, 32 * nb, 64 * kb, scr, lane); continue; }
        r -= I_IN;
        if (r < I_BR) { const int kb = r / 32, nb = r % 32; const float* W = p.w_br_nsa; tr_item([W](int k, int n) { return W[(size_t)k * DM + n]; }, 512, Wbrn_t, 32 * nb, 64 * kb, scr, lane); continue; }
        r -= I_BR;
        if (r < I_BR) { const int kb = r / 32, nb = r % 32; const float* W = p.w_br_hg; tr_item([W](int k, int n) { return W[(size_t)k * DM + n]; }, 512, Wbrh_t, 32 * nb, 64 * kb, scr, lane); continue; }
        r -= I_BR;
        if (r < I_OUT) { const int kb = r / 32, nb = r % 32; const float* W = p.w_out; tr_item([W](int k, int n) { return W[(size_t)k * DM + n]; }, DM, Wout_t, 32 * nb, 64 * kb, scr, lane); continue; }
        r -= I_OUT;
        { const int kb = r / 4, nb = r % 4; const float* Wk = p.w_cmp_k; const float* Wv = p.w_cmp_v;
          tr_item([Wk, Wv](int k, int n) { return n < 64 ? Wk[(size_t)k * 64 + perm_d(n)] : Wv[(size_t)k * 64 + (n - 64)]; }, 2048, Wcmp_t, 32 * nb, 64 * kb, scr, lane); }
    }
    float* lbv = (float*)(p.ws + WS_SMALL); float* rope = (float*)(p.ws + WS_SMALL + 65536);
    for (int i = gtid; i < SEQ * 8; i += NGT) { const int pos = i >> 3, f = i & 7; const float inv = powf(500000.0f, -(float)f / 8.0f); const float ang = (float)pos * inv; float sn, cs; sincosf(ang, &sn, &cs); rope[2 * i] = cs; rope[2 * i + 1] = sn; }
    if (gtid < 512) { const float l0 = p.hg_lb[gtid], l1 = p.hg_lb[512 + gtid]; const float m = fmaxf(l0, l1); const float e0 = expf(l0 - m), e1 = expf(l1 - m); lbv[gtid] = e0 / (e0 + e1); }
    bf16* XN = (bf16*)(p.ws + WS_XN);
    for (int m = gw; m < TOK; m += NGW) {
        const f32x4* xr = (const f32x4*)(p.x + (size_t)m * DM) + lane; const f32x4* gr = (const f32x4*)p.attn_norm + lane;
        f32x4 v[4]; float s = 0.f;
#pragma unroll
        for (int j = 0; j < 4; ++j) { v[j] = xr[64 * j]; s += (v[j].x * v[j].x + v[j].y * v[j].y) + (v[j].z * v[j].z + v[j].w * v[j].w); }
        const float r = 1.0f / sqrtf(wave_sum(s) * (1.0f / DM) + 1e-6f);
        unsigned long long* o8 = (unsigned long long*)(XN + (size_t)m * DM) + lane;
#pragma unroll
        for (int j = 0; j < 4; ++j) { const f32x4 g = gr[64 * j]; o8[64 * j] = (unsigned long long)pk2(v[j].x * r * g.x, v[j].y * r * g.y) | ((unsigned long long)pk2(v[j].z * r * g.z, v[j].w * r * g.w) << 32); }
    }
}

__device__ __forceinline__ void s_compress(const Params& p, int lane, int gw, int NGW) {
    const bf16* KV = (const bf16*)(p.ws + WS_KV); const float* rope = (const float*)(p.ws + WS_SMALL + 65536);
    float* kc = (float*)(p.ws + WS_MISC + 2 * MiB); float* vc = (float*)(p.ws + WS_MISC + 3 * MiB);
    for (int it = gw; it < NB * NCMP * 4; it += NGW) {
        const int j = it & 1, g = (it >> 1) & 1, bn = it >> 2, b = bn / NCMP, n = bn % NCMP;
        const float* W = j == 0 ? p.w_cmp_k : p.w_cmp_v; const int sc = j == 0 ? perm_d(lane) : lane;
        float acc = 0.f;
        for (int l = 0; l < 32; ++l) {
            const bf16* src = KV + (size_t)(b * SEQ + 16 * n + l) * 768 + j * 128 + g * 64;
            for (int d = 0; d < 64; ++d) acc = fmaf(bf2f(src[d]) + p.cmp_pos[l * 64 + d], W[(size_t)(l * 64 + d) * 64 + sc], acc);
        }
        if (j == 0) { const float other = __shfl_xor(acc, 1);
            if (lane < 16) { const int i = lane >> 1; const float cs = rope[(size_t)(16 * n) * 16 + 2 * i], sn = rope[(size_t)(16 * n) * 16 + 2 * i + 1];
                acc = (lane & 1) ? (acc * cs + other * sn) : (acc * cs - other * sn); }
            kc[((size_t)(b * NCMP + n) * 2 + g) * 64 + lane] = acc;
        } else vc[((size_t)(b * NCMP + n) * 2 + g) * 64 + lane] = acc;
    }
}
__device__ __forceinline__ void s_cmp_attn(const Params& p, unsigned char* lds, int wave, int lane, int gw, int NGW) {
    float* wl = (float*)(lds + wave * 17472); float* qs = wl; float* pp = wl + 256; float* sc = pp + 4 * 512;
    const bf16* Q = (const bf16*)(p.ws + WS_Q); const float* GT = (const float*)(p.ws + WS_GT);
    const float* kc = (const float*)(p.ws + WS_MISC + 2 * MiB); const float* vc = (const float*)(p.ws + WS_MISC + 3 * MiB);
    float* onsa = (float*)(p.ws + WS_ONSA); int* selidx = (int*)(p.ws + WS_MISC);
    for (int it = gw; it < TOK * 2; it += NGW) {
        const int g = it & 1, m = it >> 1, b = m >> 13, s = m & 8191;
        WAVE_LDS_FENCE();
#pragma unroll
        for (int r = 0; r < 4; ++r) qs[r * 64 + lane] = bf2f(Q[(size_t)m * 512 + (g * 4 + r) * 64 + lane]);
        WAVE_LDS_FENCE();
        const int nvalid = s >= 31 ? (s - 31) / 16 + 1 : 0;
        float mx[4] = {-3.0e38f, -3.0e38f, -3.0e38f, -3.0e38f};
        for (int n = lane; n < nvalid; n += 64) {
            const float* kp = kc + ((size_t)(b * NCMP + n) * 2 + g) * 64;
            float d0 = 0.f, d1 = 0.f, d2 = 0.f, d3 = 0.f;
            for (int d = 0; d < 64; ++d) { const float kv = kp[d]; d0 = fmaf(qs[d], kv, d0); d1 = fmaf(qs[64 + d], kv, d1); d2 = fmaf(qs[128 + d], kv, d2); d3 = fmaf(qs[192 + d], kv, d3); }
            pp[n] = d0; pp[512 + n] = d1; pp[1024 + n] = d2; pp[1536 + n] = d3;
            mx[0] = fmaxf(mx[0], d0); mx[1] = fmaxf(mx[1], d1); mx[2] = fmaxf(mx[2], d2); mx[3] = fmaxf(mx[3], d3);
        }
        float sm[4];
#pragma unroll
        for (int r = 0; r < 4; ++r) { mx[r] = wave_max(mx[r]); float a = 0.f; for (int n = lane; n < nvalid; n += 64) { const float e = expf(pp[r * 512 + n] - mx[r]); pp[r * 512 + n] = e; a += e; } sm[r] = wave_sum(a); }
#pragma unroll
        for (int r = 0; r < 4; ++r) { const float inv = nvalid > 0 ? 1.0f / sm[r] : 0.f; for (int n = lane; n < nvalid; n += 64) pp[r * 512 + n] *= inv; }
        WAVE_LDS_FENCE();
        float o[4] = {0.f, 0.f, 0.f, 0.f};
        for (int n = 0; n < nvalid; ++n) { const float v = vc[((size_t)(b * NCMP + n) * 2 + g) * 64 + lane]; o[0] = fmaf(pp[n], v, o[0]); o[1] = fmaf(pp[512 + n], v, o[1]); o[2] = fmaf(pp[1024 + n], v, o[2]); o[3] = fmaf(pp[1536 + n], v, o[3]); }
#pragma unroll
        for (int r = 0; r < 4; ++r) { const int h = g * 4 + r; onsa[(size_t)m * 512 + h * 64 + lane] = GT[(size_t)m * 24 + h * 3 + 0] * o[r]; }
        const int jc = s >> 6;
        for (int j = lane; j < NSEL; j += 64) {
            float imp = 0.f;
            for (int n = 4 * j - 1; n <= 4 * j + 3; ++n) if (n >= 0 && n < nvalid) imp += (pp[n] + pp[512 + n]) + (pp[1024 + n] + pp[1536 + n]);
            float v; if (j == jc || j == 0) v = 1.0e4f; else if (64 * j <= s) v = imp; else v = -1.0f;
            sc[j] = v;
        }
        WAVE_LDS_FENCE();
        float v0 = sc[lane], v1 = sc[lane + 64];
        for (int k = 0; k < TOPN; ++k) {
            float bv; int bi;
            if (v0 >= v1) { bv = v0; bi = lane; } else { bv = v1; bi = lane + 64; }
#pragma unroll
            for (int o2 = 1; o2 < 64; o2 <<= 1) { const float ov = __shfl_xor(bv, o2); const int oi = __shfl_xor(bi, o2); if (ov > bv || (ov == bv && oi < bi)) { bv = ov; bi = oi; } }
            if (lane == 0) selidx[(size_t)it * TOPN + k] = bi;
            if (bi == lane) v0 = -3.0e38f; if (bi == lane + 64) v1 = -3.0e38f;
        }
    }
}
template <int MODE> __device__ __forceinline__ void s_sparse_attn(const Params& p, unsigned char* lds, int wave, int lane, int gw, int NGW) {
    float* wl = (float*)(lds + wave * 17472); float* qs = wl; float* pp = wl + 256; int* sel = (int*)(pp + 4 * 1024);
    const bf16* Q = (const bf16*)(p.ws + WS_Q); const bf16* KV = (const bf16*)(p.ws + WS_KV); const float* GT = (const float*)(p.ws + WS_GT);
    float* onsa = (float*)(p.ws + WS_ONSA); const int* selidx = (const int*)(p.ws + WS_MISC);
    constexpr int NCH = MODE == 0 ? 16 : 8; constexpr int KJ = MODE == 0 ? 2 : 4;
    for (int it = gw; it < TOK * 2; it += NGW) {
        const int g = it & 1, m = it >> 1, b = m >> 13, s = m & 8191;
        WAVE_LDS_FENCE();
#pragma unroll
        for (int r = 0; r < 4; ++r) qs[r * 64 + lane] = bf2f(Q[(size_t)m * 512 + (g * 4 + r) * 64 + lane]);
        if (MODE == 0 && lane < 16) sel[lane] = selidx[(size_t)it * TOPN + lane];
        WAVE_LDS_FENCE();
        float mx[4] = {-3.0e38f, -3.0e38f, -3.0e38f, -3.0e38f};
        for (int c = 0; c < NCH; ++c) {
            int kpos; bool valid;
            if (MODE == 0) { kpos = sel[c] * 64 + lane; valid = kpos <= s; } else { kpos = s - 511 + c * 64 + lane; valid = kpos >= 0; }
            const int idx = c * 64 + lane;
            if (valid) {
                const bf16* kp = KV + (size_t)(b * SEQ + kpos) * 768 + KJ * 128 + g * 64;
                float d0 = 0.f, d1 = 0.f, d2 = 0.f, d3 = 0.f;
                for (int d = 0; d < 64; ++d) { const float kv = bf2f(kp[d]); d0 = fmaf(qs[d], kv, d0); d1 = fmaf(qs[64 + d], kv, d1); d2 = fmaf(qs[128 + d], kv, d2); d3 = fmaf(qs[192 + d], kv, d3); }
                pp[idx] = d0; pp[1024 + idx] = d1; pp[2048 + idx] = d2; pp[3072 + idx] = d3;
                mx[0] = fmaxf(mx[0], d0); mx[1] = fmaxf(mx[1], d1); mx[2] = fmaxf(mx[2], d2); mx[3] = fmaxf(mx[3], d3);
            }
        }
        float sm[4];
#pragma unroll
        for (int r = 0; r < 4; ++r) { mx[r] = wave_max(mx[r]); float a = 0.f;
            for (int c = 0; c < NCH; ++c) { const int idx = c * 64 + lane; int kpos; bool valid;
                if (MODE == 0) { kpos = sel[c] * 64 + lane; valid = kpos <= s; } else { kpos = s - 511 + c * 64 + lane; valid = kpos >= 0; }
                float e = 0.f; if (valid) e = expf(pp[r * 1024 + idx] - mx[r]); pp[r * 1024 + idx] = e; a += e; }
            sm[r] = wave_sum(a); }
        WAVE_LDS_FENCE();
        float o[4] = {0.f, 0.f, 0.f, 0.f};
        for (int i = 0; i < NCH * 64; ++i) { int kpos; if (MODE == 0) kpos = sel[i >> 6] * 64 + (i & 63); else kpos = s - 511 + i;
            if (kpos < 0 || kpos > s) continue;
            const float v = bf2f(KV[(size_t)(b * SEQ + kpos) * 768 + (KJ + 1) * 128 + g * 64 + lane]);
            o[0] = fmaf(pp[i], v, o[0]); o[1] = fmaf(pp[1024 + i], v, o[1]); o[2] = fmaf(pp[2048 + i], v, o[2]); o[3] = fmaf(pp[3072 + i], v, o[3]); }
#pragma unroll
        for (int r = 0; r < 4; ++r) { const int h = g * 4 + r; onsa[(size_t)m * 512 + h * 64 + lane] += GT[(size_t)m * 24 + h * 3 + (MODE == 0 ? 1 : 2)] * o[r] / sm[r]; }
    }
}
__device__ __forceinline__ void s_hgrn(const Params& p, unsigned char* lds, int tid, int item) {
    float* qf = (float*)lds; float* ff = qf + 16 * 128; float* vv = ff + 16 * 128;
    const bf16* HQ = (const bf16*)(p.ws + WS_HQ); const float* HF = (const float*)(p.ws + WS_HF); const bf16* HI = (const bf16*)(p.ws + WS_HI); float* ohg = (float*)(p.ws + WS_OHG);
    const int b = item >> 2, hh = item & 3, j = tid >> 2, kq = tid & 3;
    float St[32];
#pragma unroll
    for (int i = 0; i < 32; ++i) St[i] = 0.f;
    for (int s0 = 0; s0 < SEQ; s0 += 16) {
        __syncthreads();
        for (int e = tid; e < 16 * 128; e += 512) { const int tt = e >> 7, k = e & 127; const size_t ro = (size_t)(b * SEQ + s0 + tt) * 512 + hh * 128 + k;
            qf[e] = bf2f(HQ[ro]); ff[e] = expf(HF[ro]); vv[e] = bf2f(HI[ro]); }
        __syncthreads();
        for (int tt = 0; tt < 16; ++tt) {
            const float v = vv[tt * 128 + j]; float o = 0.f;
#pragma unroll
            for (int i = 0; i < 32; ++i) { const int k = kq * 32 + i; const float f = ff[tt * 128 + k]; St[i] = fmaf(f, St[i], (1.0f - f) * v); o = fmaf(qf[tt * 128 + k], St[i], o); }
            o += __shfl_xor(o, 1); o += __shfl_xor(o, 2);
            if (kq == 0) ohg[(size_t)(b * SEQ + s0 + tt) * 512 + hh * 128 + j] = o;
        }
    }
    __syncthreads();
}
__device__ __forceinline__ void s_hg_post(const Params& p, int lane, int gw, int NGW) {
    float* ohg = (float*)(p.ws + WS_OHG); const bf16* HGs = (const bf16*)(p.ws + WS_HGS);
    for (int w = gw; w < TOK * 4; w += NGW) { const int m = w >> 2, hh = w & 3; float* o = ohg + (size_t)m * 512 + hh * 128;
        const float a = o[lane], b = o[lane + 64]; const float r = 1.0f / sqrtf(wave_sum(a * a + b * b) * (1.0f / 128.0f) + 1e-6f);
        const bf16* gr = HGs + (size_t)m * 512 + hh * 128;
        o[lane] = a * r * p.hg_norm[lane] * bf2f(gr[lane]); o[lane + 64] = b * r * p.hg_norm[lane + 64] * bf2f(gr[lane + 64]); }
}
struct GA { const float* A; const float* Bm; float* C; int M, N, K, lda, ldb, ldc, nz; const int* cnt; const int* off; const int* rowlist; size_t strideB; };
__device__ __forceinline__ void s_sgemm(const GA a, unsigned char* lds, int tid, int G) {
    const int half = tid >> 8, t = tid & 255; float* As = (float*)(lds + half * 8704); float* Bs = As + 16 * 68;
    const int tilesN = (a.N + 63) / 64, tilesM = (a.M + 63) / 64, per_z = tilesN * tilesM, total = per_z * a.nz;
    const int tx = t & 15, ty = t >> 4, ar = t >> 2, ak = (t & 3) * 4, bk = t >> 4, bn = (t & 15) * 4;
    for (int base = blockIdx.x * 2; base < total; base += G * 2) {
        bool act[2]; int zz[2], mm0[2], nn0[2], MM[2], ro[2];
#pragma unroll
        for (int h = 0; h < 2; ++h) { const int tt = base + h; act[h] = tt < total; zz[h] = 0; mm0[h] = 0; nn0[h] = 0; MM[h] = 0; ro[h] = 0;
            if (act[h]) { zz[h] = tt / per_z; const int r = tt % per_z; mm0[h] = (r / tilesN) * 64; nn0[h] = (r % tilesN) * 64; MM[h] = a.cnt ? a.cnt[zz[h]] : a.M; ro[h] = a.off ? a.off[zz[h]] : 0; act[h] = mm0[h] < MM[h]; } }
        if (!act[0] && !act[1]) continue;
        const bool me = half == 0 ? act[0] : act[1]; const int z = half == 0 ? zz[0] : zz[1], m0 = half == 0 ? mm0[0] : mm0[1], n0 = half == 0 ? nn0[0] : nn0[1], M = half == 0 ? MM[0] : MM[1], roff = half == 0 ? ro[0] : ro[1];
        const float* Bp = a.Bm + (size_t)z * a.strideB;
        const bool av_ok = me && (m0 + ar) < M; size_t arow = 0; if (av_ok) arow = a.rowlist ? (size_t)a.rowlist[roff + m0 + ar] : (size_t)(roff + m0 + ar);
        const float* Ap = a.A + arow * a.lda + ak; const int ncol = n0 + bn; const bool bv_ok = me && ncol < a.N;
        float acc[4][4];
#pragma unroll
        for (int i = 0; i < 4; ++i)
#pragma unroll
            for (int j = 0; j < 4; ++j) acc[i][j] = 0.f;
        for (int k0 = 0; k0 < a.K; k0 += 16) {
            f32x4 av = {0.f, 0.f, 0.f, 0.f}; if (av_ok) av = *(const f32x4*)(Ap + k0);
            f32x4 bv = {0.f, 0.f, 0.f, 0.f}; if (bv_ok) bv = *(const f32x4*)(Bp + (size_t)(k0 + bk) * a.ldb + ncol);
            As[(ak + 0) * 68 + ar] = av.x; As[(ak + 1) * 68 + ar] = av.y; As[(ak + 2) * 68 + ar] = av.z; As[(ak + 3) * 68 + ar] = av.w;
            *(f32x4*)&Bs[bk * 68 + bn] = bv;
            __syncthreads();
#pragma unroll
            for (int kk = 0; kk < 16; ++kk) { const f32x4 a4 = *(const f32x4*)&As[kk * 68 + ty * 4]; const f32x4 b4 = *(const f32x4*)&Bs[kk * 68 + tx * 4];
#pragma unroll
                for (int i = 0; i < 4; ++i)
#pragma unroll
                    for (int j = 0; j < 4; ++j) acc[i][j] = fmaf(a4[i], b4[j], acc[i][j]); }
            __syncthreads();
        }
        if (me) {
#pragma unroll
            for (int i = 0; i < 4; ++i) { const int m = m0 + ty * 4 + i; if (m < M) { float* cr = a.C + (size_t)(roff + m) * a.ldc;
#pragma unroll
                for (int j = 0; j < 4; ++j) { const int n = n0 + tx * 4 + j; if (n < a.N) cr[n] = acc[i][j]; } } }
        }
    }
}
__device__ __forceinline__ void s_mix(const Params& p, int gtid, int NGT) {
    float* b1 = (float*)(p.ws + WS_BUF1); const float* b2 = (const float*)(p.ws + WS_BUF2); const bf16* MG = (const bf16*)p.out;
    for (size_t i = gtid; i < (size_t)TOK * DM; i += NGT) { const size_t m = i >> 10; const int c = (int)(i & 1023); b1[i] = bf2f(MG[m * 2048 + c]) * b1[i] + bf2f(MG[m * 2048 + 1024 + c]) * b2[i]; }
}
__device__ __forceinline__ void s_res_norm_route(const Params& p, int lane, int gw, int NGW) {
    const float* b2 = (const float*)(p.ws + WS_BUF2); float* h2 = (float*)(p.ws + WS_H2);
    int* eid = (int*)(p.ws + WS_MISC + 4 * MiB); float* ew = (float*)(p.ws + WS_MISC + 4 * MiB + 256 * 1024); int* slot = (int*)(p.ws + WS_MISC + 4 * MiB + 512 * 1024);
    int* cnt = (int*)(p.ws + WS_CTL) + CW_CNT;
    for (int m = gw; m < TOK; m += NGW) {
        const f32x4* xr = (const f32x4*)(p.x + (size_t)m * DM) + lane; const f32x4* yr = (const f32x4*)(b2 + (size_t)m * DM) + lane; f32x4* orow = (f32x4*)(p.out + (size_t)m * DM) + lane;
        const f32x4* gr = (const f32x4*)p.ffn_norm + lane; f32x4* hr = (f32x4*)(h2 + (size_t)m * DM) + lane;
        f32x4 v[4]; float s = 0.f;
#pragma unroll
        for (int j = 0; j < 4; ++j) { v[j] = xr[64 * j] + yr[64 * j]; orow[64 * j] = v[j]; s += (v[j].x * v[j].x + v[j].y * v[j].y) + (v[j].z * v[j].z + v[j].w * v[j].w); }
        const float r = 1.0f / sqrtf(wave_sum(s) * (1.0f / DM) + 1e-6f);
        float acc[36];
#pragma unroll
        for (int i = 0; i < 36; ++i) acc[i] = 0.f;
#pragma unroll
        for (int j = 0; j < 4; ++j) { const f32x4 g = gr[64 * j]; f32x4 h; h.x = v[j].x * r * g.x; h.y = v[j].y * r * g.y; h.z = v[j].z * r * g.z; h.w = v[j].w * r * g.w; hr[64 * j] = h;
#pragma unroll
            for (int e = 0; e < 4; ++e) { const int k = 256 * j + 4 * lane + e; const float hv = h[e];
#pragma unroll
                for (int i = 0; i < 4; ++i) acc[i] = fmaf(hv, p.w_grp[k * 4 + i], acc[i]);
#pragma unroll
                for (int i = 0; i < 32; ++i) acc[4 + i] = fmaf(hv, p.w_rtr[k * 32 + i], acc[4 + i]); } }
#pragma unroll
        for (int i = 0; i < 36; ++i) acc[i] = wave_sum(acc[i]);
        if (lane == 0) {
            float gl[4]; int gs = 0;
#pragma unroll
            for (int i = 0; i < 4; ++i) gl[i] = acc[i] + p.b_grp[i];
            float gm = gl[0];
#pragma unroll
            for (int i = 1; i < 4; ++i) if (gl[i] > gm) { gm = gl[i]; gs = i; }
            float den = 0.f;
#pragma unroll
            for (int i = 0; i < 4; ++i) den += expf(gl[i] - gm);
            const float gp = 1.0f / den;
            float el[8];
#pragma unroll
            for (int i = 0; i < 8; ++i) { float vv = 0.f;
#pragma unroll
                for (int q = 0; q < 4; ++q) if (q == gs) vv = acc[4 + q * 8 + i] + p.b_rtr[q * 8 + i];
                el[i] = vv; }
            int i0 = 0; float b0 = el[0];
#pragma unroll
            for (int i = 1; i < 8; ++i) if (el[i] > b0) { b0 = el[i]; i0 = i; }
            int i1 = -1; float b1 = -3.0e38f;
#pragma unroll
            for (int i = 0; i < 8; ++i) if (i != i0 && el[i] > b1) { b1 = el[i]; i1 = i; }
            const float e1 = expf(b1 - b0); const float w0 = 1.0f / (1.0f + e1), w1 = e1 / (1.0f + e1);
            const int ea = gs * 8 + i0, eb = gs * 8 + i1;
            eid[m * 2] = ea; eid[m * 2 + 1] = eb; ew[m * 2] = w0 * gp; ew[m * 2 + 1] = w1 * gp;
            slot[m * 2] = atomicAdd(&cnt[ea], 1); slot[m * 2 + 1] = atomicAdd(&cnt[eb], 1);
        }
    }
}
__device__ __forceinline__ void s_fill(const Params& p, int gtid, int NGT) {
    const int* cnt = (const int*)(p.ws + WS_CTL) + CW_CNT; int* off = (int*)(p.ws + WS_CTL) + CW_CNT + 64;
    const int* eid = (const int*)(p.ws + WS_MISC + 4 * MiB); const int* slot = (const int*)(p.ws + WS_MISC + 4 * MiB + 512 * 1024);
    int* pos = (int*)(p.ws + WS_MISC + 4 * MiB + 768 * 1024); int* rowtok = (int*)(p.ws + WS_MISC + 5 * MiB);
    for (int i = gtid; i < TOK * 2; i += NGT) { const int e = eid[i]; int o = 0; for (int q = 0; q < NE; ++q) o += (q < e) ? __hip_atomic_load(cnt + q, __ATOMIC_RELAXED, __HIP_MEMORY_SCOPE_AGENT) : 0;
        const int r = o + slot[i]; rowtok[r] = i >> 1; pos[i] = r; }
    if (gtid == 0) { int a = 0; for (int q = 0; q < NE; ++q) { off[q] = a; a += __hip_atomic_load(cnt + q, __ATOMIC_RELAXED, __HIP_MEMORY_SCOPE_AGENT); } }
}
__device__ __forceinline__ void s_silu_mul(const Params& p, int gtid, int NGT) {
    float* hg = (float*)(p.ws + WS_HGT); const float* hu = (const float*)(p.ws + WS_HU);
    for (size_t i = gtid; i < (size_t)TOK * 2 * FF; i += NGT) { const float g = hg[i]; hg[i] = g * sigmoidf_(g) * hu[i]; }
}
__device__ __forceinline__ void s_final(const Params& p, int lane, int gw, int NGW) {
    const float* y = (const float*)(p.ws + WS_Y); const int* eid = (const int*)(p.ws + WS_MISC + 4 * MiB); const float* ew = (const float*)(p.ws + WS_MISC + 4 * MiB + 256 * 1024); const int* pos = (const int*)(p.ws + WS_MISC + 4 * MiB + 768 * 1024);
    for (int t = gw; t < TOK; t += NGW) {
        int a = 0, b = 1; if (eid[t * 2 + 1] < eid[t * 2]) { a = 1; b = 0; }
        const float wa = ew[t * 2 + a], wb = ew[t * 2 + b];
        const f32x4* ya = (const f32x4*)(y + (size_t)pos[t * 2 + a] * DM) + lane; const f32x4* yb = (const f32x4*)(y + (size_t)pos[t * 2 + b] * DM) + lane;
        f32x4* xr = (f32x4*)(p.out + (size_t)t * DM) + lane; const f32x4* gr = (const f32x4*)p.final_norm + lane;
        f32x4 v[4]; float s = 0.f;
#pragma unroll
        for (int j = 0; j < 4; ++j) { v[j] = xr[64 * j] + (ya[64 * j] * wa + yb[64 * j] * wb); s += (v[j].x * v[j].x + v[j].y * v[j].y) + (v[j].z * v[j].z + v[j].w * v[j].w); }
        const float r = 1.0f / sqrtf(wave_sum(s) * (1.0f / DM) + 1e-6f);
#pragma unroll
        for (int j = 0; j < 4; ++j) { const f32x4 g = gr[64 * j]; f32x4 w; w.x = v[j].x * r * g.x; w.y = v[j].y * r * g.y; w.z = v[j].z * r * g.z; w.w = v[j].w * r * g.w; xr[64 * j] = w; }
    }
}

struct Args { Params p; int pad0, pad1; };
__global__ void __launch_bounds__(NWAVES * 64, 2) mk_fwd(Args args) {
    extern __shared__ __attribute__((aligned(16))) unsigned char lds[];
    const Params& p = args.p;
    const int tid = threadIdx.x, lane = tid & 63, wave = __builtin_amdgcn_readfirstlane(tid >> 6);
    const int G = gridDim.x; const int bx = blockIdx.x; const int vcu = (G % 8 == 0) ? (bx % 8) * (G / 8) + bx / 8 : bx;
    const int gw = vcu * NWAVES + wave, NGW = G * NWAVES, gtid = bx * (NWAVES * 64) + tid, NGT = G * NWAVES * 64;
    volatile LAS unsigned* MISC = (volatile LAS unsigned*)((LAS unsigned char*)lds + MISC_OFF);
    for (int u = tid; u < (LDS_BYTES - MISC_OFF) / 4; u += NWAVES * 64) ((LAS unsigned*)((LAS unsigned char*)lds + MISC_OFF))[u] = 0u;
    __syncthreads();
    gu32* ctl = (gu32*)(p.ws + WS_CTL);
    XcdBarrier bar = xcd_barrier_post((unsigned*)(ctl + CW_BAR), MISC + 8);
#define GRID_BAR() xcd_barrier(bar)

    p0_prologue(p, lds, wave, lane, gw, NGW, gtid, NGT);
    GRID_BAR();
    {
        pg8::Gemm g{(const pg8::bf16_t*)(p.ws + WS_XN), (const pg8::bf16_t*)(p.ws + WS_WIN), TOK, NPROJ, DM}; pg8::StaticOrder S; S.init(TOK, NPROJ, G, bx);
        pg8::EpiProj E{(pg8::bf16_t*)(p.ws + WS_Q), (pg8::bf16_t*)(p.ws + WS_KV), (pg8::bf16_t*)(p.ws + WS_HQ), (pg8::bf16_t*)(p.ws + WS_HI), (pg8::bf16_t*)(p.ws + WS_HGS), (pg8::bf16_t*)p.out,
                       (float*)(p.ws + WS_HF), (float*)(p.ws + WS_GT), (const float*)(p.ws + WS_SMALL), (const float*)(p.ws + WS_SMALL + 65536)};
        pg8::gemm_phase<pg8::EpiProj, pg8::StaticOrder, true, true>((LAS unsigned char*)lds, g, S, E);
    }
    GRID_BAR();
    s_compress(p, lane, gw, NGW);
    GRID_BAR();
    if (bx < 8) s_hgrn(p, lds, tid, bx);
    s_cmp_attn(p, lds, wave, lane, gw, NGW);
    GRID_BAR();
    s_sparse_attn<0>(p, lds, wave, lane, gw, NGW);
    GRID_BAR();
    s_sparse_attn<1>(p, lds, wave, lane, gw, NGW);
    s_hg_post(p, lane, gw, NGW);
    GRID_BAR();
    { GA a{(const float*)(p.ws + WS_ONSA), p.w_br_nsa, (float*)(p.ws + WS_BUF1), TOK, DM, 512, 512, DM, DM, 1, nullptr, nullptr, nullptr, 0}; s_sgemm(a, lds, tid, G); }
    { GA a{(const float*)(p.ws + WS_OHG), p.w_br_hg, (float*)(p.ws + WS_BUF2), TOK, DM, 512, 512, DM, DM, 1, nullptr, nullptr, nullptr, 0}; s_sgemm(a, lds, tid, G); }
    GRID_BAR();
    s_mix(p, gtid, NGT);
    GRID_BAR();
    { GA a{(const float*)(p.ws + WS_BUF1), p.w_out, (float*)(p.ws + WS_BUF2), TOK, DM, DM, DM, DM, DM, 1, nullptr, nullptr, nullptr, 0}; s_sgemm(a, lds, tid, G); }
    GRID_BAR();
    s_res_norm_route(p, lane, gw, NGW);
    GRID_BAR();
    s_fill(p, gtid, NGT);
    GRID_BAR();
    {
        const int* cnt = (const int*)(p.ws + WS_CTL) + CW_CNT; const int* off = cnt + 64; const int* rowtok = (const int*)(p.ws + WS_MISC + 5 * MiB);
        { GA a{(const float*)(p.ws + WS_H2), p.w_gate, (float*)(p.ws + WS_HGT), TOK, FF, DM, DM, FF, FF, NE, cnt, off, rowtok, (size_t)DM * FF}; s_sgemm(a, lds, tid, G); }
        { GA a{(const float*)(p.ws + WS_H2), p.w_up, (float*)(p.ws + WS_HU), TOK, FF, DM, DM, FF, FF, NE, cnt, off, rowtok, (size_t)DM * FF}; s_sgemm(a, lds, tid, G); }
        GRID_BAR();
        s_silu_mul(p, gtid, NGT);
        GRID_BAR();
        { GA a{(const float*)(p.ws + WS_HGT), p.w_down, (float*)(p.ws + WS_Y), TOK, DM, FF, FF, DM, DM, NE, cnt, off, nullptr, (size_t)FF * DM}; s_sgemm(a, lds, tid, G); }
    }
    GRID_BAR();
    s_final(p, lane, gw, NGW);
}

extern "C" void kernel_launch(void* const* d_in, const int* in_sizes, int n_in, void* d_out, int out_size, void* d_ws, size_t ws_size, hipStream_t stream) {
    static int grid = 0;
    if (grid == 0) {
        if (n_in != 20 || out_size != TOK * DM || ws_size < WS_END) { fprintf(stderr, "kernel_launch: unexpected problem (n_in %d, out %d, ws %zu)\n", n_in, out_size, ws_size); grid = -1; return; }
        int dev = 0, cus = 0, per_cu = 0;
        if (hipGetDevice(&dev) != hipSuccess || hipDeviceGetAttribute(&cus, hipDeviceAttributeMultiprocessorCount, dev) != hipSuccess) { grid = -1; return; }
        if (hipFuncSetAttribute((const void*)mk_fwd, hipFuncAttributeMaxDynamicSharedMemorySize, LDS_BYTES) != hipSuccess) { fprintf(stderr, "kernel_launch: hipFuncSetAttribute failed\n"); grid = -1; return; }
        if (hipOccupancyMaxActiveBlocksPerMultiprocessor(&per_cu, (const void*)mk_fwd, NWAVES * 64, LDS_BYTES) != hipSuccess || per_cu < 1) { fprintf(stderr, "kernel_launch: occupancy query says %d\n", per_cu); }
        (void)hipGetLastError();
        grid = cus;
    }
    if (grid < 0) return;
    if (hipMemsetAsync((char*)d_ws + WS_CTL, 0, CTL_ZERO_BYTES, stream) != hipSuccess) { fprintf(stderr, "kernel_launch: memset failed\n"); return; }
    Args a{};
    Params& p = a.p;
    p.x = (const float*)d_in[0]; p.attn_norm = (const float*)d_in[1]; p.w_in = (const float*)d_in[2]; p.w_cmp_k = (const float*)d_in[3]; p.w_cmp_v = (const float*)d_in[4]; p.cmp_pos = (const float*)d_in[5];
    p.hg_lb = (const float*)d_in[6]; p.hg_norm = (const float*)d_in[7]; p.w_br_nsa = (const float*)d_in[8]; p.w_br_hg = (const float*)d_in[9]; p.w_out = (const float*)d_in[10]; p.ffn_norm = (const float*)d_in[11];
    p.w_grp = (const float*)d_in[12]; p.b_grp = (const float*)d_in[13]; p.w_rtr = (const float*)d_in[14]; p.b_rtr = (const float*)d_in[15]; p.w_gate = (const float*)d_in[16]; p.w_up = (const float*)d_in[17];
    p.w_down = (const float*)d_in[18]; p.final_norm = (const float*)d_in[19]; p.out = (float*)d_out; p.ws = (unsigned char*)d_ws;
    hipLaunchKernelGGL(mk_fwd, dim3(grid), dim3(NWAVES * 64), LDS_BYTES, stream, a);
}
```

```cpp
#include <hip/hip_runtime.h>
#include <cstdio>
#include <cstdint>
namespace pg8 {
#define PG8_LAS __attribute__((address_space(3)))
typedef unsigned short bf16_t;
typedef short bf16x8 __attribute__((ext_vector_type(8)));
typedef float f32x4 __attribute__((ext_vector_type(4)));
typedef unsigned u32x4 __attribute__((ext_vector_type(4)));
constexpr int BM = 256, BK = 64, HALF = 128, HTB = HALF * BK * 2  , STAGE_BYTES = 8 * HTB, NXCD = 8, WGM = 8;

__host__ __device__ __forceinline__ int lds_byte(int r, int c) { const int st = (r >> 4) * 2 + (c >> 5), rr = r & 15, cc = c & 31, ob = rr * 64 + cc * 2; return st * 1024 + (ob ^ (((ob >> 9) & 1) << 5)); }
__host__ __device__ __forceinline__ void stage_rc(int b, int& R, int& C) { const int st = b / 1024, sb = b % 1024, swz = sb ^ (((sb >> 9) & 1) << 5); R = (st >> 1) * 16 + swz / 64; C = (st & 1) * 32 + (swz % 64) / 2; }
__host__ __device__ __forceinline__ int perm32(int rho) { const int n = rho >> 4, i = rho & 15; return 8 * (i >> 2) + 4 * n + (i & 3); }

struct Unit { int pm, pn, sel; };
struct Gemm { const bf16_t* A; const bf16_t* Bt; int M, N, K; const bf16_t* A2; const bf16_t* Bt2; };

struct StaticOrder {
    int nM, nN, nwg, G, c;
    __host__ __device__ void init(int M, int N, int G_, int c_) { nM = M / BM; nN = N / BM; nwg = nM * nN; G = G_; c = c_; }
    __host__ __device__ bool next(int i, Unit& u) const {
        const long L = (long)i * G + c; if (L >= nwg) return false;
        int wgid = (int)L; { const int q = nwg / NXCD, r = nwg % NXCD, xcd = wgid % NXCD, off = wgid / NXCD; wgid = (xcd < r ? xcd * (q + 1) : r * (q + 1) + (xcd - r) * q) + off; }
        const int nig = WGM * nN, gid = wgid / nig, fm = gid * WGM, gsz = (nM - fm) < WGM ? (nM - fm) : WGM;
        u.pm = fm + ((wgid % nig) % gsz); u.pn = (wgid % nig) / gsz; u.sel = 0; return true;
    }
    __device__ __forceinline__ void a_ready(const Unit&) const {}
    __device__ __forceinline__ void done(const Unit&) const {}
};

__device__ __forceinline__ unsigned cvt_pk_bf16(float lo, float hi) { unsigned r; asm volatile("v_cvt_pk_bf16_f32 %0, %1, %2" : "=v"(r) : "v"(lo), "v"(hi)); return r; }
__device__ __forceinline__ float sigm(float x) { return __builtin_amdgcn_rcpf(1.0f + __expf(-x)); }
__device__ __forceinline__ void rot2(float& a, float& b, float c, float s) { const float t1 = a, t2 = b; a = t1 * c - t2 * s; b = t2 * c + t1 * s; }
__device__ __forceinline__ void st_bf16x8(bf16_t* dst, const float (&v)[8]) { u32x4 w; w.x = cvt_pk_bf16(v[0], v[1]); w.y = cvt_pk_bf16(v[2], v[3]); w.z = cvt_pk_bf16(v[4], v[5]); w.w = cvt_pk_bf16(v[6], v[7]); *(u32x4*)dst = w; }
struct EpiProj {
    static constexpr bool PERM = true, AFTER_DRAIN = false;
    __device__ __forceinline__ bool keep(const Unit&) const { return false; }
    bf16_t *Q, *KV, *HQ, *HI, *HGs, *MG; float *HF, *GT; const float* lb; const float* rope;
    __device__ __forceinline__ void operator()(const f32x4 (&acc)[2][2][4][2], const Unit& u, int wr, int wc, int fr, int fq) const {
        const int pn = u.pn; int row0 = u.pm * BM + wr * 64 + fr; int cw = wc * 32 + 8 * fq; asm volatile("" : "+v"(row0), "+v"(cw));
#pragma unroll
        for (int ai = 0; ai < 2; ++ai)
#pragma unroll
            for (int m = 0; m < 4; ++m) {
                const int row = row0 + ai * HALF + m * 16; const int pos = row & 8191;
#pragma unroll
                for (int bj = 0; bj < 2; ++bj) {
                    float v[8];
#pragma unroll
                    for (int e = 0; e < 4; ++e) { v[e] = acc[ai][bj][m][0][e]; v[4 + e] = acc[ai][bj][m][1][e]; }
                    const int c = bj * HALF + cw;
                    if (pn < 5) {
                        bool dorope; bf16_t* dst; float sc; int col;
                        if (pn < 2) { col = pn * 256 + c; dorope = (col & 63) < 16; dst = Q + (size_t)row * 512 + col; sc = 0.125f; }
                        else { col = (pn - 2) * 256 + c; const int j = col >> 7; dorope = ((col & 63) < 16) && (j == 2 || j == 4); dst = KV + (size_t)row * 768 + col; sc = 1.0f; }
                        if (dorope) { const int i0 = (col & 63) >> 1; const float* rp = rope + (size_t)pos * 16 + i0 * 2;
                            const f32x4 r0 = *(const f32x4*)rp; const f32x4 r1 = *(const f32x4*)(rp + 4);
                            rot2(v[0], v[1], r0[0], r0[1]); rot2(v[2], v[3], r0[2], r0[3]); rot2(v[4], v[5], r1[0], r1[1]); rot2(v[6], v[7], r1[2], r1[3]); }
#pragma unroll
                        for (int e = 0; e < 8; ++e) v[e] *= sc;
                        st_bf16x8(dst, v);
                    } else if (pn < 7) { st_bf16x8(HQ + (size_t)row * 512 + (pn - 5) * 256 + c, v);
                    } else if (pn < 9) { const int cc = (pn - 7) * 256 + c; const f32x4 l0 = *(const f32x4*)(lb + cc), l1 = *(const f32x4*)(lb + cc + 4);
                        f32x4 o0, o1;
#pragma unroll
                        for (int e = 0; e < 4; ++e) { o0[e] = __logf(l0[e] + (1.0f - l0[e]) * sigm(v[e])); o1[e] = __logf(l1[e] + (1.0f - l1[e]) * sigm(v[4 + e])); }
                        float* d = HF + (size_t)row * 512 + cc; *(f32x4*)d = o0; *(f32x4*)(d + 4) = o1;
                    } else if (pn < 11) { st_bf16x8(HI + (size_t)row * 512 + (pn - 9) * 256 + c, v);
                    } else if (pn < 13) {
#pragma unroll
                        for (int e = 0; e < 8; ++e) v[e] = v[e] * sigm(v[e]);
                        st_bf16x8(HGs + (size_t)row * 512 + (pn - 11) * 256 + c, v);
                    } else if (pn < 21) {
#pragma unroll
                        for (int e = 0; e < 8; ++e) v[e] = sigm(v[e]);
                        st_bf16x8(MG + (size_t)row * 2048 + (pn - 13) * 256 + c, v);
                    } else { if (c < 24) { f32x4 o0, o1;
#pragma unroll
                            for (int e = 0; e < 4; ++e) { o0[e] = sigm(v[e]); o1[e] = sigm(v[4 + e]); }
                            float* d = GT + (size_t)row * 24 + c; *(f32x4*)d = o0; *(f32x4*)(d + 4) = o1; } }
                }
            }
    }
};

__device__ __forceinline__ void ld_bf16x8(const bf16_t* src, float (&v)[8]) { const u32x4 w = *(const u32x4*)src;
    v[0] = __builtin_bit_cast(float, w.x << 16); v[1] = __builtin_bit_cast(float, w.x & 0xffff0000u); v[2] = __builtin_bit_cast(float, w.y << 16); v[3] = __builtin_bit_cast(float, w.y & 0xffff0000u);
    v[4] = __builtin_bit_cast(float, w.z << 16); v[5] = __builtin_bit_cast(float, w.z & 0xffff0000u); v[6] = __builtin_bit_cast(float, w.w << 16); v[7] = __builtin_bit_cast(float, w.w & 0xffff0000u); }
struct MergeOrder {
    StaticOrder so;
    __device__ void init(int M, int N, int G, int c) { so.init(M, N, G, c); }
    __device__ bool next(int i, Unit& u) const { if (!so.next(i >> 1, u)) return false; u.sel = i & 1; return true; }
    __device__ __forceinline__ void a_ready(const Unit&) const {}
    __device__ __forceinline__ void done(const Unit&) const {}
};
struct EpiMerge {
    static constexpr bool PERM = true, AFTER_DRAIN = false;
    __device__ __forceinline__ bool keep(const Unit&) const { return false; }
    const bf16_t* MG; bf16_t* MIX;
    __device__ __forceinline__ void operator()(const f32x4 (&acc)[2][2][4][2], const Unit& u, int wr, int wc, int fr, int fq) const {
        int row0 = u.pm * BM + wr * 64 + fr; int col0 = u.pn * BM + wc * 32 + 8 * fq; asm volatile("" : "+v"(row0), "+v"(col0));
#pragma unroll
        for (int ai = 0; ai < 2; ++ai)
#pragma unroll
            for (int m = 0; m < 4; ++m) { const int row = row0 + ai * HALF + m * 16;
#pragma unroll
                for (int bj = 0; bj < 2; ++bj) { const int col = col0 + bj * HALF;
                    float g[8], v[8]; ld_bf16x8(MG + (size_t)row * 2048 + (u.sel ? 1024 : 0) + col, g);
#pragma unroll
                    for (int e = 0; e < 4; ++e) { v[e] = acc[ai][bj][m][0][e] * g[e]; v[4 + e] = acc[ai][bj][m][1][e] * g[4 + e]; }
                    bf16_t* dst = MIX + (size_t)row * 1024 + col;
                    if (u.sel) { float o[8]; ld_bf16x8(dst, o);
#pragma unroll
                        for (int e = 0; e < 8; ++e) v[e] += o[e]; }
                    st_bf16x8(dst, v); } }
    }
};
struct EpiOut {
    static constexpr bool PERM = false, AFTER_DRAIN = false;
    __device__ __forceinline__ bool keep(const Unit&) const { return false; }
    const float* X; float* O;
    __device__ __forceinline__ void operator()(const f32x4 (&acc)[2][2][4][2], const Unit& u, int wr, int wc, int fr, int fq) const {
        int row0 = u.pm * BM + wr * 64 + fr; int col0 = u.pn * BM + wc * 32 + 4 * fq; asm volatile("" : "+v"(row0), "+v"(col0));
#pragma unroll
        for (int ai = 0; ai < 2; ++ai)
#pragma unroll
            for (int m = 0; m < 4; ++m) { const size_t ro = (size_t)(row0 + ai * HALF + m * 16) * 1024 + col0;
#pragma unroll
                for (int bj = 0; bj < 2; ++bj)
#pragma unroll
                    for (int n = 0; n < 2; ++n) { const size_t o = ro + bj * HALF + n * 16; *(f32x4*)(O + o) = *(const f32x4*)(X + o) + acc[ai][bj][m][n]; } }
    }
};
struct MoeOrder {
    const volatile PG8_LAS int* tp;
    int G, c;
    __device__ bool next(int i, Unit& u) const {
        const int L = i * G + c; const int ntile = __builtin_amdgcn_readfirstlane(tp[32]);
        if (L >= 4 * ntile) return false;
        const int rt = L >> 2, nt = L & 3; int e = 0;
        for (int q = 1; q < 32; ++q) e += (__builtin_amdgcn_readfirstlane(tp[q]) <= rt) ? 1 : 0;
        u.pm = rt; u.pn = e * 4 + nt; u.sel = 0; return true;
    }
    __device__ __forceinline__ void a_ready(const Unit&) const {}
    __device__ __forceinline__ void done(const Unit&) const {}
};
struct EpiGU {
    static constexpr bool PERM = true, AFTER_DRAIN = false;
    __device__ __forceinline__ bool keep(const Unit&) const { return false; }
    const float* RS; bf16_t* HID;
    __device__ __forceinline__ void operator()(const f32x4 (&acc)[2][2][4][2], const Unit& u, int wr, int wc, int fr, int fq) const {
        int row0 = u.pm * BM + wr * 64 + fr; int col0 = (u.pn & 3) * 128 + wc * 32 + 8 * fq; asm volatile("" : "+v"(row0), "+v"(col0));
#pragma unroll
        for (int ai = 0; ai < 2; ++ai)
#pragma unroll
            for (int m = 0; m < 4; ++m) { const int row = row0 + ai * HALF + m * 16; const float r = RS[row]; float v[8];
#pragma unroll
                for (int e = 0; e < 4; ++e) { const float g0 = acc[ai][0][m][0][e] * r, g1 = acc[ai][0][m][1][e] * r; v[e] = g0 * sigm(g0) * (acc[ai][1][m][0][e] * r); v[4 + e] = g1 * sigm(g1) * (acc[ai][1][m][1][e] * r); }
                st_bf16x8(HID + (size_t)row * 512 + col0, v); }
    }
};
struct EpiDown {
    static constexpr bool PERM = true, AFTER_DRAIN = false;
    __device__ __forceinline__ bool keep(const Unit&) const { return false; }
    bf16_t* Y;
    __device__ __forceinline__ void operator()(const f32x4 (&acc)[2][2][4][2], const Unit& u, int wr, int wc, int fr, int fq) const {
        int row0 = u.pm * BM + wr * 64 + fr; int col0 = (u.pn & 3) * BM + wc * 32 + 8 * fq; asm volatile("" : "+v"(row0), "+v"(col0));
#pragma unroll
        for (int ai = 0; ai < 2; ++ai)
#pragma unroll
            for (int m = 0; m < 4; ++m) { const int row = row0 + ai * HALF + m * 16;
#pragma unroll
                for (int bj = 0; bj < 2; ++bj) { float v[8];
#pragma unroll
                    for (int e = 0; e < 4; ++e) { v[e] = acc[ai][bj][m][0][e]; v[4 + e] = acc[ai][bj][m][1][e]; }
                    st_bf16x8(Y + (size_t)row * 1024 + col0 + bj * HALF, v); } }
    }
};

template <class Epi, class Sched, bool ALIGN_EPI = false, bool SP2 = false>
__device__ __forceinline__ void gemm_phase(PG8_LAS unsigned char* lds, const Gemm g, const Sched& S, const Epi& E) {
    const int tid = threadIdx.x, wid = __builtin_amdgcn_readfirstlane(tid >> 6), lane = tid & 63, wr = wid >> 2, wc = wid & 3, fr = lane & 15, fq = lane >> 4;
    const int K = g.K, nt = K / BK;
    unsigned voffA[2], voffB[2];
#pragma unroll
    for (int i = 0; i < 2; ++i) { int R, C; stage_rc(tid * 16 + i * 8192, R, C); const int Rb = Epi::PERM ? ((R & ~31) + perm32(R & 31)) : R;
        voffA[i] = (unsigned)(R * K + C) * 2u; voffB[i] = (unsigned)(Rb * K + C) * 2u; }
    const size_t kstep = (size_t)(BK * 2);
    const size_t hstep = (size_t)HALF * K * 2;
    const size_t tstep = 2 * hstep;
    const unsigned ldsw = (unsigned)wid * 1024u;
    const int aoff = lds_byte(wr * 64 + fr, fq * 8), boff = lds_byte(wc * 32 + fr, fq * 8);
#define PG8_SA(b, h) (((b) * 2 + (h)) * HTB)
#define PG8_SB(b, h) ((4 + (b) * 2 + (h)) * HTB)
#define PG8_STAGE(bufoff, gbase, voff) do { _Pragma("unroll") for (int _i = 0; _i < 2; ++_i) \
        __builtin_amdgcn_global_load_lds((const unsigned*)((const char*)(gbase) + (voff)[_i]), (PG8_LAS unsigned*)(lds + (bufoff) + ldsw + _i * 8192), 16, 0, 0); } while (0)
#define PG8_LDA(dst, b, h) do { _Pragma("unroll") for (int m = 0; m < 4; ++m) _Pragma("unroll") for (int k = 0; k < 2; ++k) dst[m][k] = *(const PG8_LAS bf16x8*)(lds + PG8_SA(b, h) + aoff + m * 2048 + k * 1024); } while (0)
#define PG8_LDB(dst, b, h) do { _Pragma("unroll") for (int n = 0; n < 2; ++n) _Pragma("unroll") for (int k = 0; k < 2; ++k) dst[n][k] = *(const PG8_LAS bf16x8*)(lds + PG8_SB(b, h) + boff + n * 2048 + k * 1024); } while (0)
#define PG8_MMA(ai, bj, At, Bt) do { __builtin_amdgcn_s_setprio(1); _Pragma("unroll") for (int m = 0; m < 4; ++m) _Pragma("unroll") for (int n = 0; n < 2; ++n) _Pragma("unroll") for (int k = 0; k < 2; ++k) \
        acc[ai][bj][m][n] = __builtin_amdgcn_mfma_f32_16x16x32_bf16(Bt[n][k], At[m][k], acc[ai][bj][m][n], 0, 0, 0); __builtin_amdgcn_s_setprio(0); } while (0)
#define PG8_WAIT_V(n) asm volatile("s_waitcnt vmcnt(" #n ")" ::: "memory")
#define PG8_WAIT_L(n) asm volatile("s_waitcnt lgkmcnt(" #n ")" ::: "memory")
#define PG8_BAR __builtin_amdgcn_s_barrier()
#define PG8_SCHED __builtin_amdgcn_sched_barrier(0)
    Unit cur, nxt; int ui = 0;
    if (!S.next(0, cur)) return;
    f32x4 acc[2][2][4][2];
#pragma unroll
    for (int a = 0; a < 2; ++a)
#pragma unroll
        for (int b = 0; b < 2; ++b)
#pragma unroll
            for (int m = 0; m < 4; ++m)
#pragma unroll
                for (int n = 0; n < 2; ++n) acc[a][b][m][n] = (f32x4){0.f, 0.f, 0.f, 0.f};
    bf16x8 At[4][2], B0[2][2], B1[2][2];
    const char* cA = (const char*)(cur.sel ? g.A2 : g.A) + (size_t)cur.pm * tstep; const char* cB = (const char*)(cur.sel ? g.Bt2 : g.Bt) + (size_t)cur.pn * tstep;
    S.a_ready(cur);
    if constexpr (SP2) {
        PG8_STAGE(PG8_SB(0, 0), cB, voffB); PG8_STAGE(PG8_SB(0, 1), cB + hstep, voffB); PG8_STAGE(PG8_SA(0, 0), cA, voffA); PG8_STAGE(PG8_SA(0, 1), cA + hstep, voffA);
        if (wr == 1) PG8_BAR;
        PG8_WAIT_V(2); PG8_BAR;
        PG8_STAGE(PG8_SB(1, 0), cB + kstep, voffB); PG8_STAGE(PG8_SA(1, 0), cA + kstep, voffA); PG8_STAGE(PG8_SB(1, 1), cB + hstep + kstep, voffB);
        PG8_WAIT_V(6); PG8_BAR;
    } else {
        PG8_STAGE(PG8_SB(0, 0), cB, voffB); PG8_STAGE(PG8_SA(0, 0), cA, voffA); PG8_STAGE(PG8_SB(0, 1), cB + hstep, voffB); PG8_STAGE(PG8_SA(0, 1), cA + hstep, voffA);
        if (wr == 1) PG8_BAR;
        PG8_WAIT_V(4); PG8_BAR;
        PG8_STAGE(PG8_SB(1, 0), cB + kstep, voffB); PG8_STAGE(PG8_SA(1, 0), cA + kstep, voffA); PG8_STAGE(PG8_SB(1, 1), cB + hstep + kstep, voffB);
        PG8_WAIT_V(6); PG8_BAR;
    }
    for (;;) {
        const bool has_next = S.next(ui + 1, nxt);
        const char* nA = has_next ? (const char*)(nxt.sel ? g.A2 : g.A) + (size_t)nxt.pm * tstep : cA; const char* nB = has_next ? (const char*)(nxt.sel ? g.Bt2 : g.Bt) + (size_t)nxt.pn * tstep : cB;
        for (int t = 0; t < nt; t += 2) {
            const bool last = (t == nt - 2);
            const char* a1 = cA + (size_t)(t + 1) * kstep;
            const char* a2 = last ? nA : cA + (size_t)(t + 2) * kstep; const char* b2 = last ? nB : cB + (size_t)(t + 2) * kstep;
            const char* a3 = a2 + kstep; const char* b3 = b2 + kstep;
            if (last && has_next) S.a_ready(nxt);
            if constexpr (SP2) {
            PG8_LDB(B0, 0, 0); PG8_LDB(B1, 0, 1); PG8_SCHED; PG8_LDA(At, 0, 0); PG8_STAGE(PG8_SA(1, 1), a1 + hstep, voffA);
            PG8_WAIT_V(8); PG8_WAIT_L(0); PG8_BAR; PG8_MMA(0, 0, At, B0); PG8_MMA(0, 1, At, B1); PG8_BAR; PG8_SCHED;
            PG8_LDA(At, 0, 1); PG8_STAGE(PG8_SB(0, 0), b2, voffB); PG8_STAGE(PG8_SB(0, 1), b2 + hstep, voffB); PG8_STAGE(PG8_SA(0, 0), a2, voffA);
            PG8_WAIT_V(8); PG8_WAIT_L(0); PG8_BAR; PG8_MMA(1, 0, At, B0); PG8_MMA(1, 1, At, B1); PG8_BAR; PG8_SCHED;
            PG8_LDB(B0, 1, 0); PG8_LDB(B1, 1, 1); PG8_SCHED; PG8_LDA(At, 1, 0); PG8_STAGE(PG8_SA(0, 1), a2 + hstep, voffA);
            PG8_WAIT_V(8); PG8_WAIT_L(0); PG8_BAR; PG8_MMA(0, 0, At, B0); PG8_MMA(0, 1, At, B1); PG8_BAR; PG8_SCHED;
            PG8_LDA(At, 1, 1); PG8_STAGE(PG8_SB(1, 0), b3, voffB); PG8_STAGE(PG8_SB(1, 1), b3 + hstep, voffB); PG8_STAGE(PG8_SA(1, 0), a3, voffA);
            PG8_WAIT_V(8); PG8_WAIT_L(0); PG8_BAR; PG8_MMA(1, 0, At, B0); PG8_MMA(1, 1, At, B1); PG8_BAR; PG8_SCHED;
            } else {
            PG8_LDB(B0, 0, 0); PG8_SCHED; PG8_LDA(At, 0, 0); PG8_STAGE(PG8_SA(1, 1), a1 + hstep, voffA);
            PG8_WAIT_L(8); PG8_BAR; PG8_WAIT_L(0); PG8_MMA(0, 0, At, B0); PG8_BAR; PG8_SCHED;
            PG8_LDB(B1, 0, 1); PG8_STAGE(PG8_SB(0, 0), b2, voffB);
            PG8_BAR; PG8_WAIT_L(0); PG8_MMA(0, 1, At, B1); PG8_BAR;
            PG8_LDA(At, 0, 1); PG8_STAGE(PG8_SA(0, 0), a2, voffA);
            PG8_BAR; PG8_WAIT_L(0); PG8_MMA(1, 0, At, B0); PG8_BAR; PG8_SCHED;
            PG8_STAGE(PG8_SB(0, 1), b2 + hstep, voffB);
            PG8_WAIT_V(6); PG8_BAR; PG8_MMA(1, 1, At, B1); PG8_BAR;
            PG8_LDB(B0, 1, 0); PG8_SCHED; PG8_LDA(At, 1, 0); PG8_STAGE(PG8_SA(0, 1), a2 + hstep, voffA);
            PG8_WAIT_L(8); PG8_BAR; PG8_WAIT_L(0); PG8_MMA(0, 0, At, B0); PG8_BAR; PG8_SCHED;
            PG8_LDB(B1, 1, 1); PG8_STAGE(PG8_SB(1, 0), b3, voffB);
            PG8_BAR; PG8_WAIT_L(0); PG8_MMA(0, 1, At, B1); PG8_BAR;
            PG8_LDA(At, 1, 1); PG8_STAGE(PG8_SA(1, 0), a3, voffA);
            PG8_BAR; PG8_WAIT_L(0); PG8_MMA(1, 0, At, B0); PG8_BAR; PG8_SCHED;
            PG8_STAGE(PG8_SB(1, 1), b3 + hstep, voffB);
            PG8_WAIT_V(6); PG8_BAR; PG8_MMA(1, 1, At, B1); PG8_BAR;
            }
        }
        if constexpr (ALIGN_EPI) { if (wr == 0) PG8_BAR; }
        if constexpr (!Epi::AFTER_DRAIN) { E(acc, cur, wr, wc, fr, fq); S.done(cur); }
        if (!has_next) break;
        if (!E.keep(cur)) {
#pragma unroll
        for (int a = 0; a < 2; ++a)
#pragma unroll
            for (int b = 0; b < 2; ++b)
#pragma unroll
                for (int m = 0; m < 4; ++m)
#pragma unroll
                    for (int n = 0; n < 2; ++n) acc[a][b][m][n] = (f32x4){0.f, 0.f, 0.f, 0.f};
        }
        cur = nxt; cA = nA; cB = nB; ++ui;
        if constexpr (ALIGN_EPI) { if (wr == 1) PG8_BAR; }
    }
    PG8_WAIT_V(0);
    if constexpr (!ALIGN_EPI) { if (wr == 0) PG8_BAR; }
    PG8_BAR;
    if constexpr (Epi::AFTER_DRAIN) { E.fused(acc, cur, wr, wc, fr, fq, lds, wid, lane); S.done(cur); }
#undef PG8_SA
#undef PG8_SB
#undef PG8_STAGE
#undef PG8_LDA
#undef PG8_LDB
#undef PG8_MMA
#undef PG8_WAIT_V
#undef PG8_WAIT_L
#undef PG8_BAR
#undef PG8_SCHED
}
}

#define GAS __attribute__((address_space(1)))
#define LAS __attribute__((address_space(3)))
typedef unsigned short bf16;
typedef unsigned v4u __attribute__((ext_vector_type(4)));
typedef float f32x4 __attribute__((ext_vector_type(4)));
typedef short bf16x8 __attribute__((ext_vector_type(8)));
typedef GAS unsigned gu32;
typedef GAS unsigned long long gu64;
#define RLX_AGENT __ATOMIC_RELAXED, __HIP_MEMORY_SCOPE_AGENT
#define LDS_WAIT() asm volatile("s_waitcnt lgkmcnt(0)" ::: "memory")
#define VM_WAIT() asm volatile("s_waitcnt vmcnt(0)" ::: "memory")
__device__ __forceinline__ unsigned long long rt() { return __builtin_amdgcn_s_memrealtime(); }
__device__ __forceinline__ unsigned f2bf(float f) { unsigned u = __builtin_bit_cast(unsigned, f); return (u + 0x7fffu + ((u >> 16) & 1u)) >> 16; }
__device__ __forceinline__ unsigned pk2(float lo, float hi) { return f2bf(lo) | (f2bf(hi) << 16); }

#define XB_TMO      128
#define XB_XCNT(j)  (256  + 64 * (j))
#define XB_XSUB(j)  (1280 + 64 * (j))
#define XB_XGEN(j)  (2304 + 64 * (j))
#define XB_TOP      3328
#define XB_TOPGEN   3392
#define XCD_BAR_WORDS 3456
#define XB_SPIN_CAP (1u << 18)

__device__ __forceinline__ unsigned xb_ld(unsigned* p)              { return __hip_atomic_load(p, __ATOMIC_RELAXED, __HIP_MEMORY_SCOPE_AGENT); }
__device__ __forceinline__ unsigned xb_add(unsigned* p, unsigned v) { return __hip_atomic_fetch_add(p, v, __ATOMIC_RELAXED, __HIP_MEMORY_SCOPE_AGENT); }
__device__ __forceinline__ unsigned xb_xcc_id() { return (unsigned)__builtin_amdgcn_s_getreg((3 << 11) | 20) & 0xFu; }
#define XB_SPIN(cond, bar) do { unsigned _sp = 0; while (cond) { __builtin_amdgcn_s_sleep(1); \
    if ((++_sp & 255u) == 0u) { if (xb_ld(&(bar)[XB_TMO])) break; if (_sp > XB_SPIN_CAP) { atomicAdd(&(bar)[XB_TMO], 1u); break; } } } } while (0)

struct XcdBarrier {
    unsigned* bar; unsigned x;
    volatile LAS unsigned* st;
};

__device__ __forceinline__ XcdBarrier xcd_barrier_post(unsigned* bar, volatile LAS unsigned* st) {
    XcdBarrier b; b.bar = bar; b.x = xb_xcc_id(); b.st = st;
    if (threadIdx.x == 0) (void)xb_add(&bar[XB_XCNT(b.x)], 1u);
    return b;
}
__device__ __forceinline__ void xcd_barrier_complete(unsigned* bar, unsigned x, unsigned& nloc, unsigned& nx) {
    const unsigned G = gridDim.x * gridDim.y * gridDim.z;
    unsigned sum, cnt, mine, sp = 0u;
    for (;;) {
        sum = 0u; cnt = 0u; mine = 0u;
#pragma unroll
        for (unsigned j = 0; j < 16; ++j) { const unsigned c = xb_ld(&bar[XB_XCNT(j)]); sum += c; cnt += (c > 0u) ? 1u : 0u; mine = (j == x) ? c : mine; }
        if (sum == G) break;
        __builtin_amdgcn_s_sleep(1);
        if ((++sp & 255u) == 0u) { if (xb_ld(&bar[XB_TMO])) break; if (sp > XB_SPIN_CAP) { atomicAdd(&bar[XB_TMO], 1u); break; } }
    }
    nloc = mine > 0u ? mine : 1u; nx = cnt > 0u ? cnt : 1u;
}

__device__ __forceinline__ void xcd_barrier(const XcdBarrier& b) {
    asm volatile("s_waitcnt vmcnt(0)" ::: "memory");
    __syncthreads();
    if (threadIdx.x == 0) {
        unsigned* bar = b.bar;
        __builtin_amdgcn_s_waitcnt(0);
        unsigned nloc = b.st[0], nx = b.st[1];
        if (nloc == 0u) { xcd_barrier_complete(bar, b.x, nloc, nx); b.st[0] = nloc; b.st[1] = nx; }
        const unsigned old = xb_add(&bar[XB_XSUB(b.x)], 1u);
        const unsigned gen = old / nloc;
        if (old + 1u == (gen + 1u) * nloc) {
            __builtin_amdgcn_fence(__ATOMIC_RELEASE, "agent");
            asm volatile("s_waitcnt vmcnt(0)" ::: "memory");
            const unsigned og = xb_add(&bar[XB_TOP], 1u);
            const unsigned tg = og / nx;
            if (og + 1u == (tg + 1u) * nx) xb_add(&bar[XB_TOPGEN], 1u);
            else XB_SPIN(xb_ld(&bar[XB_TOPGEN]) == tg, bar);
            __builtin_amdgcn_fence(__ATOMIC_ACQUIRE, "agent");
            xb_add(&bar[XB_XGEN(b.x)], 1u);
            asm volatile("s_waitcnt vmcnt(0)" ::: "memory");
        } else {
            XB_SPIN(xb_ld(&bar[XB_XGEN(b.x)]) == gen, bar);
            __builtin_amdgcn_fence(__ATOMIC_ACQUIRE, "agent");
            asm volatile("s_waitcnt vmcnt(0)" ::: "memory");
        }
    }
    __syncthreads();
}
constexpr int NWAVES = 8;
constexpr int DM = 1024, NB = 2, SEQ = 8192, TOK = NB * SEQ;
constexpr int NC_IN = 5400, NPROJ = 5632;
constexpr int NCMP = 511, NSEL = 128, TOPN = 16, NE = 32, FF = 512;
constexpr size_t MiB = 1u << 20;
constexpr size_t WS_CTL = 0, CTL_ZERO_BYTES = 1 * MiB;
constexpr size_t WS_SMALL = 1 * MiB;
constexpr size_t WS_WIN = 2 * MiB;
constexpr size_t WS_WBRN = 13 * MiB, WS_WBRH = 14 * MiB, WS_WOUT = 15 * MiB, WS_WCMP = 17 * MiB;
constexpr size_t WS_WGU = 18 * MiB, WS_WD = 82 * MiB;
constexpr size_t WS_XN = 114 * MiB;
constexpr size_t WS_Q = 146 * MiB, WS_KV = 162 * MiB, WS_HQ = 186 * MiB, WS_HF = 202 * MiB, WS_HI = 234 * MiB, WS_HGS = 250 * MiB, WS_GT = 266 * MiB;
constexpr size_t WS_MISC = 276 * MiB;
constexpr size_t WS_END = 284 * MiB;
constexpr size_t WS_ONSA = 82 * MiB, WS_OHG = 114 * MiB;
constexpr size_t WS_ONSAB = 186 * MiB, WS_OHGB = 202 * MiB, WS_MIX = 218 * MiB;
constexpr int R_PAD = 40960;
constexpr size_t WS_H2S = 146 * MiB, WS_HID = 226 * MiB, WS_YB = 146 * MiB;
constexpr size_t OFF_WRH = 640 * 1024, OFF_WRL = 768 * 1024;
constexpr size_t M_EID = 4 * MiB, M_EW = 4 * MiB + 256 * 1024, M_SLOT = 4 * MiB + 512 * 1024, M_POS = 4 * MiB + 768 * 1024, M_RINV = 5 * MiB, M_RS = 5 * MiB + 256 * 1024;
constexpr int MISC_TP = 16;
constexpr int CW_BAR = 4096;
constexpr int CW_CNT = 16384;
constexpr int SCR_BYTES = 143360;
constexpr int MISC_OFF = SCR_BYTES;
constexpr int LDS_BYTES = 147456;

__device__ __forceinline__ float wave_sum(float v) {
#pragma unroll
    for (int o = 1; o < 64; o <<= 1) v += __shfl_xor(v, o);
    return v;
}
__device__ __forceinline__ float wave_max(float v) {
#pragma unroll
    for (int o = 1; o < 64; o <<= 1) v = fmaxf(v, __shfl_xor(v, o));
    return v;
}
__device__ __forceinline__ float bf2f(bf16 b) { return __builtin_bit_cast(float, (unsigned)b << 16); }
__device__ __forceinline__ float sigmoidf_(float x) { return 1.0f / (1.0f + expf(-x)); }
__device__ __forceinline__ int perm_d(int dp) { return dp < 16 ? ((dp >> 1) + 8 * (dp & 1)) : dp; }
#define WAVE_LDS_FENCE() asm volatile("s_waitcnt lgkmcnt(0)" ::: "memory")

struct Params {
    const float *x, *attn_norm, *w_in, *w_cmp_k, *w_cmp_v, *cmp_pos, *hg_lb, *hg_norm, *w_br_nsa, *w_br_hg, *w_out, *ffn_norm, *w_grp, *b_grp, *w_rtr, *b_rtr, *w_gate, *w_up, *w_down, *final_norm;
    float* out; unsigned char* ws;
};

template <class F> __device__ __forceinline__ void tr_item(F srcf, int K, bf16* WT, int n0, int k0, float* scr, int lane) {
#pragma unroll 8
    for (int i = 0; i < 32; ++i) { const int kk = 2 * i + (lane >> 5); scr[kk * 33 + (lane & 31)] = srcf(k0 + kk, n0 + (lane & 31)); }
    WAVE_LDS_FENCE();
    const int c = lane & 7;
#pragma unroll
    for (int j = 0; j < 4; ++j) { const int n = (lane >> 3) + 8 * j; const float* s = scr + (8 * c) * 33 + n;
        v4u o; o.x = pk2(s[0 * 33], s[1 * 33]); o.y = pk2(s[2 * 33], s[3 * 33]); o.z = pk2(s[4 * 33], s[5 * 33]); o.w = pk2(s[6 * 33], s[7 * 33]);
        *(v4u*)(WT + (size_t)(n0 + n) * K + k0 + 8 * c) = o; }
    WAVE_LDS_FENCE();
}
__device__ __forceinline__ int win_src_col(int n) {
    if (n < 512) return (n & ~63) + perm_d(n & 63);
    if (n < 1280) { const int j = (n - 512) >> 7; const int d = n & 63; return (n & ~63) + ((j == 2 || j == 4) ? perm_d(d) : d); }
    if (n < 5376) return n + 24;
    if (n < 5400) return 1280 + (n - 5376);
    return -1;
}
__device__ __forceinline__ void p0_prologue(const Params& p, unsigned char* lds, int wave, int lane, int gw, int NGW, int gtid, int NGT) {
    float* scr = (float*)(lds + wave * 8448);
    bf16* Win_t = (bf16*)(p.ws + WS_WIN); bf16* Wbrn_t = (bf16*)(p.ws + WS_WBRN); bf16* Wbrh_t = (bf16*)(p.ws + WS_WBRH); bf16* Wout_t = (bf16*)(p.ws + WS_WOUT); bf16* Wcmp_t = (bf16*)(p.ws + WS_WCMP);
    constexpr int I_IN = 16 * (NPROJ / 32), I_BR = 8 * 32, I_OUT = 16 * 32, I_CMP = 32 * 4, I_GU = NE * 16 * 32;
    constexpr int NITEMS = I_IN + 2 * I_BR + I_OUT + I_CMP + I_GU;
    bf16* Wgu_t = (bf16*)(p.ws + WS_WGU);
    for (int it = gw; it < NITEMS; it += NGW) {
        int r = it;
        if (r < I_IN) { const int nblk = NPROJ / 32, kb = r / nblk, nb = r % nblk; const float* W = p.w_in;
            tr_item([W](int k, int n) { const int c = win_src_col(n); return c >= 0 ? W[(size_t)k * NC_IN + c] : 0.0f; }, DM, Win_t, 32 * nb, 64 * kb, scr, lane); continue; }
        r -= I_IN;
        if (r < I_BR) { const int kb = r / 32, nb = r % 32; const float* W = p.w_br_nsa; tr_item([W](int k, int n) { return W[(size_t)k * DM + n]; }, 512, Wbrn_t, 32 * nb, 64 * kb, scr, lane); continue; }
        r -= I_BR;
        if (r < I_BR) { const int kb = r / 32, nb = r % 32; const float* W = p.w_br_hg; tr_item([W](int k, int n) { return W[(size_t)k * DM + n]; }, 512, Wbrh_t, 32 * nb, 64 * kb, scr, lane); continue; }
        r -= I_BR;
        if (r < I_OUT) { const int kb = r / 32, nb = r % 32; const float* W = p.w_out; tr_item([W](int k, int n) { return W[(size_t)k * DM + n]; }, DM, Wout_t, 32 * nb, 64 * kb, scr, lane); continue; }
        r -= I_OUT;
        if (r < I_CMP) { const int kb = r / 4, nb = r % 4; const float* Wk = p.w_cmp_k; const float* Wv = p.w_cmp_v;
          tr_item([Wk, Wv](int k, int n) { return n < 64 ? Wk[(size_t)k * 64 + perm_d(n)] : Wv[(size_t)k * 64 + (n - 64)]; }, 2048, Wcmp_t, 32 * nb, 64 * kb, scr, lane); continue; }
        r -= I_CMP;
        { const int e = r >> 9, rem = r & 511, kb = rem >> 5, nb = rem & 31; const int n0 = 32 * nb, which = (n0 >> 7) & 1, cb = (n0 >> 8) * 128 + (n0 & 127) - n0;
          const float* W = (which ? p.w_up : p.w_gate) + (size_t)e * DM * FF;
          tr_item([W, cb](int k, int n) { return W[(size_t)k * FF + n + cb]; }, DM, Wgu_t + (size_t)e * 1024 * DM, n0, 64 * kb, scr, lane); }
    }
    { bf16* Wh = (bf16*)(p.ws + WS_SMALL + OFF_WRH); bf16* Wl = (bf16*)(p.ws + WS_SMALL + OFF_WRL);
      for (int i = gtid; i < 48 * 1024; i += NGT) { const int c = i >> 10, k = i & 1023; const float w = c < 4 ? p.w_grp[k * 4 + c] : (c < 36 ? p.w_rtr[k * 32 + (c - 4)] : 0.0f);
          const unsigned hi = f2bf(w); Wh[i] = (bf16)hi; Wl[i] = (bf16)f2bf(w - __builtin_bit_cast(float, hi << 16)); } }
    float* lbv = (float*)(p.ws + WS_SMALL); float* rope = (float*)(p.ws + WS_SMALL + 65536);
    for (int i = gtid; i < SEQ * 8; i += NGT) { const int pos = i >> 3, f = i & 7; const float inv = powf(500000.0f, -(float)f / 8.0f); const float ang = (float)pos * inv; float sn, cs; sincosf(ang, &sn, &cs); rope[2 * i] = cs; rope[2 * i + 1] = sn; }
    if (gtid < 512) { const float l0 = p.hg_lb[gtid], l1 = p.hg_lb[512 + gtid]; const float m = fmaxf(l0, l1); const float e0 = expf(l0 - m), e1 = expf(l1 - m); lbv[gtid] = e0 / (e0 + e1); }
    bf16* XN = (bf16*)(p.ws + WS_XN);
    for (int m = gw; m < TOK; m += NGW) {
        const f32x4* xr = (const f32x4*)(p.x + (size_t)m * DM) + lane; const f32x4* gr = (const f32x4*)p.attn_norm + lane;
        f32x4 v[4]; float s = 0.f;
#pragma unroll
        for (int j = 0; j < 4; ++j) { v[j] = xr[64 * j]; s += (v[j].x * v[j].x + v[j].y * v[j].y) + (v[j].z * v[j].z + v[j].w * v[j].w); }
        const float r = 1.0f / sqrtf(wave_sum(s) * (1.0f / DM) + 1e-6f);
        unsigned long long* o8 = (unsigned long long*)(XN + (size_t)m * DM) + lane;
#pragma unroll
        for (int j = 0; j < 4; ++j) { const f32x4 g = gr[64 * j]; o8[64 * j] = (unsigned long long)pk2(v[j].x * r * g.x, v[j].y * r * g.y) | ((unsigned long long)pk2(v[j].z * r * g.z, v[j].w * r * g.w) << 32); }
    }
}

__device__ __forceinline__ void s_compress(const Params& p, int lane, int gw, int NGW) {
    const bf16* KV = (const bf16*)(p.ws + WS_KV); const float* rope = (const float*)(p.ws + WS_SMALL + 65536);
    float* kc = (float*)(p.ws + WS_MISC + 2 * MiB); float* vc = (float*)(p.ws + WS_MISC + 3 * MiB);
    for (int it = gw; it < NB * NCMP * 4; it += NGW) {
        const int j = it & 1, g = (it >> 1) & 1, bn = it >> 2, b = bn / NCMP, n = bn % NCMP;
        const float* W = j == 0 ? p.w_cmp_k : p.w_cmp_v; const int sc = j == 0 ? perm_d(lane) : lane;
        float acc = 0.f;
        for (int l = 0; l < 32; ++l) {
            const bf16* src = KV + (size_t)(b * SEQ + 16 * n + l) * 768 + j * 128 + g * 64;
            for (int d = 0; d < 64; ++d) acc = fmaf(bf2f(src[d]) + p.cmp_pos[l * 64 + d], W[(size_t)(l * 64 + d) * 64 + sc], acc);
        }
        if (j == 0) { const float other = __shfl_xor(acc, 1);
            if (lane < 16) { const int i = lane >> 1; const float cs = rope[(size_t)(16 * n) * 16 + 2 * i], sn = rope[(size_t)(16 * n) * 16 + 2 * i + 1];
                acc = (lane & 1) ? (acc * cs + other * sn) : (acc * cs - other * sn); }
            kc[((size_t)(b * NCMP + n) * 2 + g) * 64 + lane] = acc;
        } else vc[((size_t)(b * NCMP + n) * 2 + g) * 64 + lane] = acc;
    }
}
__device__ __forceinline__ void s_cmp_attn(const Params& p, unsigned char* lds, int wave, int lane, int gw, int NGW) {
    float* wl = (float*)(lds + wave * 17472); float* qs = wl; float* pp = wl + 256; float* sc = pp + 4 * 512;
    const bf16* Q = (const bf16*)(p.ws + WS_Q); const float* GT = (const float*)(p.ws + WS_GT);
    const float* kc = (const float*)(p.ws + WS_MISC + 2 * MiB); const float* vc = (const float*)(p.ws + WS_MISC + 3 * MiB);
    float* onsa = (float*)(p.ws + WS_ONSA); int* selidx = (int*)(p.ws + WS_MISC);
    for (int it = gw; it < TOK * 2; it += NGW) {
        const int g = it & 1, m = it >> 1, b = m >> 13, s = m & 8191;
        WAVE_LDS_FENCE();
#pragma unroll
        for (int r = 0; r < 4; ++r) qs[r * 64 + lane] = bf2f(Q[(size_t)m * 512 + (g * 4 + r) * 64 + lane]);
        WAVE_LDS_FENCE();
        const int nvalid = s >= 31 ? (s - 31) / 16 + 1 : 0;
        float mx[4] = {-3.0e38f, -3.0e38f, -3.0e38f, -3.0e38f};
        for (int n = lane; n < nvalid; n += 64) {
            const float* kp = kc + ((size_t)(b * NCMP + n) * 2 + g) * 64;
            float d0 = 0.f, d1 = 0.f, d2 = 0.f, d3 = 0.f;
            for (int d = 0; d < 64; ++d) { const float kv = kp[d]; d0 = fmaf(qs[d], kv, d0); d1 = fmaf(qs[64 + d], kv, d1); d2 = fmaf(qs[128 + d], kv, d2); d3 = fmaf(qs[192 + d], kv, d3); }
            pp[n] = d0; pp[512 + n] = d1; pp[1024 + n] = d2; pp[1536 + n] = d3;
            mx[0] = fmaxf(mx[0], d0); mx[1] = fmaxf(mx[1], d1); mx[2] = fmaxf(mx[2], d2); mx[3] = fmaxf(mx[3], d3);
        }
        float sm[4];
#pragma unroll
        for (int r = 0; r < 4; ++r) { mx[r] = wave_max(mx[r]); float a = 0.f; for (int n = lane; n < nvalid; n += 64) { const float e = expf(pp[r * 512 + n] - mx[r]); pp[r * 512 + n] = e; a += e; } sm[r] = wave_sum(a); }
#pragma unroll
        for (int r = 0; r < 4; ++r) { const float inv = nvalid > 0 ? 1.0f / sm[r] : 0.f; for (int n = lane; n < nvalid; n += 64) pp[r * 512 + n] *= inv; }
        WAVE_LDS_FENCE();
        float o[4] = {0.f, 0.f, 0.f, 0.f};
        for (int n = 0; n < nvalid; ++n) { const float v = vc[((size_t)(b * NCMP + n) * 2 + g) * 64 + lane]; o[0] = fmaf(pp[n], v, o[0]); o[1] = fmaf(pp[512 + n], v, o[1]); o[2] = fmaf(pp[1024 + n], v, o[2]); o[3] = fmaf(pp[1536 + n], v, o[3]); }
#pragma unroll
        for (int r = 0; r < 4; ++r) { const int h = g * 4 + r; onsa[(size_t)m * 512 + h * 64 + lane] = GT[(size_t)m * 24 + h * 3 + 0] * o[r]; }
        const int jc = s >> 6;
        for (int j = lane; j < NSEL; j += 64) {
            float imp = 0.f;
            for (int n = 4 * j - 1; n <= 4 * j + 3; ++n) if (n >= 0 && n < nvalid) imp += (pp[n] + pp[512 + n]) + (pp[1024 + n] + pp[1536 + n]);
            float v; if (j == jc || j == 0) v = 1.0e4f; else if (64 * j <= s) v = imp; else v = -1.0f;
            sc[j] = v;
        }
        WAVE_LDS_FENCE();
        float v0 = sc[lane], v1 = sc[lane + 64];
        for (int k = 0; k < TOPN; ++k) {
            float bv; int bi;
            if (v0 >= v1) { bv = v0; bi = lane; } else { bv = v1; bi = lane + 64; }
#pragma unroll
            for (int o2 = 1; o2 < 64; o2 <<= 1) { const float ov = __shfl_xor(bv, o2); const int oi = __shfl_xor(bi, o2); if (ov > bv || (ov == bv && oi < bi)) { bv = ov; bi = oi; } }
            if (lane == 0) selidx[(size_t)it * TOPN + k] = bi;
            if (bi == lane) v0 = -3.0e38f; if (bi == lane + 64) v1 = -3.0e38f;
        }
    }
}
template <int MODE> __device__ __forceinline__ void s_sparse_attn(const Params& p, unsigned char* lds, int wave, int lane, int gw, int NGW) {
    float* wl = (float*)(lds + wave * 17472); float* qs = wl; float* pp = wl + 256; int* sel = (int*)(pp + 4 * 1024);
    const bf16* Q = (const bf16*)(p.ws + WS_Q); const bf16* KV = (const bf16*)(p.ws + WS_KV); const float* GT = (const float*)(p.ws + WS_GT);
    float* onsa = (float*)(p.ws + WS_ONSA); const int* selidx = (const int*)(p.ws + WS_MISC);
    constexpr int NCH = MODE == 0 ? 16 : 8; constexpr int KJ = MODE == 0 ? 2 : 4;
    for (int it = gw; it < TOK * 2; it += NGW) {
        const int g = it & 1, m = it >> 1, b = m >> 13, s = m & 8191;
        WAVE_LDS_FENCE();
#pragma unroll
        for (int r = 0; r < 4; ++r) qs[r * 64 + lane] = bf2f(Q[(size_t)m * 512 + (g * 4 + r) * 64 + lane]);
        if (MODE == 0 && lane < 16) sel[lane] = selidx[(size_t)it * TOPN + lane];
        WAVE_LDS_FENCE();
        float mx[4] = {-3.0e38f, -3.0e38f, -3.0e38f, -3.0e38f};
        for (int c = 0; c < NCH; ++c) {
            int kpos; bool valid;
            if (MODE == 0) { kpos = sel[c] * 64 + lane; valid = kpos <= s; } else { kpos = s - 511 + c * 64 + lane; valid = kpos >= 0; }
            const int idx = c * 64 + lane;
            if (valid) {
                const bf16* kp = KV + (size_t)(b * SEQ + kpos) * 768 + KJ * 128 + g * 64;
                float d0 = 0.f, d1 = 0.f, d2 = 0.f, d3 = 0.f;
                for (int d = 0; d < 64; ++d) { const float kv = bf2f(kp[d]); d0 = fmaf(qs[d], kv, d0); d1 = fmaf(qs[64 + d], kv, d1); d2 = fmaf(qs[128 + d], kv, d2); d3 = fmaf(qs[192 + d], kv, d3); }
                pp[idx] = d0; pp[1024 + idx] = d1; pp[2048 + idx] = d2; pp[3072 + idx] = d3;
                mx[0] = fmaxf(mx[0], d0); mx[1] = fmaxf(mx[1], d1); mx[2] = fmaxf(mx[2], d2); mx[3] = fmaxf(mx[3], d3);
            }
        }
        float sm[4];
#pragma unroll
        for (int r = 0; r < 4; ++r) { mx[r] = wave_max(mx[r]); float a = 0.f;
            for (int c = 0; c < NCH; ++c) { const int idx = c * 64 + lane; int kpos; bool valid;
                if (MODE == 0) { kpos = sel[c] * 64 + lane; valid = kpos <= s; } else { kpos = s - 511 + c * 64 + lane; valid = kpos >= 0; }
                float e = 0.f; if (valid) e = expf(pp[r * 1024 + idx] - mx[r]); pp[r * 1024 + idx] = e; a += e; }
            sm[r] = wave_sum(a); }
        WAVE_LDS_FENCE();
        float o[4] = {0.f, 0.f, 0.f, 0.f};
        for (int i = 0; i < NCH * 64; ++i) { int kpos; if (MODE == 0) kpos = sel[i >> 6] * 64 + (i & 63); else kpos = s - 511 + i;
            if (kpos < 0 || kpos > s) continue;
            const float v = bf2f(KV[(size_t)(b * SEQ + kpos) * 768 + (KJ + 1) * 128 + g * 64 + lane]);
            o[0] = fmaf(pp[i], v, o[0]); o[1] = fmaf(pp[1024 + i], v, o[1]); o[2] = fmaf(pp[2048 + i], v, o[2]); o[3] = fmaf(pp[3072 + i], v, o[3]); }
#pragma unroll
        for (int r = 0; r < 4; ++r) { const int h = g * 4 + r; const size_t oi = (size_t)m * 512 + h * 64 + lane; const float val = onsa[oi] + GT[(size_t)m * 24 + h * 3 + (MODE == 0 ? 1 : 2)] * o[r] / sm[r];
            if (MODE == 0) onsa[oi] = val; else ((bf16*)(p.ws + WS_ONSAB))[oi] = (bf16)f2bf(val); }
    }
}
__device__ __forceinline__ void s_hgrn(const Params& p, unsigned char* lds, int tid, int item) {
    float* qf = (float*)lds; float* ff = qf + 16 * 128; float* vv = ff + 16 * 128;
    const bf16* HQ = (const bf16*)(p.ws + WS_HQ); const float* HF = (const float*)(p.ws + WS_HF); const bf16* HI = (const bf16*)(p.ws + WS_HI); float* ohg = (float*)(p.ws + WS_OHG);
    const int b = item >> 2, hh = item & 3, j = tid >> 2, kq = tid & 3;
    float St[32];
#pragma unroll
    for (int i = 0; i < 32; ++i) St[i] = 0.f;
    for (int s0 = 0; s0 < SEQ; s0 += 16) {
        __syncthreads();
        for (int e = tid; e < 16 * 128; e += 512) { const int tt = e >> 7, k = e & 127; const size_t ro = (size_t)(b * SEQ + s0 + tt) * 512 + hh * 128 + k;
            qf[e] = bf2f(HQ[ro]); ff[e] = expf(HF[ro]); vv[e] = bf2f(HI[ro]); }
        __syncthreads();
        for (int tt = 0; tt < 16; ++tt) {
            const float v = vv[tt * 128 + j]; float o = 0.f;
#pragma unroll
            for (int i = 0; i < 32; ++i) { const int k = kq * 32 + i; const float f = ff[tt * 128 + k]; St[i] = fmaf(f, St[i], (1.0f - f) * v); o = fmaf(qf[tt * 128 + k], St[i], o); }
            o += __shfl_xor(o, 1); o += __shfl_xor(o, 2);
            if (kq == 0) ohg[(size_t)(b * SEQ + s0 + tt) * 512 + hh * 128 + j] = o;
        }
    }
    __syncthreads();
}
__device__ __forceinline__ void s_hg_post(const Params& p, int lane, int gw, int NGW) {
    float* ohg = (float*)(p.ws + WS_OHG); const bf16* HGs = (const bf16*)(p.ws + WS_HGS);
    for (int w = gw; w < TOK * 4; w += NGW) { const int m = w >> 2, hh = w & 3; float* o = ohg + (size_t)m * 512 + hh * 128;
        const float a = o[lane], b = o[lane + 64]; const float r = 1.0f / sqrtf(wave_sum(a * a + b * b) * (1.0f / 128.0f) + 1e-6f);
        const bf16* gr = HGs + (size_t)m * 512 + hh * 128;
        bf16* ob = (bf16*)(p.ws + WS_OHGB) + (size_t)m * 512 + hh * 128;
        ob[lane] = (bf16)f2bf(a * r * p.hg_norm[lane] * bf2f(gr[lane])); ob[lane + 64] = (bf16)f2bf(b * r * p.hg_norm[lane + 64] * bf2f(gr[lane + 64])); }
}
typedef short bf16x8_t __attribute__((ext_vector_type(8)));
__device__ __forceinline__ void f_router(const Params& p, unsigned char* lds, int wave, int lane, int gw, int NGW) {
    { float* scr = (float*)(lds + wave * 8448); bf16* Wd_t = (bf16*)(p.ws + WS_WD);
      for (int r = gw; r < NE * 8 * 32; r += NGW) { const int e = r >> 8, rem = r & 255, kb = rem >> 5, nb = rem & 31; const float* W = p.w_down + (size_t)e * FF * DM;
          tr_item([W](int k, int n) { return W[(size_t)k * DM + n]; }, FF, Wd_t + (size_t)e * DM * FF, 32 * nb, 64 * kb, scr, lane); } }
    __syncthreads();
    float* lg = (float*)(lds + wave * 4096); float* rr = lg + 16 * 48;
    const bf16* Wh = (const bf16*)(p.ws + WS_SMALL + OFF_WRH); const bf16* Wl = (const bf16*)(p.ws + WS_SMALL + OFF_WRL);
    int* eid = (int*)(p.ws + WS_MISC + M_EID); float* ew = (float*)(p.ws + WS_MISC + M_EW); int* slot = (int*)(p.ws + WS_MISC + M_SLOT); float* rinv = (float*)(p.ws + WS_MISC + M_RINV);
    int* cnt = (int*)(p.ws + WS_CTL) + CW_CNT;
    const int row = lane & 15, kq = lane >> 4;
    for (int it = gw; it < TOK / 16; it += NGW) {
        const int m0 = it * 16; const float* xr = p.out + (size_t)(m0 + row) * DM;
        f32x4 acc[3]; acc[0] = (f32x4){0.f, 0.f, 0.f, 0.f}; acc[1] = acc[0]; acc[2] = acc[0]; float ss = 0.f;
        for (int s = 0; s < 32; ++s) { const int k0 = 32 * s + 8 * kq;
            const f32x4 x0 = *(const f32x4*)(xr + k0), x1 = *(const f32x4*)(xr + k0 + 4); const f32x4 g0 = *(const f32x4*)(p.ffn_norm + k0), g1 = *(const f32x4*)(p.ffn_norm + k0 + 4);
            ss += (x0.x * x0.x + x0.y * x0.y) + (x0.z * x0.z + x0.w * x0.w) + (x1.x * x1.x + x1.y * x1.y) + (x1.z * x1.z + x1.w * x1.w);
            const f32x4 y0 = x0 * g0, y1 = x1 * g1; bf16x8_t ah, al;
#pragma unroll
            for (int j = 0; j < 4; ++j) { unsigned h = f2bf(y0[j]); ah[j] = (short)h; al[j] = (short)f2bf(y0[j] - __builtin_bit_cast(float, h << 16)); h = f2bf(y1[j]); ah[4 + j] = (short)h; al[4 + j] = (short)f2bf(y1[j] - __builtin_bit_cast(float, h << 16)); }
#pragma unroll
            for (int ct = 0; ct < 3; ++ct) { const bf16x8_t bh = *(const bf16x8_t*)(Wh + (size_t)(16 * ct + row) * DM + k0), bl = *(const bf16x8_t*)(Wl + (size_t)(16 * ct + row) * DM + k0);
                acc[ct] = __builtin_amdgcn_mfma_f32_16x16x32_bf16(ah, bh, acc[ct], 0, 0, 0); acc[ct] = __builtin_amdgcn_mfma_f32_16x16x32_bf16(ah, bl, acc[ct], 0, 0, 0); acc[ct] = __builtin_amdgcn_mfma_f32_16x16x32_bf16(al, bh, acc[ct], 0, 0, 0); } }
        ss += __shfl_xor(ss, 16); ss += __shfl_xor(ss, 32);
        const float ri = 1.0f / sqrtf(ss * (1.0f / DM) + 1e-6f);
        WAVE_LDS_FENCE();
        if (kq == 0) rr[row] = ri;
#pragma unroll
        for (int ct = 0; ct < 3; ++ct)
#pragma unroll
            for (int e = 0; e < 4; ++e) lg[(4 * kq + e) * 48 + 16 * ct + row] = acc[ct][e];
        WAVE_LDS_FENCE();
        if (lane < 16) { const int m = m0 + lane; const float rv = rr[lane]; const float* L = lg + lane * 48;
            float gl[4]; int gs = 0;
#pragma unroll
            for (int i = 0; i < 4; ++i) gl[i] = L[i] * rv + p.b_grp[i];
            float gm = gl[0];
#pragma unroll
            for (int i = 1; i < 4; ++i) if (gl[i] > gm) { gm = gl[i]; gs = i; }
            float den = 0.f;
#pragma unroll
            for (int i = 0; i < 4; ++i) den += expf(gl[i] - gm);
            const float gp = 1.0f / den;
            float el[8];
#pragma unroll
            for (int i = 0; i < 8; ++i) el[i] = L[4 + gs * 8 + i] * rv + p.b_rtr[gs * 8 + i];
            int i0 = 0; float b0 = el[0];
#pragma unroll
            for (int i = 1; i < 8; ++i) if (el[i] > b0) { b0 = el[i]; i0 = i; }
            int i1 = -1; float b1 = -3.0e38f;
#pragma unroll
            for (int i = 0; i < 8; ++i) if (i != i0 && el[i] > b1) { b1 = el[i]; i1 = i; }
            const float e1 = expf(b1 - b0); const float w0 = 1.0f / (1.0f + e1), w1 = e1 / (1.0f + e1);
            const int ea = gs * 8 + i0, eb = gs * 8 + i1;
            eid[m * 2] = ea; eid[m * 2 + 1] = eb; ew[m * 2] = w0 * gp; ew[m * 2 + 1] = w1 * gp; rinv[m] = rv;
            slot[m * 2] = atomicAdd(&cnt[ea], 1); slot[m * 2 + 1] = atomicAdd(&cnt[eb], 1); }
    }
}
__device__ __forceinline__ void f_fill(const Params& p, volatile LAS unsigned* MISC, int tid, int lane, int gw, int NGW) {
    const int* cnt = (const int*)(p.ws + WS_CTL) + CW_CNT;
    if (tid == 0) { unsigned a = 0; for (int q = 0; q < NE; ++q) { MISC[MISC_TP + q] = a; a += ((unsigned)__hip_atomic_load(cnt + q, __ATOMIC_RELAXED, __HIP_MEMORY_SCOPE_AGENT) + 255u) >> 8; } MISC[MISC_TP + NE] = a; }
    __syncthreads();
    const int* eid = (const int*)(p.ws + WS_MISC + M_EID); const int* slot = (const int*)(p.ws + WS_MISC + M_SLOT); int* pos = (int*)(p.ws + WS_MISC + M_POS);
    const float* rinv = (const float*)(p.ws + WS_MISC + M_RINV); float* rs = (float*)(p.ws + WS_MISC + M_RS); bf16* H2S = (bf16*)(p.ws + WS_H2S);
    for (int m = gw; m < TOK; m += NGW) {
        const int ra = (int)MISC[MISC_TP + eid[2 * m]] * 256 + slot[2 * m], rb = (int)MISC[MISC_TP + eid[2 * m + 1]] * 256 + slot[2 * m + 1];
        if (lane == 0) { pos[2 * m] = ra; pos[2 * m + 1] = rb; const float rv = rinv[m]; rs[ra] = rv; rs[rb] = rv; }
        const f32x4* xr = (const f32x4*)(p.out + (size_t)m * DM) + lane; const f32x4* gr = (const f32x4*)p.ffn_norm + lane;
        unsigned long long* oa = (unsigned long long*)(H2S + (size_t)ra * DM) + lane; unsigned long long* ob = (unsigned long long*)(H2S + (size_t)rb * DM) + lane;
#pragma unroll
        for (int j = 0; j < 4; ++j) { const f32x4 v = xr[64 * j] * gr[64 * j]; const unsigned long long w = (unsigned long long)pk2(v.x, v.y) | ((unsigned long long)pk2(v.z, v.w) << 32); oa[64 * j] = w; ob[64 * j] = w; }
    }
}
__device__ __forceinline__ void f_final(const Params& p, int lane, int gw, int NGW) {
    const bf16* Y = (const bf16*)(p.ws + WS_YB); const int* eid = (const int*)(p.ws + WS_MISC + M_EID); const float* ew = (const float*)(p.ws + WS_MISC + M_EW); const int* pos = (const int*)(p.ws + WS_MISC + M_POS);
    for (int t = gw; t < TOK; t += NGW) {
        int a = 0, b = 1; if (eid[t * 2 + 1] < eid[t * 2]) { a = 1; b = 0; }
        const float wa = ew[t * 2 + a], wb = ew[t * 2 + b];
        const unsigned long long* ya = (const unsigned long long*)(Y + (size_t)pos[t * 2 + a] * DM) + lane; const unsigned long long* yb = (const unsigned long long*)(Y + (size_t)pos[t * 2 + b] * DM) + lane;
        f32x4* xr = (f32x4*)(p.out + (size_t)t * DM) + lane; const f32x4* gr = (const f32x4*)p.final_norm + lane;
        f32x4 v[4]; float s = 0.f;
#pragma unroll
        for (int j = 0; j < 4; ++j) { const unsigned long long qa = ya[64 * j], qb = yb[64 * j]; const unsigned a0 = (unsigned)qa, a1 = (unsigned)(qa >> 32), b0 = (unsigned)qb, b1 = (unsigned)(qb >> 32);
            f32x4 fa, fb; fa.x = __builtin_bit_cast(float, a0 << 16); fa.y = __builtin_bit_cast(float, a0 & 0xffff0000u); fa.z = __builtin_bit_cast(float, a1 << 16); fa.w = __builtin_bit_cast(float, a1 & 0xffff0000u);
            fb.x = __builtin_bit_cast(float, b0 << 16); fb.y = __builtin_bit_cast(float, b0 & 0xffff0000u); fb.z = __builtin_bit_cast(float, b1 << 16); fb.w = __builtin_bit_cast(float, b1 & 0xffff0000u);
            v[j] = xr[64 * j] + (fa * wa + fb * wb); s += (v[j].x * v[j].x + v[j].y * v[j].y) + (v[j].z * v[j].z + v[j].w * v[j].w); }
        const float r = 1.0f / sqrtf(wave_sum(s) * (1.0f / DM) + 1e-6f);
#pragma unroll
        for (int j = 0; j < 4; ++j) { const f32x4 g = gr[64 * j]; f32x4 w; w.x = v[j].x * r * g.x; w.y = v[j].y * r * g.y; w.z = v[j].z * r * g.z; w.w = v[j].w * r * g.w; xr[64 * j] = w; }
    }
}

struct Args { Params p; int pad0, pad1; };
__global__ void __launch_bounds__(NWAVES * 64, 2) mk_fwd(Args args) {
    extern __shared__ __attribute__((aligned(16))) unsigned char lds[];
    const Params& p = args.p;
    const int tid = threadIdx.x, lane = tid & 63, wave = __builtin_amdgcn_readfirstlane(tid >> 6);
    const int G = gridDim.x; const int bx = blockIdx.x; const int vcu = (G % 8 == 0) ? (bx % 8) * (G / 8) + bx / 8 : bx;
    const int gw = vcu * NWAVES + wave, NGW = G * NWAVES, gtid = bx * (NWAVES * 64) + tid, NGT = G * NWAVES * 64;
    volatile LAS unsigned* MISC = (volatile LAS unsigned*)((LAS unsigned char*)lds + MISC_OFF);
    for (int u = tid; u < (LDS_BYTES - MISC_OFF) / 4; u += NWAVES * 64) ((LAS unsigned*)((LAS unsigned char*)lds + MISC_OFF))[u] = 0u;
    __syncthreads();
    gu32* ctl = (gu32*)(p.ws + WS_CTL);
    XcdBarrier bar = xcd_barrier_post((unsigned*)(ctl + CW_BAR), MISC + 8);
#define GRID_BAR() xcd_barrier(bar)

    p0_prologue(p, lds, wave, lane, gw, NGW, gtid, NGT);
    GRID_BAR();
    {
        pg8::Gemm g{(const pg8::bf16_t*)(p.ws + WS_XN), (const pg8::bf16_t*)(p.ws + WS_WIN), TOK, NPROJ, DM, nullptr, nullptr}; pg8::StaticOrder S; S.init(TOK, NPROJ, G, bx);
        pg8::EpiProj E{(pg8::bf16_t*)(p.ws + WS_Q), (pg8::bf16_t*)(p.ws + WS_KV), (pg8::bf16_t*)(p.ws + WS_HQ), (pg8::bf16_t*)(p.ws + WS_HI), (pg8::bf16_t*)(p.ws + WS_HGS), (pg8::bf16_t*)p.out,
                       (float*)(p.ws + WS_HF), (float*)(p.ws + WS_GT), (const float*)(p.ws + WS_SMALL), (const float*)(p.ws + WS_SMALL + 65536)};
        pg8::gemm_phase<pg8::EpiProj, pg8::StaticOrder, true, true>((LAS unsigned char*)lds, g, S, E);
    }
    GRID_BAR();
    s_compress(p, lane, gw, NGW);
    GRID_BAR();
    if (bx < 8) s_hgrn(p, lds, tid, bx);
    s_cmp_attn(p, lds, wave, lane, gw, NGW);
    GRID_BAR();
    s_sparse_attn<0>(p, lds, wave, lane, gw, NGW);
    GRID_BAR();
    s_sparse_attn<1>(p, lds, wave, lane, gw, NGW);
    s_hg_post(p, lane, gw, NGW);
    GRID_BAR();
    {
        pg8::Gemm g{(const pg8::bf16_t*)(p.ws + WS_ONSAB), (const pg8::bf16_t*)(p.ws + WS_WBRN), TOK, DM, 512, (const pg8::bf16_t*)(p.ws + WS_OHGB), (const pg8::bf16_t*)(p.ws + WS_WBRH)};
        pg8::MergeOrder S; S.init(TOK, DM, G, bx); pg8::EpiMerge E{(const pg8::bf16_t*)p.out, (pg8::bf16_t*)(p.ws + WS_MIX)};
        pg8::gemm_phase<pg8::EpiMerge, pg8::MergeOrder, true, true>((LAS unsigned char*)lds, g, S, E);
    }
    GRID_BAR();
    {
        pg8::Gemm g{(const pg8::bf16_t*)(p.ws + WS_MIX), (const pg8::bf16_t*)(p.ws + WS_WOUT), TOK, DM, DM, nullptr, nullptr};
        pg8::StaticOrder S; S.init(TOK, DM, G, bx); pg8::EpiOut E{p.x, p.out};
        pg8::gemm_phase<pg8::EpiOut, pg8::StaticOrder, true, true>((LAS unsigned char*)lds, g, S, E);
    }
    GRID_BAR();
    f_router(p, lds, wave, lane, gw, NGW);
    GRID_BAR();
    f_fill(p, MISC, tid, lane, gw, NGW);
    GRID_BAR();
    {
        pg8::MoeOrder S{(const volatile PG8_LAS int*)(MISC + MISC_TP), G, bx};
        { pg8::Gemm g{(const pg8::bf16_t*)(p.ws + WS_H2S), (const pg8::bf16_t*)(p.ws + WS_WGU), R_PAD, NE * 1024, DM, nullptr, nullptr};
          pg8::EpiGU E{(const float*)(p.ws + WS_MISC + M_RS), (pg8::bf16_t*)(p.ws + WS_HID)};
          pg8::gemm_phase<pg8::EpiGU, pg8::MoeOrder, true, true>((LAS unsigned char*)lds, g, S, E); }
        GRID_BAR();
        { pg8::Gemm g{(const pg8::bf16_t*)(p.ws + WS_HID), (const pg8::bf16_t*)(p.ws + WS_WD), R_PAD, NE * 1024, FF, nullptr, nullptr};
          pg8::EpiDown E{(pg8::bf16_t*)(p.ws + WS_YB)};
          pg8::gemm_phase<pg8::EpiDown, pg8::MoeOrder, true, true>((LAS unsigned char*)lds, g, S, E); }
    }
    GRID_BAR();
    f_final(p, lane, gw, NGW);
}

extern "C" void kernel_launch(void* const* d_in, const int* in_sizes, int n_in, void* d_out, int out_size, void* d_ws, size_t ws_size, hipStream_t stream) {
    static int grid = 0;
    if (grid == 0) {
        if (n_in != 20 || out_size != TOK * DM || ws_size < WS_END) { fprintf(stderr, "kernel_launch: unexpected problem (n_in %d, out %d, ws %zu)\n", n_in, out_size, ws_size); grid = -1; return; }
        int dev = 0, cus = 0, per_cu = 0;
        if (hipGetDevice(&dev) != hipSuccess || hipDeviceGetAttribute(&cus, hipDeviceAttributeMultiprocessorCount, dev) != hipSuccess) { grid = -1; return; }
        if (hipFuncSetAttribute((const void*)mk_fwd, hipFuncAttributeMaxDynamicSharedMemorySize, LDS_BYTES) != hipSuccess) { fprintf(stderr, "kernel_launch: hipFuncSetAttribute failed\n"); grid = -1; return; }
        if (hipOccupancyMaxActiveBlocksPerMultiprocessor(&per_cu, (const void*)mk_fwd, NWAVES * 64, LDS_BYTES) != hipSuccess || per_cu < 1) { fprintf(stderr, "kernel_launch: occupancy query says %d\n", per_cu); }
        (void)hipGetLastError();
        grid = cus;
    }
    if (grid < 0) return;
    if (hipMemsetAsync((char*)d_ws + WS_CTL, 0, CTL_ZERO_BYTES, stream) != hipSuccess) { fprintf(stderr, "kernel_launch: memset failed\n"); return; }
    Args a{};
    Params& p = a.p;
    p.x = (const float*)d_in[0]; p.attn_norm = (const float*)d_in[1]; p.w_in = (const float*)d_in[2]; p.w_cmp_k = (const float*)d_in[3]; p.w_cmp_v = (const float*)d_in[4]; p.cmp_pos = (const float*)d_in[5];
    p.hg_lb = (const float*)d_in[6]; p.hg_norm = (const float*)d_in[7]; p.w_br_nsa = (const float*)d_in[8]; p.w_br_hg = (const float*)d_in[9]; p.w_out = (const float*)d_in[10]; p.ffn_norm = (const float*)d_in[11];
    p.w_grp = (const float*)d_in[12]; p.b_grp = (const float*)d_in[13]; p.w_rtr = (const float*)d_in[14]; p.b_rtr = (const float*)d_in[15]; p.w_gate = (const float*)d_in[16]; p.w_up = (const float*)d_in[17];
    p.w_down = (const float*)d_in[18]; p.final_norm = (const float*)d_in[19]; p.out = (float*)d_out; p.ws = (unsigned char*)d_ws;
    hipLaunchKernelGGL(mk_fwd, dim3(grid), dim3(NWAVES * 64), LDS_BYTES, stream, a);
}
```

```cpp
#include <hip/hip_runtime.h>
#include <cstdio>
#include <cstdint>
namespace pg8 {
#define PG8_LAS __attribute__((address_space(3)))
typedef unsigned short bf16_t;
typedef short bf16x8 __attribute__((ext_vector_type(8)));
typedef float f32x4 __attribute__((ext_vector_type(4)));
typedef unsigned u32x4 __attribute__((ext_vector_type(4)));
constexpr int BM = 256, BK = 64, HALF = 128, HTB = HALF * BK * 2  , STAGE_BYTES = 8 * HTB, NXCD = 8, WGM = 8;

__host__ __device__ __forceinline__ int lds_byte(int r, int c) { const int st = (r >> 4) * 2 + (c >> 5), rr = r & 15, cc = c & 31, ob = rr * 64 + cc * 2; return st * 1024 + (ob ^ (((ob >> 9) & 1) << 5)); }
__host__ __device__ __forceinline__ void stage_rc(int b, int& R, int& C) { const int st = b / 1024, sb = b % 1024, swz = sb ^ (((sb >> 9) & 1) << 5); R = (st >> 1) * 16 + swz / 64; C = (st & 1) * 32 + (swz % 64) / 2; }
__host__ __device__ __forceinline__ int perm32(int rho) { const int n = rho >> 4, i = rho & 15; return 8 * (i >> 2) + 4 * n + (i & 3); }

struct Unit { int pm, pn, sel; };
struct Gemm { const bf16_t* A; const bf16_t* Bt; int M, N, K; const bf16_t* A2; const bf16_t* Bt2; };

struct StaticOrder {
    int nM, nN, nwg, G, c;
    __host__ __device__ void init(int M, int N, int G_, int c_) { nM = M / BM; nN = N / BM; nwg = nM * nN; G = G_; c = c_; }
    __host__ __device__ bool next(int i, Unit& u) const {
        const long L = (long)i * G + c; if (L >= nwg) return false;
        int wgid = (int)L; { const int q = nwg / NXCD, r = nwg % NXCD, xcd = wgid % NXCD, off = wgid / NXCD; wgid = (xcd < r ? xcd * (q + 1) : r * (q + 1) + (xcd - r) * q) + off; }
        const int nig = WGM * nN, gid = wgid / nig, fm = gid * WGM, gsz = (nM - fm) < WGM ? (nM - fm) : WGM;
        u.pm = fm + ((wgid % nig) % gsz); u.pn = (wgid % nig) / gsz; u.sel = 0; return true;
    }
    __device__ __forceinline__ void a_ready(const Unit&) const {}
    __device__ __forceinline__ void done(const Unit&) const {}
};

__device__ __forceinline__ unsigned cvt_pk_bf16(float lo, float hi) { unsigned r; asm volatile("v_cvt_pk_bf16_f32 %0, %1, %2" : "=v"(r) : "v"(lo), "v"(hi)); return r; }
__device__ __forceinline__ float sigm(float x) { return __builtin_amdgcn_rcpf(1.0f + __expf(-x)); }
__device__ __forceinline__ void rot2(float& a, float& b, float c, float s) { const float t1 = a, t2 = b; a = t1 * c - t2 * s; b = t2 * c + t1 * s; }
__device__ __forceinline__ void st_bf16x8(bf16_t* dst, const float (&v)[8]) { u32x4 w; w.x = cvt_pk_bf16(v[0], v[1]); w.y = cvt_pk_bf16(v[2], v[3]); w.z = cvt_pk_bf16(v[4], v[5]); w.w = cvt_pk_bf16(v[6], v[7]); *(u32x4*)dst = w; }
struct EpiProj {
    static constexpr bool PERM = true, AFTER_DRAIN = false;
    __device__ __forceinline__ bool keep(const Unit&) const { return false; }
    bf16_t *Q, *KV, *HQ, *HI, *HGs, *MG; float *HF, *GT; const float* lb; const float* rope;
    __device__ __forceinline__ void operator()(const f32x4 (&acc)[2][2][4][2], const Unit& u, int wr, int wc, int fr, int fq) const {
        const int pn = u.pn; int row0 = u.pm * BM + wr * 64 + fr; int cw = wc * 32 + 8 * fq; asm volatile("" : "+v"(row0), "+v"(cw));
#pragma unroll
        for (int ai = 0; ai < 2; ++ai)
#pragma unroll
            for (int m = 0; m < 4; ++m) {
                const int row = row0 + ai * HALF + m * 16; const int pos = row & 8191;
#pragma unroll
                for (int bj = 0; bj < 2; ++bj) {
                    float v[8];
#pragma unroll
                    for (int e = 0; e < 4; ++e) { v[e] = acc[ai][bj][m][0][e]; v[4 + e] = acc[ai][bj][m][1][e]; }
                    const int c = bj * HALF + cw;
                    if (pn < 5) {
                        bool dorope; bf16_t* dst; float sc; int col;
                        if (pn < 2) { col = pn * 256 + c; dorope = (col & 63) < 16; dst = Q + (size_t)row * 512 + col; sc = 0.125f; }
                        else { col = (pn - 2) * 256 + c; const int j = col >> 7; dorope = ((col & 63) < 16) && (j == 2 || j == 4); dst = KV + (size_t)row * 768 + col; sc = 1.0f; }
                        if (dorope) { const int i0 = (col & 63) >> 1; const float* rp = rope + (size_t)pos * 16 + i0 * 2;
                            const f32x4 r0 = *(const f32x4*)rp; const f32x4 r1 = *(const f32x4*)(rp + 4);
                            rot2(v[0], v[1], r0[0], r0[1]); rot2(v[2], v[3], r0[2], r0[3]); rot2(v[4], v[5], r1[0], r1[1]); rot2(v[6], v[7], r1[2], r1[3]); }
#pragma unroll
                        for (int e = 0; e < 8; ++e) v[e] *= sc;
                        st_bf16x8(dst, v);
                    } else if (pn < 7) { st_bf16x8(HQ + (size_t)row * 512 + (pn - 5) * 256 + c, v);
                    } else if (pn < 9) { const int cc = (pn - 7) * 256 + c; const f32x4 l0 = *(const f32x4*)(lb + cc), l1 = *(const f32x4*)(lb + cc + 4);
                        f32x4 o0, o1;
#pragma unroll
                        for (int e = 0; e < 4; ++e) { o0[e] = __logf(l0[e] + (1.0f - l0[e]) * sigm(v[e])); o1[e] = __logf(l1[e] + (1.0f - l1[e]) * sigm(v[4 + e])); }
                        float* d = HF + (size_t)row * 512 + cc; *(f32x4*)d = o0; *(f32x4*)(d + 4) = o1;
                    } else if (pn < 11) { st_bf16x8(HI + (size_t)row * 512 + (pn - 9) * 256 + c, v);
                    } else if (pn < 13) {
#pragma unroll
                        for (int e = 0; e < 8; ++e) v[e] = v[e] * sigm(v[e]);
                        st_bf16x8(HGs + (size_t)row * 512 + (pn - 11) * 256 + c, v);
                    } else if (pn < 21) {
#pragma unroll
                        for (int e = 0; e < 8; ++e) v[e] = sigm(v[e]);
                        st_bf16x8(MG + (size_t)row * 2048 + (pn - 13) * 256 + c, v);
                    } else { if (c < 24) { f32x4 o0, o1;
#pragma unroll
                            for (int e = 0; e < 4; ++e) { o0[e] = sigm(v[e]); o1[e] = sigm(v[4 + e]); }
                            float* d = GT + (size_t)row * 24 + c; *(f32x4*)d = o0; *(f32x4*)(d + 4) = o1; } }
                }
            }
    }
};

__device__ __forceinline__ void ld_bf16x8(const bf16_t* src, float (&v)[8]) { const u32x4 w = *(const u32x4*)src;
    v[0] = __builtin_bit_cast(float, w.x << 16); v[1] = __builtin_bit_cast(float, w.x & 0xffff0000u); v[2] = __builtin_bit_cast(float, w.y << 16); v[3] = __builtin_bit_cast(float, w.y & 0xffff0000u);
    v[4] = __builtin_bit_cast(float, w.z << 16); v[5] = __builtin_bit_cast(float, w.z & 0xffff0000u); v[6] = __builtin_bit_cast(float, w.w << 16); v[7] = __builtin_bit_cast(float, w.w & 0xffff0000u); }
struct MergeOrder {
    StaticOrder so;
    __device__ void init(int M, int N, int G, int c) { so.init(M, N, G, c); }
    __device__ bool next(int i, Unit& u) const { if (!so.next(i >> 1, u)) return false; u.sel = i & 1; return true; }
    __device__ __forceinline__ void a_ready(const Unit&) const {}
    __device__ __forceinline__ void done(const Unit&) const {}
};
struct EpiMerge {
    static constexpr bool PERM = true, AFTER_DRAIN = false;
    __device__ __forceinline__ bool keep(const Unit&) const { return false; }
    const bf16_t* MG; bf16_t* MIX;
    __device__ __forceinline__ void operator()(const f32x4 (&acc)[2][2][4][2], const Unit& u, int wr, int wc, int fr, int fq) const {
        int row0 = u.pm * BM + wr * 64 + fr; int col0 = u.pn * BM + wc * 32 + 8 * fq; asm volatile("" : "+v"(row0), "+v"(col0));
#pragma unroll
        for (int ai = 0; ai < 2; ++ai)
#pragma unroll
            for (int m = 0; m < 4; ++m) { const int row = row0 + ai * HALF + m * 16;
#pragma unroll
                for (int bj = 0; bj < 2; ++bj) { const int col = col0 + bj * HALF;
                    float g[8], v[8]; ld_bf16x8(MG + (size_t)row * 2048 + (u.sel ? 1024 : 0) + col, g);
#pragma unroll
                    for (int e = 0; e < 4; ++e) { v[e] = acc[ai][bj][m][0][e] * g[e]; v[4 + e] = acc[ai][bj][m][1][e] * g[4 + e]; }
                    bf16_t* dst = MIX + (size_t)row * 1024 + col;
                    if (u.sel) { float o[8]; ld_bf16x8(dst, o);
#pragma unroll
                        for (int e = 0; e < 8; ++e) v[e] += o[e]; }
                    st_bf16x8(dst, v); } }
    }
};
struct EpiOut {
    static constexpr bool PERM = false, AFTER_DRAIN = false;
    __device__ __forceinline__ bool keep(const Unit&) const { return false; }
    const float* X; float* O;
    __device__ __forceinline__ void operator()(const f32x4 (&acc)[2][2][4][2], const Unit& u, int wr, int wc, int fr, int fq) const {
        int row0 = u.pm * BM + wr * 64 + fr; int col0 = u.pn * BM + wc * 32 + 4 * fq; asm volatile("" : "+v"(row0), "+v"(col0));
#pragma unroll
        for (int ai = 0; ai < 2; ++ai)
#pragma unroll
            for (int m = 0; m < 4; ++m) { const size_t ro = (size_t)(row0 + ai * HALF + m * 16) * 1024 + col0;
#pragma unroll
                for (int bj = 0; bj < 2; ++bj)
#pragma unroll
                    for (int n = 0; n < 2; ++n) { const size_t o = ro + bj * HALF + n * 16; *(f32x4*)(O + o) = *(const f32x4*)(X + o) + acc[ai][bj][m][n]; } }
    }
};
struct MoeOrder {
    const volatile PG8_LAS int* tp;
    int G, c;
    __device__ bool next(int i, Unit& u) const {
        const int L = i * G + c; const int ntile = __builtin_amdgcn_readfirstlane(tp[32]);
        if (L >= 4 * ntile) return false;
        const int rt = L >> 2, nt = L & 3; int e = 0;
        for (int q = 1; q < 32; ++q) e += (__builtin_amdgcn_readfirstlane(tp[q]) <= rt) ? 1 : 0;
        u.pm = rt; u.pn = e * 4 + nt; u.sel = 0; return true;
    }
    __device__ __forceinline__ void a_ready(const Unit&) const {}
    __device__ __forceinline__ void done(const Unit&) const {}
};
struct EpiGU {
    static constexpr bool PERM = true, AFTER_DRAIN = false;
    __device__ __forceinline__ bool keep(const Unit&) const { return false; }
    const float* RS; bf16_t* HID;
    __device__ __forceinline__ void operator()(const f32x4 (&acc)[2][2][4][2], const Unit& u, int wr, int wc, int fr, int fq) const {
        int row0 = u.pm * BM + wr * 64 + fr; int col0 = (u.pn & 3) * 128 + wc * 32 + 8 * fq; asm volatile("" : "+v"(row0), "+v"(col0));
#pragma unroll
        for (int ai = 0; ai < 2; ++ai)
#pragma unroll
            for (int m = 0; m < 4; ++m) { const int row = row0 + ai * HALF + m * 16; const float r = RS[row]; float v[8];
#pragma unroll
                for (int e = 0; e < 4; ++e) { const float g0 = acc[ai][0][m][0][e] * r, g1 = acc[ai][0][m][1][e] * r; v[e] = g0 * sigm(g0) * (acc[ai][1][m][0][e] * r); v[4 + e] = g1 * sigm(g1) * (acc[ai][1][m][1][e] * r); }
                st_bf16x8(HID + (size_t)row * 512 + col0, v); }
    }
};
struct EpiDown {
    static constexpr bool PERM = true, AFTER_DRAIN = false;
    __device__ __forceinline__ bool keep(const Unit&) const { return false; }
    bf16_t* Y;
    __device__ __forceinline__ void operator()(const f32x4 (&acc)[2][2][4][2], const Unit& u, int wr, int wc, int fr, int fq) const {
        int row0 = u.pm * BM + wr * 64 + fr; int col0 = (u.pn & 3) * BM + wc * 32 + 8 * fq; asm volatile("" : "+v"(row0), "+v"(col0));
#pragma unroll
        for (int ai = 0; ai < 2; ++ai)
#pragma unroll
            for (int m = 0; m < 4; ++m) { const int row = row0 + ai * HALF + m * 16;
#pragma unroll
                for (int bj = 0; bj < 2; ++bj) { float v[8];
#pragma unroll
                    for (int e = 0; e < 4; ++e) { v[e] = acc[ai][bj][m][0][e]; v[4 + e] = acc[ai][bj][m][1][e]; }
                    st_bf16x8(Y + (size_t)row * 1024 + col0 + bj * HALF, v); } }
    }
};

template <class Epi, class Sched, bool ALIGN_EPI = false, bool SP2 = false>
__device__ __forceinline__ void gemm_phase(PG8_LAS unsigned char* lds, const Gemm g, const Sched& S, const Epi& E) {
    int tid_ = threadIdx.x; asm volatile("" : "+v"(tid_));
    const int tid = tid_, wid = __builtin_amdgcn_readfirstlane(tid >> 6), lane = tid & 63, wr = wid >> 2, wc = wid & 3, fr = lane & 15, fq = lane >> 4;
    const int K = g.K, nt = K / BK;
    unsigned voffA[2], voffB[2];
#pragma unroll
    for (int i = 0; i < 2; ++i) { int R, C; stage_rc(tid * 16 + i * 8192, R, C); const int Rb = Epi::PERM ? ((R & ~31) + perm32(R & 31)) : R;
        voffA[i] = (unsigned)(R * K + C) * 2u; voffB[i] = (unsigned)(Rb * K + C) * 2u; }
    const size_t kstep = (size_t)(BK * 2);
    const size_t hstep = (size_t)HALF * K * 2;
    const size_t tstep = 2 * hstep;
    const unsigned ldsw = (unsigned)wid * 1024u;
    const int aoff = lds_byte(wr * 64 + fr, fq * 8), boff = lds_byte(wc * 32 + fr, fq * 8);
#define PG8_SA(b, h) (((b) * 2 + (h)) * HTB)
#define PG8_SB(b, h) ((4 + (b) * 2 + (h)) * HTB)
#define PG8_STAGE(bufoff, gbase, voff) do { _Pragma("unroll") for (int _i = 0; _i < 2; ++_i) \
        __builtin_amdgcn_global_load_lds((const unsigned*)((const char*)(gbase) + (voff)[_i]), (PG8_LAS unsigned*)(lds + (bufoff) + ldsw + _i * 8192), 16, 0, 0); } while (0)
#define PG8_LDA(dst, b, h) do { _Pragma("unroll") for (int m = 0; m < 4; ++m) _Pragma("unroll") for (int k = 0; k < 2; ++k) dst[m][k] = *(const PG8_LAS bf16x8*)(lds + PG8_SA(b, h) + aoff + m * 2048 + k * 1024); } while (0)
#define PG8_LDB(dst, b, h) do { _Pragma("unroll") for (int n = 0; n < 2; ++n) _Pragma("unroll") for (int k = 0; k < 2; ++k) dst[n][k] = *(const PG8_LAS bf16x8*)(lds + PG8_SB(b, h) + boff + n * 2048 + k * 1024); } while (0)
#define PG8_MMA(ai, bj, At, Bt) do { __builtin_amdgcn_s_setprio(1); _Pragma("unroll") for (int m = 0; m < 4; ++m) _Pragma("unroll") for (int n = 0; n < 2; ++n) _Pragma("unroll") for (int k = 0; k < 2; ++k) \
        acc[ai][bj][m][n] = __builtin_amdgcn_mfma_f32_16x16x32_bf16(Bt[n][k], At[m][k], acc[ai][bj][m][n], 0, 0, 0); __builtin_amdgcn_s_setprio(0); } while (0)
#define PG8_WAIT_V(n) asm volatile("s_waitcnt vmcnt(" #n ")" ::: "memory")
#define PG8_WAIT_L(n) asm volatile("s_waitcnt lgkmcnt(" #n ")" ::: "memory")
#define PG8_BAR __builtin_amdgcn_s_barrier()
#define PG8_SCHED __builtin_amdgcn_sched_barrier(0)
    Unit cur, nxt; int ui = 0;
    if (!S.next(0, cur)) return;
    f32x4 acc[2][2][4][2];
#pragma unroll
    for (int a = 0; a < 2; ++a)
#pragma unroll
        for (int b = 0; b < 2; ++b)
#pragma unroll
            for (int m = 0; m < 4; ++m)
#pragma unroll
                for (int n = 0; n < 2; ++n) acc[a][b][m][n] = (f32x4){0.f, 0.f, 0.f, 0.f};
    bf16x8 At[4][2], B0[2][2], B1[2][2];
    const char* cA = (const char*)(cur.sel ? g.A2 : g.A) + (size_t)cur.pm * tstep; const char* cB = (const char*)(cur.sel ? g.Bt2 : g.Bt) + (size_t)cur.pn * tstep;
    S.a_ready(cur);
    if constexpr (SP2) {
        PG8_STAGE(PG8_SB(0, 0), cB, voffB); PG8_STAGE(PG8_SB(0, 1), cB + hstep, voffB); PG8_STAGE(PG8_SA(0, 0), cA, voffA); PG8_STAGE(PG8_SA(0, 1), cA + hstep, voffA);
        if (wr == 1) PG8_BAR;
        PG8_WAIT_V(2); PG8_BAR;
        PG8_STAGE(PG8_SB(1, 0), cB + kstep, voffB); PG8_STAGE(PG8_SA(1, 0), cA + kstep, voffA); PG8_STAGE(PG8_SB(1, 1), cB + hstep + kstep, voffB);
        PG8_WAIT_V(6); PG8_BAR;
    } else {
        PG8_STAGE(PG8_SB(0, 0), cB, voffB); PG8_STAGE(PG8_SA(0, 0), cA, voffA); PG8_STAGE(PG8_SB(0, 1), cB + hstep, voffB); PG8_STAGE(PG8_SA(0, 1), cA + hstep, voffA);
        if (wr == 1) PG8_BAR;
        PG8_WAIT_V(4); PG8_BAR;
        PG8_STAGE(PG8_SB(1, 0), cB + kstep, voffB); PG8_STAGE(PG8_SA(1, 0), cA + kstep, voffA); PG8_STAGE(PG8_SB(1, 1), cB + hstep + kstep, voffB);
        PG8_WAIT_V(6); PG8_BAR;
    }
    for (;;) {
        const bool has_next = S.next(ui + 1, nxt);
        const char* nA = has_next ? (const char*)(nxt.sel ? g.A2 : g.A) + (size_t)nxt.pm * tstep : cA; const char* nB = has_next ? (const char*)(nxt.sel ? g.Bt2 : g.Bt) + (size_t)nxt.pn * tstep : cB;
        for (int t = 0; t < nt; t += 2) {
            const bool last = (t == nt - 2);
            const char* a1 = cA + (size_t)(t + 1) * kstep;
            const char* a2 = last ? nA : cA + (size_t)(t + 2) * kstep; const char* b2 = last ? nB : cB + (size_t)(t + 2) * kstep;
            const char* a3 = a2 + kstep; const char* b3 = b2 + kstep;
            if (last && has_next) S.a_ready(nxt);
            if constexpr (SP2) {
            PG8_LDB(B0, 0, 0); PG8_LDB(B1, 0, 1); PG8_SCHED; PG8_LDA(At, 0, 0); PG8_STAGE(PG8_SA(1, 1), a1 + hstep, voffA);
            PG8_WAIT_V(8); PG8_WAIT_L(0); PG8_BAR; PG8_MMA(0, 0, At, B0); PG8_MMA(0, 1, At, B1); PG8_BAR; PG8_SCHED;
            PG8_LDA(At, 0, 1); PG8_STAGE(PG8_SB(0, 0), b2, voffB); PG8_STAGE(PG8_SB(0, 1), b2 + hstep, voffB); PG8_STAGE(PG8_SA(0, 0), a2, voffA);
            PG8_WAIT_V(8); PG8_WAIT_L(0); PG8_BAR; PG8_MMA(1, 0, At, B0); PG8_MMA(1, 1, At, B1); PG8_BAR; PG8_SCHED;
            PG8_LDB(B0, 1, 0); PG8_LDB(B1, 1, 1); PG8_SCHED; PG8_LDA(At, 1, 0); PG8_STAGE(PG8_SA(0, 1), a2 + hstep, voffA);
            PG8_WAIT_V(8); PG8_WAIT_L(0); PG8_BAR; PG8_MMA(0, 0, At, B0); PG8_MMA(0, 1, At, B1); PG8_BAR; PG8_SCHED;
            PG8_LDA(At, 1, 1); PG8_STAGE(PG8_SB(1, 0), b3, voffB); PG8_STAGE(PG8_SB(1, 1), b3 + hstep, voffB); PG8_STAGE(PG8_SA(1, 0), a3, voffA);
            PG8_WAIT_V(8); PG8_WAIT_L(0); PG8_BAR; PG8_MMA(1, 0, At, B0); PG8_MMA(1, 1, At, B1); PG8_BAR; PG8_SCHED;
            } else {
            PG8_LDB(B0, 0, 0); PG8_SCHED; PG8_LDA(At, 0, 0); PG8_STAGE(PG8_SA(1, 1), a1 + hstep, voffA);
            PG8_WAIT_L(8); PG8_BAR; PG8_WAIT_L(0); PG8_MMA(0, 0, At, B0); PG8_BAR; PG8_SCHED;
            PG8_LDB(B1, 0, 1); PG8_STAGE(PG8_SB(0, 0), b2, voffB);
            PG8_BAR; PG8_WAIT_L(0); PG8_MMA(0, 1, At, B1); PG8_BAR;
            PG8_LDA(At, 0, 1); PG8_STAGE(PG8_SA(0, 0), a2, voffA);
            PG8_BAR; PG8_WAIT_L(0); PG8_MMA(1, 0, At, B0); PG8_BAR; PG8_SCHED;
            PG8_STAGE(PG8_SB(0, 1), b2 + hstep, voffB);
            PG8_WAIT_V(6); PG8_BAR; PG8_MMA(1, 1, At, B1); PG8_BAR;
            PG8_LDB(B0, 1, 0); PG8_SCHED; PG8_LDA(At, 1, 0); PG8_STAGE(PG8_SA(0, 1), a2 + hstep, voffA);
            PG8_WAIT_L(8); PG8_BAR; PG8_WAIT_L(0); PG8_MMA(0, 0, At, B0); PG8_BAR; PG8_SCHED;
            PG8_LDB(B1, 1, 1); PG8_STAGE(PG8_SB(1, 0), b3, voffB);
            PG8_BAR; PG8_WAIT_L(0); PG8_MMA(0, 1, At, B1); PG8_BAR;
            PG8_LDA(At, 1, 1); PG8_STAGE(PG8_SA(1, 0), a3, voffA);
            PG8_BAR; PG8_WAIT_L(0); PG8_MMA(1, 0, At, B0); PG8_BAR; PG8_SCHED;
            PG8_STAGE(PG8_SB(1, 1), b3 + hstep, voffB);
            PG8_WAIT_V(6); PG8_BAR; PG8_MMA(1, 1, At, B1); PG8_BAR;
            }
        }
        if constexpr (ALIGN_EPI) { if (wr == 0) PG8_BAR; }
        if constexpr (!Epi::AFTER_DRAIN) { E(acc, cur, wr, wc, fr, fq); S.done(cur); }
        if (!has_next) break;
        if (!E.keep(cur)) {
#pragma unroll
        for (int a = 0; a < 2; ++a)
#pragma unroll
            for (int b = 0; b < 2; ++b)
#pragma unroll
                for (int m = 0; m < 4; ++m)
#pragma unroll
                    for (int n = 0; n < 2; ++n) acc[a][b][m][n] = (f32x4){0.f, 0.f, 0.f, 0.f};
        }
        cur = nxt; cA = nA; cB = nB; ++ui;
        if constexpr (ALIGN_EPI) { if (wr == 1) PG8_BAR; }
    }
    PG8_WAIT_V(0);
    if constexpr (!ALIGN_EPI) { if (wr == 0) PG8_BAR; }
    PG8_BAR;
    if constexpr (Epi::AFTER_DRAIN) { E.fused(acc, cur, wr, wc, fr, fq, lds, wid, lane); S.done(cur); }
#undef PG8_SA
#undef PG8_SB
#undef PG8_STAGE
#undef PG8_LDA
#undef PG8_LDB
#undef PG8_MMA
#undef PG8_WAIT_V
#undef PG8_WAIT_L
#undef PG8_BAR
#undef PG8_SCHED
}
}

#define GAS __attribute__((address_space(1)))
#define LAS __attribute__((address_space(3)))
typedef unsigned short bf16;
typedef unsigned v4u __attribute__((ext_vector_type(4)));
typedef float f32x4 __attribute__((ext_vector_type(4)));
typedef short bf16x8 __attribute__((ext_vector_type(8)));
typedef GAS unsigned gu32;
typedef GAS unsigned long long gu64;
#define RLX_AGENT __ATOMIC_RELAXED, __HIP_MEMORY_SCOPE_AGENT
#define LDS_WAIT() asm volatile("s_waitcnt lgkmcnt(0)" ::: "memory")
#define VM_WAIT() asm volatile("s_waitcnt vmcnt(0)" ::: "memory")
__device__ __forceinline__ unsigned long long rt() { return __builtin_amdgcn_s_memrealtime(); }
__device__ __forceinline__ unsigned f2bf(float f) { unsigned u = __builtin_bit_cast(unsigned, f); return (u + 0x7fffu + ((u >> 16) & 1u)) >> 16; }
__device__ __forceinline__ unsigned pk2(float lo, float hi) { return f2bf(lo) | (f2bf(hi) << 16); }

#define XB_TMO      128
#define XB_XCNT(j)  (256  + 64 * (j))
#define XB_XSUB(j)  (1280 + 64 * (j))
#define XB_XGEN(j)  (2304 + 64 * (j))
#define XB_TOP      3328
#define XB_TOPGEN   3392
#define XCD_BAR_WORDS 3456
#define XB_SPIN_CAP (1u << 18)

__device__ __forceinline__ unsigned xb_ld(unsigned* p)              { return __hip_atomic_load(p, __ATOMIC_RELAXED, __HIP_MEMORY_SCOPE_AGENT); }
__device__ __forceinline__ unsigned xb_add(unsigned* p, unsigned v) { return __hip_atomic_fetch_add(p, v, __ATOMIC_RELAXED, __HIP_MEMORY_SCOPE_AGENT); }
__device__ __forceinline__ unsigned xb_xcc_id() { return (unsigned)__builtin_amdgcn_s_getreg((3 << 11) | 20) & 0xFu; }
#define XB_SPIN(cond, bar) do { unsigned _sp = 0; while (cond) { __builtin_amdgcn_s_sleep(1); \
    if ((++_sp & 255u) == 0u) { if (xb_ld(&(bar)[XB_TMO])) break; if (_sp > XB_SPIN_CAP) { atomicAdd(&(bar)[XB_TMO], 1u); break; } } } } while (0)

struct XcdBarrier {
    unsigned* bar; unsigned x;
    volatile LAS unsigned* st;
};

__device__ __forceinline__ XcdBarrier xcd_barrier_post(unsigned* bar, volatile LAS unsigned* st) {
    XcdBarrier b; b.bar = bar; b.x = xb_xcc_id(); b.st = st;
    if (threadIdx.x == 0) (void)xb_add(&bar[XB_XCNT(b.x)], 1u);
    return b;
}
__device__ __forceinline__ void xcd_barrier_complete(unsigned* bar, unsigned x, unsigned& nloc, unsigned& nx) {
    const unsigned G = gridDim.x * gridDim.y * gridDim.z;
    unsigned sum, cnt, mine, sp = 0u;
    for (;;) {
        sum = 0u; cnt = 0u; mine = 0u;
#pragma unroll
        for (unsigned j = 0; j < 16; ++j) { const unsigned c = xb_ld(&bar[XB_XCNT(j)]); sum += c; cnt += (c > 0u) ? 1u : 0u; mine = (j == x) ? c : mine; }
        if (sum == G) break;
        __builtin_amdgcn_s_sleep(1);
        if ((++sp & 255u) == 0u) { if (xb_ld(&bar[XB_TMO])) break; if (sp > XB_SPIN_CAP) { atomicAdd(&bar[XB_TMO], 1u); break; } }
    }
    nloc = mine > 0u ? mine : 1u; nx = cnt > 0u ? cnt : 1u;
}

__device__ __forceinline__ void xcd_barrier(const XcdBarrier& b) {
    asm volatile("s_waitcnt vmcnt(0)" ::: "memory");
    __syncthreads();
    if (threadIdx.x == 0) {
        unsigned* bar = b.bar;
        __builtin_amdgcn_s_waitcnt(0);
        unsigned nloc = b.st[0], nx = b.st[1];
        if (nloc == 0u) { xcd_barrier_complete(bar, b.x, nloc, nx); b.st[0] = nloc; b.st[1] = nx; }
        const unsigned old = xb_add(&bar[XB_XSUB(b.x)], 1u);
        const unsigned gen = old / nloc;
        if (old + 1u == (gen + 1u) * nloc) {
            __builtin_amdgcn_fence(__ATOMIC_RELEASE, "agent");
            asm volatile("s_waitcnt vmcnt(0)" ::: "memory");
            const unsigned og = xb_add(&bar[XB_TOP], 1u);
            const unsigned tg = og / nx;
            if (og + 1u == (tg + 1u) * nx) xb_add(&bar[XB_TOPGEN], 1u);
            else XB_SPIN(xb_ld(&bar[XB_TOPGEN]) == tg, bar);
            __builtin_amdgcn_fence(__ATOMIC_ACQUIRE, "agent");
            xb_add(&bar[XB_XGEN(b.x)], 1u);
            asm volatile("s_waitcnt vmcnt(0)" ::: "memory");
        } else {
            XB_SPIN(xb_ld(&bar[XB_XGEN(b.x)]) == gen, bar);
            __builtin_amdgcn_fence(__ATOMIC_ACQUIRE, "agent");
            asm volatile("s_waitcnt vmcnt(0)" ::: "memory");
        }
    }
    __syncthreads();
}
constexpr int NWAVES = 8;
constexpr int DM = 1024, NB = 2, SEQ = 8192, TOK = NB * SEQ;
constexpr int NC_IN = 5400, NPROJ = 5632;
constexpr int NCMP = 511, NSEL = 128, TOPN = 16, NE = 32, FF = 512;
constexpr size_t MiB = 1u << 20;
constexpr size_t WS_CTL = 0, CTL_ZERO_BYTES = 1 * MiB;
constexpr size_t WS_SMALL = 1 * MiB;
constexpr size_t WS_WIN = 2 * MiB;
constexpr size_t WS_WBRN = 13 * MiB, WS_WBRH = 14 * MiB, WS_WOUT = 15 * MiB, WS_WCMP = 17 * MiB;
constexpr size_t WS_WGU = 18 * MiB, WS_WD = 82 * MiB;
constexpr size_t WS_XN = 114 * MiB;
constexpr size_t WS_Q = 146 * MiB, WS_KV = 162 * MiB, WS_HQ = 186 * MiB, WS_HF = 202 * MiB, WS_HI = 234 * MiB, WS_HGS = 250 * MiB, WS_GT = 266 * MiB;
constexpr size_t WS_MISC = 276 * MiB;
constexpr size_t WS_END = 284 * MiB;
constexpr size_t WS_ONSA = 82 * MiB, WS_OHG = 50 * MiB;
constexpr size_t WS_ONSAB = 130 * MiB, WS_OHGB = 114 * MiB, WS_MIX = 218 * MiB;
constexpr int R_PAD = 40960;
constexpr size_t WS_H2S = 146 * MiB, WS_HID = 226 * MiB, WS_YB = 146 * MiB;
constexpr size_t OFF_WRH = 640 * 1024, OFF_WRL = 768 * 1024;
constexpr size_t M_EID = 4 * MiB, M_EW = 4 * MiB + 256 * 1024, M_SLOT = 4 * MiB + 512 * 1024, M_POS = 4 * MiB + 768 * 1024, M_RINV = 5 * MiB, M_RS = 5 * MiB + 256 * 1024;
constexpr size_t WS_ST = 18 * MiB, WS_DEC = 17 * MiB + 512 * 1024;
constexpr int CW_DBG = 20480;
#ifndef DBG_MODE
#define DBG_MODE 0
#endif
constexpr int MISC_TP = 16;
constexpr int CW_BAR = 4096;
constexpr int CW_CNT = 16384;
constexpr int SCR_BYTES = 143360;
constexpr int MISC_OFF = SCR_BYTES;
constexpr int LDS_BYTES = 147456;

__device__ __forceinline__ float wave_sum(float v) {
#pragma unroll
    for (int o = 1; o < 64; o <<= 1) v += __shfl_xor(v, o);
    return v;
}
__device__ __forceinline__ float wave_max(float v) {
#pragma unroll
    for (int o = 1; o < 64; o <<= 1) v = fmaxf(v, __shfl_xor(v, o));
    return v;
}
__device__ __forceinline__ float bf2f(bf16 b) { return __builtin_bit_cast(float, (unsigned)b << 16); }
__device__ __forceinline__ float sigmoidf_(float x) { return 1.0f / (1.0f + expf(-x)); }
__device__ __forceinline__ int perm_d(int dp) { return dp < 16 ? ((dp >> 1) + 8 * (dp & 1)) : dp; }
#define WAVE_LDS_FENCE() asm volatile("s_waitcnt lgkmcnt(0)" ::: "memory")

struct Params {
    const float *x, *attn_norm, *w_in, *w_cmp_k, *w_cmp_v, *cmp_pos, *hg_lb, *hg_norm, *w_br_nsa, *w_br_hg, *w_out, *ffn_norm, *w_grp, *b_grp, *w_rtr, *b_rtr, *w_gate, *w_up, *w_down, *final_norm;
    float* out; unsigned char* ws;
};

template <class F> __device__ __forceinline__ void tr_item(F srcf, int K, bf16* WT, int n0, int k0, float* scr, int lane) {
#pragma unroll 8
    for (int i = 0; i < 32; ++i) { const int kk = 2 * i + (lane >> 5); scr[kk * 33 + (lane & 31)] = srcf(k0 + kk, n0 + (lane & 31)); }
    WAVE_LDS_FENCE();
    const int c = lane & 7;
#pragma unroll
    for (int j = 0; j < 4; ++j) { const int n = (lane >> 3) + 8 * j; const float* s = scr + (8 * c) * 33 + n;
        v4u o; o.x = pk2(s[0 * 33], s[1 * 33]); o.y = pk2(s[2 * 33], s[3 * 33]); o.z = pk2(s[4 * 33], s[5 * 33]); o.w = pk2(s[6 * 33], s[7 * 33]);
        *(v4u*)(WT + (size_t)(n0 + n) * K + k0 + 8 * c) = o; }
    WAVE_LDS_FENCE();
}
__device__ __forceinline__ int win_src_col(int n) {
    if (n < 512) return (n & ~63) + perm_d(n & 63);
    if (n < 1280) { const int j = (n - 512) >> 7; const int d = n & 63; return (n & ~63) + ((j == 2 || j == 4) ? perm_d(d) : d); }
    if (n < 5376) return n + 24;
    if (n < 5400) return 1280 + (n - 5376);
    return -1;
}
__device__ __forceinline__ void p0_prologue(const Params& p, unsigned char* lds, int wave, int lane, int gw, int NGW, int gtid, int NGT) {
    float* scr = (float*)(lds + wave * 8448);
    bf16* Win_t = (bf16*)(p.ws + WS_WIN); bf16* Wbrn_t = (bf16*)(p.ws + WS_WBRN); bf16* Wbrh_t = (bf16*)(p.ws + WS_WBRH); bf16* Wout_t = (bf16*)(p.ws + WS_WOUT); bf16* Wcmp_t = (bf16*)(p.ws + WS_WCMP);
    constexpr int I_IN = 16 * (NPROJ / 32), I_BR = 8 * 32, I_OUT = 16 * 32, I_CMP = 32 * 4;
    constexpr int NITEMS = I_IN + 2 * I_BR + I_OUT + I_CMP;
    for (int it = gw; it < NITEMS; it += NGW) {
        int r = it;
        if (r < I_IN) { const int nblk = NPROJ / 32, kb = r / nblk, nb = r % nblk; const float* W = p.w_in;
            tr_item([W](int k, int n) { const int c = win_src_col(n); return c >= 0 ? W[(size_t)k * NC_IN + c] : 0.0f; }, DM, Win_t, 32 * nb, 64 * kb, scr, lane); continue; }
        r -= I_IN;
        if (r < I_BR) { const int kb = r / 32, nb = r % 32; const float* W = p.w_br_nsa; tr_item([W](int k, int n) { return W[(size_t)k * DM + n]; }, 512, Wbrn_t, 32 * nb, 64 * kb, scr, lane); continue; }
        r -= I_BR;
        if (r < I_BR) { const int kb = r / 32, nb = r % 32; const float* W = p.w_br_hg; tr_item([W](int k, int n) { return W[(size_t)k * DM + n]; }, 512, Wbrh_t, 32 * nb, 64 * kb, scr, lane); continue; }
        r -= I_BR;
        if (r < I_OUT) { const int kb = r / 32, nb = r % 32; const float* W = p.w_out; tr_item([W](int k, int n) { return W[(size_t)k * DM + n]; }, DM, Wout_t, 32 * nb, 64 * kb, scr, lane); continue; }
        r -= I_OUT;
        { const int kb = r / 4, nb = r % 4; const float* Wk = p.w_cmp_k; const float* Wv = p.w_cmp_v;
          tr_item([Wk, Wv](int k, int n) { return n < 64 ? Wk[(size_t)k * 64 + perm_d(n)] : Wv[(size_t)k * 64 + (n - 64)]; }, 2048, Wcmp_t, 32 * nb, 64 * kb, scr, lane); }
    }
    { bf16* Wh = (bf16*)(p.ws + WS_SMALL + OFF_WRH); bf16* Wl = (bf16*)(p.ws + WS_SMALL + OFF_WRL);
      for (int i = gtid; i < 48 * 1024; i += NGT) { const int c = i >> 10, k = i & 1023; const float w = c < 4 ? p.w_grp[k * 4 + c] : (c < 36 ? p.w_rtr[k * 32 + (c - 4)] : 0.0f);
          const unsigned hi = f2bf(w); Wh[i] = (bf16)hi; Wl[i] = (bf16)f2bf(w - __builtin_bit_cast(float, hi << 16)); } }
    float* lbv = (float*)(p.ws + WS_SMALL); float* rope = (float*)(p.ws + WS_SMALL + 65536);
    for (int i = gtid; i < SEQ * 8; i += NGT) { const int pos = i >> 3, f = i & 7; const float inv = powf(500000.0f, -(float)f / 8.0f); const float ang = (float)pos * inv; float sn, cs; sincosf(ang, &sn, &cs); rope[2 * i] = cs; rope[2 * i + 1] = sn; }
    if (gtid < 512) { const float l0 = p.hg_lb[gtid], l1 = p.hg_lb[512 + gtid]; const float m = fmaxf(l0, l1); const float e0 = expf(l0 - m), e1 = expf(l1 - m); lbv[gtid] = e0 / (e0 + e1); }
    bf16* XN = (bf16*)(p.ws + WS_XN);
    for (int m = gw; m < TOK; m += NGW) {
        const f32x4* xr = (const f32x4*)(p.x + (size_t)m * DM) + lane; const f32x4* gr = (const f32x4*)p.attn_norm + lane;
        f32x4 v[4]; float s = 0.f;
#pragma unroll
        for (int j = 0; j < 4; ++j) { v[j] = xr[64 * j]; s += (v[j].x * v[j].x + v[j].y * v[j].y) + (v[j].z * v[j].z + v[j].w * v[j].w); }
        const float r = 1.0f / sqrtf(wave_sum(s) * (1.0f / DM) + 1e-6f);
        unsigned long long* o8 = (unsigned long long*)(XN + (size_t)m * DM) + lane;
#pragma unroll
        for (int j = 0; j < 4; ++j) { const f32x4 g = gr[64 * j]; o8[64 * j] = (unsigned long long)pk2(v[j].x * r * g.x, v[j].y * r * g.y) | ((unsigned long long)pk2(v[j].z * r * g.z, v[j].w * r * g.w) << 32); }
    }
}

__device__ __forceinline__ void s_compress(const Params& p, int lane, int gw, int NGW) {
    const bf16* KV = (const bf16*)(p.ws + WS_KV); const float* rope = (const float*)(p.ws + WS_SMALL + 65536);
    float* kc = (float*)(p.ws + WS_MISC + 2 * MiB); float* vc = (float*)(p.ws + WS_MISC + 3 * MiB);
    for (int it = gw; it < NB * NCMP * 4; it += NGW) {
        const int j = it & 1, g = (it >> 1) & 1, bn = it >> 2, b = bn / NCMP, n = bn % NCMP;
        const float* W = j == 0 ? p.w_cmp_k : p.w_cmp_v; const int sc = j == 0 ? perm_d(lane) : lane;
        float acc = 0.f;
        for (int l = 0; l < 32; ++l) {
            const bf16* src = KV + (size_t)(b * SEQ + 16 * n + l) * 768 + j * 128 + g * 64;
            for (int d = 0; d < 64; ++d) acc = fmaf(bf2f(src[d]) + p.cmp_pos[l * 64 + d], W[(size_t)(l * 64 + d) * 64 + sc], acc);
        }
        if (j == 0) { const float other = __shfl_xor(acc, 1);
            if (lane < 16) { const int i = lane >> 1; const float cs = rope[(size_t)(16 * n) * 16 + 2 * i], sn = rope[(size_t)(16 * n) * 16 + 2 * i + 1];
                acc = (lane & 1) ? (acc * cs + other * sn) : (acc * cs - other * sn); }
            kc[((size_t)(b * NCMP + n) * 2 + g) * 64 + lane] = acc;
        } else vc[((size_t)(b * NCMP + n) * 2 + g) * 64 + lane] = acc;
    }
}
__device__ __forceinline__ void s_cmp_attn(const Params& p, unsigned char* lds, int wave, int lane, int gw, int NGW) {
    float* wl = (float*)(lds + wave * 17472); float* qs = wl; float* pp = wl + 256; float* sc = pp + 4 * 512;
    const bf16* Q = (const bf16*)(p.ws + WS_Q); const float* GT = (const float*)(p.ws + WS_GT);
    const float* kc = (const float*)(p.ws + WS_MISC + 2 * MiB); const float* vc = (const float*)(p.ws + WS_MISC + 3 * MiB);
    float* onsa = (float*)(p.ws + WS_ONSA); int* selidx = (int*)(p.ws + WS_MISC);
    for (int it = gw; it < TOK * 2; it += NGW) {
        const int g = it & 1, m = it >> 1, b = m >> 13, s = m & 8191;
        WAVE_LDS_FENCE();
#pragma unroll
        for (int r = 0; r < 4; ++r) qs[r * 64 + lane] = bf2f(Q[(size_t)m * 512 + (g * 4 + r) * 64 + lane]);
        WAVE_LDS_FENCE();
        const int nvalid = s >= 31 ? (s - 31) / 16 + 1 : 0;
        float mx[4] = {-3.0e38f, -3.0e38f, -3.0e38f, -3.0e38f};
        for (int n = lane; n < nvalid; n += 64) {
            const float* kp = kc + ((size_t)(b * NCMP + n) * 2 + g) * 64;
            float d0 = 0.f, d1 = 0.f, d2 = 0.f, d3 = 0.f;
            for (int d = 0; d < 64; ++d) { const float kv = kp[d]; d0 = fmaf(qs[d], kv, d0); d1 = fmaf(qs[64 + d], kv, d1); d2 = fmaf(qs[128 + d], kv, d2); d3 = fmaf(qs[192 + d], kv, d3); }
            pp[n] = d0; pp[512 + n] = d1; pp[1024 + n] = d2; pp[1536 + n] = d3;
            mx[0] = fmaxf(mx[0], d0); mx[1] = fmaxf(mx[1], d1); mx[2] = fmaxf(mx[2], d2); mx[3] = fmaxf(mx[3], d3);
        }
        float sm[4];
#pragma unroll
        for (int r = 0; r < 4; ++r) { mx[r] = wave_max(mx[r]); float a = 0.f; for (int n = lane; n < nvalid; n += 64) { const float e = expf(pp[r * 512 + n] - mx[r]); pp[r * 512 + n] = e; a += e; } sm[r] = wave_sum(a); }
#pragma unroll
        for (int r = 0; r < 4; ++r) { const float inv = nvalid > 0 ? 1.0f / sm[r] : 0.f; for (int n = lane; n < nvalid; n += 64) pp[r * 512 + n] *= inv; }
        WAVE_LDS_FENCE();
        float o[4] = {0.f, 0.f, 0.f, 0.f};
        for (int n = 0; n < nvalid; ++n) { const float v = vc[((size_t)(b * NCMP + n) * 2 + g) * 64 + lane]; o[0] = fmaf(pp[n], v, o[0]); o[1] = fmaf(pp[512 + n], v, o[1]); o[2] = fmaf(pp[1024 + n], v, o[2]); o[3] = fmaf(pp[1536 + n], v, o[3]); }
#pragma unroll
        for (int r = 0; r < 4; ++r) { const int h = g * 4 + r; onsa[(size_t)m * 512 + h * 64 + lane] = GT[(size_t)m * 24 + h * 3 + 0] * o[r]; }
        const int jc = s >> 6;
        for (int j = lane; j < NSEL; j += 64) {
            float imp = 0.f;
            for (int n = 4 * j - 1; n <= 4 * j + 3; ++n) if (n >= 0 && n < nvalid) imp += (pp[n] + pp[512 + n]) + (pp[1024 + n] + pp[1536 + n]);
            float v; if (j == jc || j == 0) v = 1.0e4f; else if (64 * j <= s) v = imp; else v = -1.0f;
            sc[j] = v;
        }
        WAVE_LDS_FENCE();
        float v0 = sc[lane], v1 = sc[lane + 64];
        for (int k = 0; k < TOPN; ++k) {
            float bv; int bi;
            if (v0 >= v1) { bv = v0; bi = lane; } else { bv = v1; bi = lane + 64; }
#pragma unroll
            for (int o2 = 1; o2 < 64; o2 <<= 1) { const float ov = __shfl_xor(bv, o2); const int oi = __shfl_xor(bi, o2); if (ov > bv || (ov == bv && oi < bi)) { bv = ov; bi = oi; } }
            if (lane == 0) selidx[(size_t)it * TOPN + k] = bi;
            if (bi == lane) v0 = -3.0e38f; if (bi == lane + 64) v1 = -3.0e38f;
        }
    }
}
template <int MODE> __device__ __forceinline__ void s_sparse_attn(const Params& p, unsigned char* lds, int wave, int lane, int gw, int NGW) {
    float* wl = (float*)(lds + wave * 17472); float* qs = wl; float* pp = wl + 256; int* sel = (int*)(pp + 4 * 1024);
    const bf16* Q = (const bf16*)(p.ws + WS_Q); const bf16* KV = (const bf16*)(p.ws + WS_KV); const float* GT = (const float*)(p.ws + WS_GT);
    float* onsa = (float*)(p.ws + WS_ONSA); const int* selidx = (const int*)(p.ws + WS_MISC);
    constexpr int NCH = MODE == 0 ? 16 : 8; constexpr int KJ = MODE == 0 ? 2 : 4;
    for (int it = gw; it < TOK * 2; it += NGW) {
        const int g = it & 1, m = it >> 1, b = m >> 13, s = m & 8191;
        WAVE_LDS_FENCE();
#pragma unroll
        for (int r = 0; r < 4; ++r) qs[r * 64 + lane] = bf2f(Q[(size_t)m * 512 + (g * 4 + r) * 64 + lane]);
        if (MODE == 0 && lane < 16) sel[lane] = selidx[(size_t)it * TOPN + lane];
        WAVE_LDS_FENCE();
        float mx[4] = {-3.0e38f, -3.0e38f, -3.0e38f, -3.0e38f};
        for (int c = 0; c < NCH; ++c) {
            int kpos; bool valid;
            if (MODE == 0) { kpos = sel[c] * 64 + lane; valid = kpos <= s; } else { kpos = s - 511 + c * 64 + lane; valid = kpos >= 0; }
            const int idx = c * 64 + lane;
            if (valid) {
                const bf16* kp = KV + (size_t)(b * SEQ + kpos) * 768 + KJ * 128 + g * 64;
                float d0 = 0.f, d1 = 0.f, d2 = 0.f, d3 = 0.f;
                for (int d = 0; d < 64; ++d) { const float kv = bf2f(kp[d]); d0 = fmaf(qs[d], kv, d0); d1 = fmaf(qs[64 + d], kv, d1); d2 = fmaf(qs[128 + d], kv, d2); d3 = fmaf(qs[192 + d], kv, d3); }
                pp[idx] = d0; pp[1024 + idx] = d1; pp[2048 + idx] = d2; pp[3072 + idx] = d3;
                mx[0] = fmaxf(mx[0], d0); mx[1] = fmaxf(mx[1], d1); mx[2] = fmaxf(mx[2], d2); mx[3] = fmaxf(mx[3], d3);
            }
        }
        float sm[4];
#pragma unroll
        for (int r = 0; r < 4; ++r) { mx[r] = wave_max(mx[r]); float a = 0.f;
            for (int c = 0; c < NCH; ++c) { const int idx = c * 64 + lane; int kpos; bool valid;
                if (MODE == 0) { kpos = sel[c] * 64 + lane; valid = kpos <= s; } else { kpos = s - 511 + c * 64 + lane; valid = kpos >= 0; }
                float e = 0.f; if (valid) e = expf(pp[r * 1024 + idx] - mx[r]); pp[r * 1024 + idx] = e; a += e; }
            sm[r] = wave_sum(a); }
        WAVE_LDS_FENCE();
        float o[4] = {0.f, 0.f, 0.f, 0.f};
        for (int i = 0; i < NCH * 64; ++i) { int kpos; if (MODE == 0) kpos = sel[i >> 6] * 64 + (i & 63); else kpos = s - 511 + i;
            if (kpos < 0 || kpos > s) continue;
            const float v = bf2f(KV[(size_t)(b * SEQ + kpos) * 768 + (KJ + 1) * 128 + g * 64 + lane]);
            o[0] = fmaf(pp[i], v, o[0]); o[1] = fmaf(pp[1024 + i], v, o[1]); o[2] = fmaf(pp[2048 + i], v, o[2]); o[3] = fmaf(pp[3072 + i], v, o[3]); }
#pragma unroll
        for (int r = 0; r < 4; ++r) { const int h = g * 4 + r; const size_t oi = (size_t)m * 512 + h * 64 + lane; const float val = onsa[oi] + GT[(size_t)m * 24 + h * 3 + (MODE == 0 ? 1 : 2)] * o[r] / sm[r];
            if (MODE == 0) onsa[oi] = val; else ((bf16*)(p.ws + WS_ONSAB))[oi] = (bf16)f2bf(val); }
    }
}
__device__ __forceinline__ void s_hgrn(const Params& p, unsigned char* lds, int tid, int item) {
    float* qf = (float*)lds; float* ff = qf + 16 * 128; float* vv = ff + 16 * 128;
    const bf16* HQ = (const bf16*)(p.ws + WS_HQ); const float* HF = (const float*)(p.ws + WS_HF); const bf16* HI = (const bf16*)(p.ws + WS_HI); float* ohg = (float*)(p.ws + WS_OHG);
    const int b = item >> 2, hh = item & 3, j = tid >> 2, kq = tid & 3;
    float St[32];
#pragma unroll
    for (int i = 0; i < 32; ++i) St[i] = 0.f;
    for (int s0 = 0; s0 < SEQ; s0 += 16) {
        __syncthreads();
        for (int e = tid; e < 16 * 128; e += 512) { const int tt = e >> 7, k = e & 127; const size_t ro = (size_t)(b * SEQ + s0 + tt) * 512 + hh * 128 + k;
            qf[e] = bf2f(HQ[ro]); ff[e] = expf(HF[ro]); vv[e] = bf2f(HI[ro]); }
        __syncthreads();
        for (int tt = 0; tt < 16; ++tt) {
            const float v = vv[tt * 128 + j]; float o = 0.f;
#pragma unroll
            for (int i = 0; i < 32; ++i) { const int k = kq * 32 + i; const float f = ff[tt * 128 + k]; St[i] = fmaf(f, St[i], (1.0f - f) * v); o = fmaf(qf[tt * 128 + k], St[i], o); }
            o += __shfl_xor(o, 1); o += __shfl_xor(o, 2);
            if (kq == 0) ohg[(size_t)(b * SEQ + s0 + tt) * 512 + hh * 128 + j] = o;
        }
    }
    __syncthreads();
}
__device__ __forceinline__ void s_hg_post(const Params& p, int lane, int gw, int NGW) {
    float* ohg = (float*)(p.ws + WS_OHG); const bf16* HGs = (const bf16*)(p.ws + WS_HGS);
    for (int w = gw; w < TOK * 4; w += NGW) { const int m = w >> 2, hh = w & 3; float* o = ohg + (size_t)m * 512 + hh * 128;
        const float a = o[lane], b = o[lane + 64]; const float r = 1.0f / sqrtf(wave_sum(a * a + b * b) * (1.0f / 128.0f) + 1e-6f);
        const bf16* gr = HGs + (size_t)m * 512 + hh * 128;
        bf16* ob = (bf16*)(p.ws + WS_OHGB) + (size_t)m * 512 + hh * 128;
        ob[lane] = (bf16)f2bf(a * r * p.hg_norm[lane] * bf2f(gr[lane])); ob[lane + 64] = (bf16)f2bf(b * r * p.hg_norm[lane + 64] * bf2f(gr[lane + 64])); }
}
typedef short bf16x8_t __attribute__((ext_vector_type(8)));
typedef short v4i16_t __attribute__((ext_vector_type(4)));
__device__ __forceinline__ bf16x8_t tr_frag(const unsigned char* p0, const unsigned char* p1) {
    const v4i16_t lo = __builtin_amdgcn_ds_read_tr16_b64_v4i16((LAS v4i16_t*)p0), hi = __builtin_amdgcn_ds_read_tr16_b64_v4i16((LAS v4i16_t*)p1);
    return (bf16x8_t){lo[0], lo[1], lo[2], lo[3], hi[0], hi[1], hi[2], hi[3]};
}
constexpr int HG_BC = 0, HG_TOT = 33792;
constexpr int HG_V = 35840;
constexpr int HG_KMT = 53248;
constexpr int HG_QM = 53248, HG_QE = 70656, HG_KM = 88064, HG_AM = 105472, HG_RS = 114688;

__device__ __forceinline__ void hg_cumsum(const float* GK, unsigned char* lds, int tid) {
    float* bc = (float*)(lds + HG_BC); float* tot = (float*)(lds + HG_TOT);
    const int seg = tid >> 7, k = tid & 127; float loc[16];
#pragma unroll
    for (int i = 0; i < 16; ++i) loc[i] = GK[(size_t)(16 * seg + i) * 512 + k];
    float run = 0.f;
#pragma unroll
    for (int i = 0; i < 16; ++i) { run += loc[i]; loc[i] = run; }
    tot[seg * 128 + k] = run;
    __syncthreads();
    float add = 0.f;
    for (int s = 0; s < seg; ++s) add += tot[s * 128 + k];
#pragma unroll
    for (int i = 0; i < 16; ++i) bc[(16 * seg + i) * 132 + k] = loc[i] + add;
    __syncthreads();
}
__device__ __forceinline__ void hg_stage_v(const bf16* HI, int m0, int hh, unsigned char* lds, int tid) {
    const int row = tid >> 3, ch = tid & 7; const bf16* src = HI + (size_t)(m0 + row) * 512 + hh * 128 + 8 * ch; unsigned char* dst = lds + HG_V + row * 272 + 16 * ch;
    const v4u a = *(const v4u*)src, b = *(const v4u*)(src + 64); *(v4u*)dst = a; *(v4u*)(dst + 128) = b;
}
__device__ __forceinline__ void hg_local(const Params& p, unsigned char* lds, int tid, int wave, int lane, int bx, int G) {
    const float* HF = (const float*)(p.ws + WS_HF); const bf16* HI = (const bf16*)(p.ws + WS_HI); bf16* ST = (bf16*)(p.ws + WS_ST); float* DEC = (float*)(p.ws + WS_DEC);
    const float* bc = (const float*)(lds + HG_BC); const int kq = lane >> 4, fr = lane & 15;
    for (int it = bx; it < 1024; it += G) {
        const int b = it >> 9, hh = (it >> 7) & 3, c = it & 127, m0 = b * SEQ + c * 64;
        hg_cumsum(HF + (size_t)m0 * 512 + hh * 128, lds, tid);
        { const int seg = tid >> 7, k = tid & 127; const float ref = bc[31 * 132 + k]; unsigned w[8];
#pragma unroll
          for (int i = 0; i < 16; i += 2) { float km[2];
#pragma unroll
              for (int e = 0; e < 2; ++e) { const int s = 16 * seg + i + e; const float bs = bc[s * 132 + k]; const float prev = s > 0 ? bc[(s - 1) * 132 + k] : 0.f; km[e] = (1.0f - __expf(bs - prev)) * __expf(ref - bs); }
              w[i >> 1] = pk2(km[0], km[1]); }
          unsigned char* dst = lds + HG_KMT + k * 144 + 32 * seg; *(v4u*)dst = (v4u){w[0], w[1], w[2], w[3]}; *(v4u*)(dst + 16) = (v4u){w[4], w[5], w[6], w[7]}; }
        hg_stage_v(HI, m0, hh, lds, tid);
        if (tid < 128) DEC[(size_t)it * 128 + tid] = __expf(bc[63 * 132 + tid]);
        __syncthreads();
        f32x4 acc[8];
#pragma unroll
        for (int vt = 0; vt < 8; ++vt) acc[vt] = (f32x4){0.f, 0.f, 0.f, 0.f};
#pragma unroll
        for (int ks = 0; ks < 2; ++ks) { const bf16x8_t a = *(const bf16x8_t*)(lds + HG_KMT + (16 * wave + fr) * 144 + 64 * ks + 16 * kq);
            const unsigned char* vb = lds + HG_V + (32 * ks + 8 * kq + (fr >> 2)) * 272 + 8 * (fr & 3);
#pragma unroll
            for (int vt = 0; vt < 8; ++vt) { const bf16x8_t bfr = tr_frag(vb + 32 * vt, vb + 32 * vt + 4 * 272); acc[vt] = __builtin_amdgcn_mfma_f32_16x16x32_bf16(a, bfr, acc[vt], 0, 0, 0); } }
        float sc[4];
#pragma unroll
        for (int e = 0; e < 4; ++e) { const int k = 16 * wave + 4 * kq + e; sc[e] = __expf(bc[63 * 132 + k] - bc[31 * 132 + k]); }
#pragma unroll
        for (int vt = 0; vt < 8; ++vt) { const int v = 16 * vt + fr; const unsigned long long w = (unsigned long long)pk2(acc[vt][0] * sc[0], acc[vt][1] * sc[1]) | ((unsigned long long)pk2(acc[vt][2] * sc[2], acc[vt][3] * sc[3]) << 32);
            *(unsigned long long*)(ST + ((size_t)it * 128 + v) * 128 + 16 * wave + 4 * kq) = w; }
        __syncthreads();
    }
}
__device__ __forceinline__ void hg_scan(const Params& p, int gtid, int NGT) {
    bf16* ST = (bf16*)(p.ws + WS_ST); const float* DEC = (const float*)(p.ws + WS_DEC);
    for (int e = gtid; e < 8 * 16384; e += NGT) { const int bh = e >> 14, vk = e & 16383, k = vk & 127;
        bf16* base = ST + (size_t)bh * 128 * 16384 + vk; const float* dc = DEC + (size_t)bh * 128 * 128 + k; float S = 0.f;
#pragma unroll 8
        for (int c = 0; c < 128; ++c) { const float tmp = bf2f(base[(size_t)c * 16384]); base[(size_t)c * 16384] = (bf16)f2bf(S); S = dc[c * 128] * S + tmp; } }
}
template <bool DBG> __device__ __forceinline__ void hg_out(const Params& p, unsigned char* lds, int tid, int wave, int lane, int bx, int G, float& dnum, float& dden) {
    const float* HF = (const float*)(p.ws + WS_HF); const bf16* HI = (const bf16*)(p.ws + WS_HI); const bf16* HQ = (const bf16*)(p.ws + WS_HQ); const bf16* HGs = (const bf16*)(p.ws + WS_HGS);
    const bf16* ST = (const bf16*)(p.ws + WS_ST); bf16* OHGB = (bf16*)(p.ws + WS_OHGB);
    const float* bc = (const float*)(lds + HG_BC); float* RS = (float*)(lds + HG_RS); const int kq = lane >> 4, fr = lane & 15;
    for (int it = bx; it < 1024; it += G) {
        const int b = it >> 9, hh = (it >> 7) & 3, c = it & 127, m0 = b * SEQ + c * 64;
        hg_cumsum(HF + (size_t)m0 * 512 + hh * 128, lds, tid);
        { const int seg = tid >> 7, k = tid & 127; const float ref = bc[31 * 132 + k];
#pragma unroll 4
          for (int i = 0; i < 16; ++i) { const int t = 16 * seg + i; const float bt = bc[t * 132 + k]; const float prev = t > 0 ? bc[(t - 1) * 132 + k] : 0.f; const float q = bf2f(HQ[(size_t)(m0 + t) * 512 + hh * 128 + k]);
              const float em = __expf(bt - ref);
              *(bf16*)(lds + HG_QM + t * 272 + 2 * k) = (bf16)f2bf(q * em); *(bf16*)(lds + HG_QE + t * 272 + 2 * k) = (bf16)f2bf(q * __expf(bt));
              *(bf16*)(lds + HG_KM + t * 272 + 2 * k) = (bf16)f2bf((1.0f - __expf(bt - prev)) * __builtin_amdgcn_rcpf(em)); } }
        hg_stage_v(HI, m0, hh, lds, tid);
        __syncthreads();
        const int tt = wave >> 1;
        {
#pragma unroll
            for (int si = 0; si < 2; ++si) { const int st = 2 * (wave & 1) + si; f32x4 a4 = (f32x4){0.f, 0.f, 0.f, 0.f};
#pragma unroll
                for (int ks = 0; ks < 4; ++ks) { const bf16x8_t a = *(const bf16x8_t*)(lds + HG_QM + (16 * tt + fr) * 272 + 64 * ks + 16 * kq), bb = *(const bf16x8_t*)(lds + HG_KM + (16 * st + fr) * 272 + 64 * ks + 16 * kq);
                    a4 = __builtin_amdgcn_mfma_f32_16x16x32_bf16(a, bb, a4, 0, 0, 0); }
#pragma unroll
                for (int e = 0; e < 4; ++e) { const int t = 16 * tt + 4 * kq + e, s = 16 * st + fr; *(bf16*)(lds + HG_AM + t * 144 + 2 * s) = (bf16)f2bf(s <= t ? a4[e] : 0.f); } }
        }
        __syncthreads();
        f32x4 acc[4]; const int vh = wave & 1; const bf16* Sit = ST + (size_t)it * 16384;
#pragma unroll
        for (int vt = 0; vt < 4; ++vt) acc[vt] = (f32x4){0.f, 0.f, 0.f, 0.f};
#pragma unroll
        for (int ks = 0; ks < 4; ++ks) { const bf16x8_t a = *(const bf16x8_t*)(lds + HG_QE + (16 * tt + fr) * 272 + 64 * ks + 16 * kq);
#pragma unroll
            for (int vt = 0; vt < 4; ++vt) { const bf16x8_t bb = *(const bf16x8_t*)(Sit + (size_t)(64 * vh + 16 * vt + fr) * 128 + 32 * ks + 8 * kq); acc[vt] = __builtin_amdgcn_mfma_f32_16x16x32_bf16(a, bb, acc[vt], 0, 0, 0); } }
#pragma unroll
        for (int ks = 0; ks < 2; ++ks) { const bf16x8_t a = *(const bf16x8_t*)(lds + HG_AM + (16 * tt + fr) * 144 + 64 * ks + 16 * kq);
            const unsigned char* vb = lds + HG_V + (32 * ks + 8 * kq + (fr >> 2)) * 272 + 8 * (fr & 3) + 128 * vh;
#pragma unroll
            for (int vt = 0; vt < 4; ++vt) { const bf16x8_t bfr = tr_frag(vb + 32 * vt, vb + 32 * vt + 4 * 272); acc[vt] = __builtin_amdgcn_mfma_f32_16x16x32_bf16(a, bfr, acc[vt], 0, 0, 0); } }
        float ss[4];
#pragma unroll
        for (int e = 0; e < 4; ++e) { float s = 0.f;
#pragma unroll
            for (int vt = 0; vt < 4; ++vt) s += acc[vt][e] * acc[vt][e];
            s += __shfl_xor(s, 1); s += __shfl_xor(s, 2); s += __shfl_xor(s, 4); s += __shfl_xor(s, 8); ss[e] = s; }
        if (fr == 0) {
#pragma unroll
            for (int e = 0; e < 4; ++e) RS[(16 * tt + 4 * kq + e) * 2 + vh] = ss[e]; }
        __syncthreads();
#pragma unroll
        for (int e = 0; e < 4; ++e) { const int t = 16 * tt + 4 * kq + e; const float rinv = 1.0f / sqrtf((RS[t * 2] + RS[t * 2 + 1]) * (1.0f / 128.0f) + 1e-6f);
#pragma unroll
            for (int vt = 0; vt < 4; ++vt) { const int v = 64 * vh + 16 * vt + fr; const size_t oi = (size_t)(m0 + t) * 512 + hh * 128 + v; const float val = acc[vt][e] * rinv * p.hg_norm[v] * bf2f(HGs[oi]);
                if (DBG) { const float rf = bf2f(OHGB[oi]); dnum += (val - rf) * (val - rf); dden += rf * rf; } else OHGB[oi] = (bf16)f2bf(val); } }
        __syncthreads();
    }
}
__device__ __forceinline__ void f_router(const Params& p, unsigned char* lds, int wave, int lane, int gw, int NGW) {
    { float* scr = (float*)(lds + wave * 8448); bf16* Wd_t = (bf16*)(p.ws + WS_WD); bf16* Wgu_t = (bf16*)(p.ws + WS_WGU);
      for (int r = gw; r < NE * 8 * 32; r += NGW) { const int e = r >> 8, rem = r & 255, kb = rem >> 5, nb = rem & 31; const float* W = p.w_down + (size_t)e * FF * DM;
          tr_item([W](int k, int n) { return W[(size_t)k * DM + n]; }, FF, Wd_t + (size_t)e * DM * FF, 32 * nb, 64 * kb, scr, lane); }
      for (int r = gw; r < NE * 16 * 32; r += NGW) { const int e = r >> 9, rem = r & 511, kb = rem >> 5, nb = rem & 31; const int n0 = 32 * nb, which = (n0 >> 7) & 1, cb = (n0 >> 8) * 128 + (n0 & 127) - n0;
          const float* W = (which ? p.w_up : p.w_gate) + (size_t)e * DM * FF;
          tr_item([W, cb](int k, int n) { return W[(size_t)k * FF + n + cb]; }, DM, Wgu_t + (size_t)e * 1024 * DM, n0, 64 * kb, scr, lane); } }
    __syncthreads();
    float* lg = (float*)(lds + wave * 4096); float* rr = lg + 16 * 48;
    const bf16* Wh = (const bf16*)(p.ws + WS_SMALL + OFF_WRH); const bf16* Wl = (const bf16*)(p.ws + WS_SMALL + OFF_WRL);
    int* eid = (int*)(p.ws + WS_MISC + M_EID); float* ew = (float*)(p.ws + WS_MISC + M_EW); int* slot = (int*)(p.ws + WS_MISC + M_SLOT); float* rinv = (float*)(p.ws + WS_MISC + M_RINV);
    int* cnt = (int*)(p.ws + WS_CTL) + CW_CNT;
    const int row = lane & 15, kq = lane >> 4;
    for (int it = gw; it < TOK / 16; it += NGW) {
        const int m0 = it * 16; const float* xr = p.out + (size_t)(m0 + row) * DM;
        f32x4 acc[3]; acc[0] = (f32x4){0.f, 0.f, 0.f, 0.f}; acc[1] = acc[0]; acc[2] = acc[0]; float ss = 0.f;
        for (int s = 0; s < 32; ++s) { const int k0 = 32 * s + 8 * kq;
            const f32x4 x0 = *(const f32x4*)(xr + k0), x1 = *(const f32x4*)(xr + k0 + 4); const f32x4 g0 = *(const f32x4*)(p.ffn_norm + k0), g1 = *(const f32x4*)(p.ffn_norm + k0 + 4);
            ss += (x0.x * x0.x + x0.y * x0.y) + (x0.z * x0.z + x0.w * x0.w) + (x1.x * x1.x + x1.y * x1.y) + (x1.z * x1.z + x1.w * x1.w);
            const f32x4 y0 = x0 * g0, y1 = x1 * g1; bf16x8_t ah, al;
#pragma unroll
            for (int j = 0; j < 4; ++j) { unsigned h = f2bf(y0[j]); ah[j] = (short)h; al[j] = (short)f2bf(y0[j] - __builtin_bit_cast(float, h << 16)); h = f2bf(y1[j]); ah[4 + j] = (short)h; al[4 + j] = (short)f2bf(y1[j] - __builtin_bit_cast(float, h << 16)); }
#pragma unroll
            for (int ct = 0; ct < 3; ++ct) { const bf16x8_t bh = *(const bf16x8_t*)(Wh + (size_t)(16 * ct + row) * DM + k0), bl = *(const bf16x8_t*)(Wl + (size_t)(16 * ct + row) * DM + k0);
                acc[ct] = __builtin_amdgcn_mfma_f32_16x16x32_bf16(ah, bh, acc[ct], 0, 0, 0); acc[ct] = __builtin_amdgcn_mfma_f32_16x16x32_bf16(ah, bl, acc[ct], 0, 0, 0); acc[ct] = __builtin_amdgcn_mfma_f32_16x16x32_bf16(al, bh, acc[ct], 0, 0, 0); } }
        ss += __shfl_xor(ss, 16); ss += __shfl_xor(ss, 32);
        const float ri = 1.0f / sqrtf(ss * (1.0f / DM) + 1e-6f);
        WAVE_LDS_FENCE();
        if (kq == 0) rr[row] = ri;
#pragma unroll
        for (int ct = 0; ct < 3; ++ct)
#pragma unroll
            for (int e = 0; e < 4; ++e) lg[(4 * kq + e) * 48 + 16 * ct + row] = acc[ct][e];
        WAVE_LDS_FENCE();
        if (lane < 16) { const int m = m0 + lane; const float rv = rr[lane]; const float* L = lg + lane * 48;
            float gl[4]; int gs = 0;
#pragma unroll
            for (int i = 0; i < 4; ++i) gl[i] = L[i] * rv + p.b_grp[i];
            float gm = gl[0];
#pragma unroll
            for (int i = 1; i < 4; ++i) if (gl[i] > gm) { gm = gl[i]; gs = i; }
            float den = 0.f;
#pragma unroll
            for (int i = 0; i < 4; ++i) den += expf(gl[i] - gm);
            const float gp = 1.0f / den;
            float el[8];
#pragma unroll
            for (int i = 0; i < 8; ++i) el[i] = L[4 + gs * 8 + i] * rv + p.b_rtr[gs * 8 + i];
            int i0 = 0; float b0 = el[0];
#pragma unroll
            for (int i = 1; i < 8; ++i) if (el[i] > b0) { b0 = el[i]; i0 = i; }
            int i1 = -1; float b1 = -3.0e38f;
#pragma unroll
            for (int i = 0; i < 8; ++i) if (i != i0 && el[i] > b1) { b1 = el[i]; i1 = i; }
            const float e1 = expf(b1 - b0); const float w0 = 1.0f / (1.0f + e1), w1 = e1 / (1.0f + e1);
            const int ea = gs * 8 + i0, eb = gs * 8 + i1;
            eid[m * 2] = ea; eid[m * 2 + 1] = eb; ew[m * 2] = w0 * gp; ew[m * 2 + 1] = w1 * gp; rinv[m] = rv;
            slot[m * 2] = atomicAdd(&cnt[ea], 1); slot[m * 2 + 1] = atomicAdd(&cnt[eb], 1); }
    }
}
__device__ __forceinline__ void f_fill(const Params& p, volatile LAS unsigned* MISC, int tid, int lane, int gw, int NGW) {
    const int* cnt = (const int*)(p.ws + WS_CTL) + CW_CNT;
    if (tid == 0) { unsigned a = 0; for (int q = 0; q < NE; ++q) { MISC[MISC_TP + q] = a; a += ((unsigned)__hip_atomic_load(cnt + q, __ATOMIC_RELAXED, __HIP_MEMORY_SCOPE_AGENT) + 255u) >> 8; } MISC[MISC_TP + NE] = a; }
    __syncthreads();
    const int* eid = (const int*)(p.ws + WS_MISC + M_EID); const int* slot = (const int*)(p.ws + WS_MISC + M_SLOT); int* pos = (int*)(p.ws + WS_MISC + M_POS);
    const float* rinv = (const float*)(p.ws + WS_MISC + M_RINV); float* rs = (float*)(p.ws + WS_MISC + M_RS); bf16* H2S = (bf16*)(p.ws + WS_H2S);
    for (int m = gw; m < TOK; m += NGW) {
        const int ra = (int)MISC[MISC_TP + eid[2 * m]] * 256 + slot[2 * m], rb = (int)MISC[MISC_TP + eid[2 * m + 1]] * 256 + slot[2 * m + 1];
        if (lane == 0) { pos[2 * m] = ra; pos[2 * m + 1] = rb; const float rv = rinv[m]; rs[ra] = rv; rs[rb] = rv; }
        const f32x4* xr = (const f32x4*)(p.out + (size_t)m * DM) + lane; const f32x4* gr = (const f32x4*)p.ffn_norm + lane;
        unsigned long long* oa = (unsigned long long*)(H2S + (size_t)ra * DM) + lane; unsigned long long* ob = (unsigned long long*)(H2S + (size_t)rb * DM) + lane;
#pragma unroll
        for (int j = 0; j < 4; ++j) { const f32x4 v = xr[64 * j] * gr[64 * j]; const unsigned long long w = (unsigned long long)pk2(v.x, v.y) | ((unsigned long long)pk2(v.z, v.w) << 32); oa[64 * j] = w; ob[64 * j] = w; }
    }
}
__device__ __forceinline__ void f_final(const Params& p, int lane, int gw, int NGW) {
    const bf16* Y = (const bf16*)(p.ws + WS_YB); const int* eid = (const int*)(p.ws + WS_MISC + M_EID); const float* ew = (const float*)(p.ws + WS_MISC + M_EW); const int* pos = (const int*)(p.ws + WS_MISC + M_POS);
    for (int t = gw; t < TOK; t += NGW) {
        int a = 0, b = 1; if (eid[t * 2 + 1] < eid[t * 2]) { a = 1; b = 0; }
        const float wa = ew[t * 2 + a], wb = ew[t * 2 + b];
        const unsigned long long* ya = (const unsigned long long*)(Y + (size_t)pos[t * 2 + a] * DM) + lane; const unsigned long long* yb = (const unsigned long long*)(Y + (size_t)pos[t * 2 + b] * DM) + lane;
        f32x4* xr = (f32x4*)(p.out + (size_t)t * DM) + lane; const f32x4* gr = (const f32x4*)p.final_norm + lane;
        f32x4 v[4]; float s = 0.f;
#pragma unroll
        for (int j = 0; j < 4; ++j) { const unsigned long long qa = ya[64 * j], qb = yb[64 * j]; const unsigned a0 = (unsigned)qa, a1 = (unsigned)(qa >> 32), b0 = (unsigned)qb, b1 = (unsigned)(qb >> 32);
            f32x4 fa, fb; fa.x = __builtin_bit_cast(float, a0 << 16); fa.y = __builtin_bit_cast(float, a0 & 0xffff0000u); fa.z = __builtin_bit_cast(float, a1 << 16); fa.w = __builtin_bit_cast(float, a1 & 0xffff0000u);
            fb.x = __builtin_bit_cast(float, b0 << 16); fb.y = __builtin_bit_cast(float, b0 & 0xffff0000u); fb.z = __builtin_bit_cast(float, b1 << 16); fb.w = __builtin_bit_cast(float, b1 & 0xffff0000u);
            v[j] = xr[64 * j] + (fa * wa + fb * wb); s += (v[j].x * v[j].x + v[j].y * v[j].y) + (v[j].z * v[j].z + v[j].w * v[j].w); }
        float r = 1.0f / sqrtf(wave_sum(s) * (1.0f / DM) + 1e-6f);
        if (DBG_MODE) { const float* dp = (const float*)(p.ws + WS_CTL) + CW_DBG; float num = 0.f, den = 0.f; for (int q = 0; q < 256; ++q) { num += dp[2 * q]; den += dp[2 * q + 1]; } r *= 1.0f + 10.0f * sqrtf(num / den); }
#pragma unroll
        for (int j = 0; j < 4; ++j) { const f32x4 g = gr[64 * j]; f32x4 w; w.x = v[j].x * r * g.x; w.y = v[j].y * r * g.y; w.z = v[j].z * r * g.z; w.w = v[j].w * r * g.w; xr[64 * j] = w; }
    }
}

struct Args { Params p; int pad0, pad1; };
__global__ void __launch_bounds__(NWAVES * 64, 2) mk_fwd(Args args) {
    extern __shared__ __attribute__((aligned(16))) unsigned char lds[];
    const Params& p = args.p;
    const int tid = threadIdx.x, lane = tid & 63, wave = __builtin_amdgcn_readfirstlane(tid >> 6);
    const int G = gridDim.x; const int bx = blockIdx.x; const int vcu = (G % 8 == 0) ? (bx % 8) * (G / 8) + bx / 8 : bx;
    const int gw = vcu * NWAVES + wave, NGW = G * NWAVES, gtid = bx * (NWAVES * 64) + tid, NGT = G * NWAVES * 64;
    volatile LAS unsigned* MISC = (volatile LAS unsigned*)((LAS unsigned char*)lds + MISC_OFF);
    for (int u = tid; u < (LDS_BYTES - MISC_OFF) / 4; u += NWAVES * 64) ((LAS unsigned*)((LAS unsigned char*)lds + MISC_OFF))[u] = 0u;
    __syncthreads();
    gu32* ctl = (gu32*)(p.ws + WS_CTL);
    XcdBarrier bar = xcd_barrier_post((unsigned*)(ctl + CW_BAR), MISC + 8);
#define GRID_BAR() xcd_barrier(bar)

    p0_prologue(p, lds, wave, lane, gw, NGW, gtid, NGT);
    GRID_BAR();
    {
        pg8::Gemm g{(const pg8::bf16_t*)(p.ws + WS_XN), (const pg8::bf16_t*)(p.ws + WS_WIN), TOK, NPROJ, DM, nullptr, nullptr}; pg8::StaticOrder S; S.init(TOK, NPROJ, G, bx);
        pg8::EpiProj E{(pg8::bf16_t*)(p.ws + WS_Q), (pg8::bf16_t*)(p.ws + WS_KV), (pg8::bf16_t*)(p.ws + WS_HQ), (pg8::bf16_t*)(p.ws + WS_HI), (pg8::bf16_t*)(p.ws + WS_HGS), (pg8::bf16_t*)p.out,
                       (float*)(p.ws + WS_HF), (float*)(p.ws + WS_GT), (const float*)(p.ws + WS_SMALL), (const float*)(p.ws + WS_SMALL + 65536)};
        pg8::gemm_phase<pg8::EpiProj, pg8::StaticOrder, true, true>((LAS unsigned char*)lds, g, S, E);
    }
    GRID_BAR();
    s_compress(p, lane, gw, NGW);
    hg_local(p, lds, tid, wave, lane, bx, G);
    GRID_BAR();
    hg_scan(p, gtid, NGT);
#if DBG_MODE == 1
    if (bx < 8) s_hgrn(p, lds, tid, bx);
#endif
    s_cmp_attn(p, lds, wave, lane, gw, NGW);
    GRID_BAR();
    s_sparse_attn<0>(p, lds, wave, lane, gw, NGW);
#if DBG_MODE != 1
    __syncthreads();
    { float dn = 0.f, dd = 0.f; hg_out<false>(p, lds, tid, wave, lane, bx, G, dn, dd); }
#endif
    GRID_BAR();
    s_sparse_attn<1>(p, lds, wave, lane, gw, NGW);
#if DBG_MODE == 1
    s_hg_post(p, lane, gw, NGW);
#endif
    GRID_BAR();
#if DBG_MODE == 1
    { float dn = 0.f, dd = 0.f; hg_out<true>(p, lds, tid, wave, lane, bx, G, dn, dd);
      dn = wave_sum(dn); dd = wave_sum(dd); float* red = (float*)lds; __syncthreads(); if (lane == 0) { red[2 * wave] = dn; red[2 * wave + 1] = dd; } __syncthreads();
      if (tid == 0) { float a = 0.f, b2 = 0.f; for (int q = 0; q < 8; ++q) { a += red[2 * q]; b2 += red[2 * q + 1]; } float* dp = (float*)(p.ws + WS_CTL) + CW_DBG; dp[2 * bx] = a; dp[2 * bx + 1] = b2; }
      __syncthreads(); }
    GRID_BAR();
#endif
    {
        pg8::Gemm g{(const pg8::bf16_t*)(p.ws + WS_ONSAB), (const pg8::bf16_t*)(p.ws + WS_WBRN), TOK, DM, 512, (const pg8::bf16_t*)(p.ws + WS_OHGB), (const pg8::bf16_t*)(p.ws + WS_WBRH)};
        pg8::MergeOrder S; S.init(TOK, DM, G, bx); pg8::EpiMerge E{(const pg8::bf16_t*)p.out, (pg8::bf16_t*)(p.ws + WS_MIX)};
        pg8::gemm_phase<pg8::EpiMerge, pg8::MergeOrder, true, true>((LAS unsigned char*)lds, g, S, E);
    }
    GRID_BAR();
    {
        pg8::Gemm g{(const pg8::bf16_t*)(p.ws + WS_MIX), (const pg8::bf16_t*)(p.ws + WS_WOUT), TOK, DM, DM, nullptr, nullptr};
        pg8::StaticOrder S; S.init(TOK, DM, G, bx); pg8::EpiOut E{p.x, p.out};
        pg8::gemm_phase<pg8::EpiOut, pg8::StaticOrder, true, true>((LAS unsigned char*)lds, g, S, E);
    }
    GRID_BAR();
    f_router(p, lds, wave, lane, gw, NGW);
    GRID_BAR();
    f_fill(p, MISC, tid, lane, gw, NGW);
    GRID_BAR();
    {
        pg8::MoeOrder S{(const volatile PG8_LAS int*)(MISC + MISC_TP), G, bx};
        { pg8::Gemm g{(const pg8::bf16_t*)(p.ws + WS_H2S), (const pg8::bf16_t*)(p.ws + WS_WGU), R_PAD, NE * 1024, DM, nullptr, nullptr};
          pg8::EpiGU E{(const float*)(p.ws + WS_MISC + M_RS), (pg8::bf16_t*)(p.ws + WS_HID)};
          pg8::gemm_phase<pg8::EpiGU, pg8::MoeOrder, true, true>((LAS unsigned char*)lds, g, S, E); }
        GRID_BAR();
        { pg8::Gemm g{(const pg8::bf16_t*)(p.ws + WS_HID), (const pg8::bf16_t*)(p.ws + WS_WD), R_PAD, NE * 1024, FF, nullptr, nullptr};
          pg8::EpiDown E{(pg8::bf16_t*)(p.ws + WS_YB)};
          pg8::gemm_phase<pg8::EpiDown, pg8::MoeOrder, true, true>((LAS unsigned char*)lds, g, S, E); }
    }
    GRID_BAR();
    f_final(p, lane, gw, NGW);
}

extern "C" void kernel_launch(void* const* d_in, const int* in_sizes, int n_in, void* d_out, int out_size, void* d_ws, size_t ws_size, hipStream_t stream) {
    static int grid = 0;
    if (grid == 0) {
        if (n_in != 20 || out_size != TOK * DM || ws_size < WS_END) { fprintf(stderr, "kernel_launch: unexpected problem (n_in %d, out %d, ws %zu)\n", n_in, out_size, ws_size); grid = -1; return; }
        int dev = 0, cus = 0, per_cu = 0;
        if (hipGetDevice(&dev) != hipSuccess || hipDeviceGetAttribute(&cus, hipDeviceAttributeMultiprocessorCount, dev) != hipSuccess) { grid = -1; return; }
        if (hipFuncSetAttribute((const void*)mk_fwd, hipFuncAttributeMaxDynamicSharedMemorySize, LDS_BYTES) != hipSuccess) { fprintf(stderr, "kernel_launch: hipFuncSetAttribute failed\n"); grid = -1; return; }
        if (hipOccupancyMaxActiveBlocksPerMultiprocessor(&per_cu, (const void*)mk_fwd, NWAVES * 64, LDS_BYTES) != hipSuccess || per_cu < 1) { fprintf(stderr, "kernel_launch: occupancy query says %d\n", per_cu); }
        (void)hipGetLastError();
        grid = cus;
    }
    if (grid < 0) return;
    if (hipMemsetAsync((char*)d_ws + WS_CTL, 0, CTL_ZERO_BYTES, stream) != hipSuccess) { fprintf(stderr, "kernel_launch: memset failed\n"); return; }
    Args a{};
    Params& p = a.p;
    p.x = (const float*)d_in[0]; p.attn_norm = (const float*)d_in[1]; p.w_in = (const float*)d_in[2]; p.w_cmp_k = (const float*)d_in[3]; p.w_cmp_v = (const float*)d_in[4]; p.cmp_pos = (const float*)d_in[5];
    p.hg_lb = (const float*)d_in[6]; p.hg_norm = (const float*)d_in[7]; p.w_br_nsa = (const float*)d_in[8]; p.w_br_hg = (const float*)d_in[9]; p.w_out = (const float*)d_in[10]; p.ffn_norm = (const float*)d_in[11];
    p.w_grp = (const float*)d_in[12]; p.b_grp = (const float*)d_in[13]; p.w_rtr = (const float*)d_in[14]; p.b_rtr = (const float*)d_in[15]; p.w_gate = (const float*)d_in[16]; p.w_up = (const float*)d_in[17];
    p.w_down = (const float*)d_in[18]; p.final_norm = (const float*)d_in[19]; p.out = (float*)d_out; p.ws = (unsigned char*)d_ws;
    hipLaunchKernelGGL(mk_fwd, dim3(grid), dim3(NWAVES * 64), LDS_BYTES, stream, a);
}
```

```cpp
#include <hip/hip_runtime.h>
#include <cstdio>
#include <cstdint>
namespace pg8 {
#define PG8_LAS __attribute__((address_space(3)))
typedef unsigned short bf16_t;
typedef short bf16x8 __attribute__((ext_vector_type(8)));
typedef float f32x4 __attribute__((ext_vector_type(4)));
typedef unsigned u32x4 __attribute__((ext_vector_type(4)));
constexpr int BM = 256, BK = 64, HALF = 128, HTB = HALF * BK * 2  , STAGE_BYTES = 8 * HTB, NXCD = 8, WGM = 8;

__host__ __device__ __forceinline__ int lds_byte(int r, int c) { const int st = (r >> 4) * 2 + (c >> 5), rr = r & 15, cc = c & 31, ob = rr * 64 + cc * 2; return st * 1024 + (ob ^ (((ob >> 9) & 1) << 5)); }
__host__ __device__ __forceinline__ void stage_rc(int b, int& R, int& C) { const int st = b / 1024, sb = b % 1024, swz = sb ^ (((sb >> 9) & 1) << 5); R = (st >> 1) * 16 + swz / 64; C = (st & 1) * 32 + (swz % 64) / 2; }
__host__ __device__ __forceinline__ int perm32(int rho) { const int n = rho >> 4, i = rho & 15; return 8 * (i >> 2) + 4 * n + (i & 3); }

struct Unit { int pm, pn, sel; };
struct Gemm { const bf16_t* A; const bf16_t* Bt; int M, N, K; const bf16_t* A2; const bf16_t* Bt2; };

struct StaticOrder {
    int nM, nN, nwg, G, c;
    __host__ __device__ void init(int M, int N, int G_, int c_) { nM = M / BM; nN = N / BM; nwg = nM * nN; G = G_; c = c_; }
    __host__ __device__ bool next(int i, Unit& u) const {
        const long L = (long)i * G + c; if (L >= nwg) return false;
        int wgid = (int)L; { const int q = nwg / NXCD, r = nwg % NXCD, xcd = wgid % NXCD, off = wgid / NXCD; wgid = (xcd < r ? xcd * (q + 1) : r * (q + 1) + (xcd - r) * q) + off; }
        const int nig = WGM * nN, gid = wgid / nig, fm = gid * WGM, gsz = (nM - fm) < WGM ? (nM - fm) : WGM;
        u.pm = fm + ((wgid % nig) % gsz); u.pn = (wgid % nig) / gsz; u.sel = 0; return true;
    }
    __device__ __forceinline__ void a_ready(const Unit&) const {}
    __device__ __forceinline__ void done(const Unit&) const {}
};

__device__ __forceinline__ unsigned cvt_pk_bf16(float lo, float hi) { unsigned r; asm volatile("v_cvt_pk_bf16_f32 %0, %1, %2" : "=v"(r) : "v"(lo), "v"(hi)); return r; }
__device__ __forceinline__ float sigm(float x) { return __builtin_amdgcn_rcpf(1.0f + __expf(-x)); }
__device__ __forceinline__ void rot2(float& a, float& b, float c, float s) { const float t1 = a, t2 = b; a = t1 * c - t2 * s; b = t2 * c + t1 * s; }
__device__ __forceinline__ void st_bf16x8(bf16_t* dst, const float (&v)[8]) { u32x4 w; w.x = cvt_pk_bf16(v[0], v[1]); w.y = cvt_pk_bf16(v[2], v[3]); w.z = cvt_pk_bf16(v[4], v[5]); w.w = cvt_pk_bf16(v[6], v[7]); *(u32x4*)dst = w; }
struct EpiProj {
    static constexpr bool PERM = true, AFTER_DRAIN = false;
    __device__ __forceinline__ bool keep(const Unit&) const { return false; }
    bf16_t *Q, *KV, *HQ, *HI, *HGs, *MG; float *HF, *GT; const float* lb; const float* rope;
    __device__ __forceinline__ void operator()(const f32x4 (&acc)[2][2][4][2], const Unit& u, int wr, int wc, int fr, int fq) const {
        const int pn = u.pn; int row0 = u.pm * BM + wr * 64 + fr; int cw = wc * 32 + 8 * fq; asm volatile("" : "+v"(row0), "+v"(cw));
#pragma unroll
        for (int ai = 0; ai < 2; ++ai)
#pragma unroll
            for (int m = 0; m < 4; ++m) {
                const int row = row0 + ai * HALF + m * 16; const int pos = row & 8191;
#pragma unroll
                for (int bj = 0; bj < 2; ++bj) {
                    float v[8];
#pragma unroll
                    for (int e = 0; e < 4; ++e) { v[e] = acc[ai][bj][m][0][e]; v[4 + e] = acc[ai][bj][m][1][e]; }
                    const int c = bj * HALF + cw;
                    if (pn < 5) {
                        bool dorope; bf16_t* dst; float sc; int col;
                        if (pn < 2) { col = pn * 256 + c; dorope = (col & 63) < 16; dst = Q + (size_t)row * 512 + col; sc = 0.125f; }
                        else { col = (pn - 2) * 256 + c; const int j = col >> 7; dorope = ((col & 63) < 16) && (j == 2 || j == 4); dst = KV + (size_t)row * 768 + col; sc = 1.0f; }
                        if (dorope) { const int i0 = (col & 63) >> 1; const float* rp = rope + (size_t)pos * 16 + i0 * 2;
                            const f32x4 r0 = *(const f32x4*)rp; const f32x4 r1 = *(const f32x4*)(rp + 4);
                            rot2(v[0], v[1], r0[0], r0[1]); rot2(v[2], v[3], r0[2], r0[3]); rot2(v[4], v[5], r1[0], r1[1]); rot2(v[6], v[7], r1[2], r1[3]); }
#pragma unroll
                        for (int e = 0; e < 8; ++e) v[e] *= sc;
                        st_bf16x8(dst, v);
                    } else if (pn < 7) { st_bf16x8(HQ + (size_t)row * 512 + (pn - 5) * 256 + c, v);
                    } else if (pn < 9) { const int cc = (pn - 7) * 256 + c; const f32x4 l0 = *(const f32x4*)(lb + cc), l1 = *(const f32x4*)(lb + cc + 4);
                        f32x4 o0, o1;
#pragma unroll
                        for (int e = 0; e < 4; ++e) { o0[e] = __logf(l0[e] + (1.0f - l0[e]) * sigm(v[e])); o1[e] = __logf(l1[e] + (1.0f - l1[e]) * sigm(v[4 + e])); }
                        float* d = HF + (size_t)row * 512 + cc; *(f32x4*)d = o0; *(f32x4*)(d + 4) = o1;
                    } else if (pn < 11) { st_bf16x8(HI + (size_t)row * 512 + (pn - 9) * 256 + c, v);
                    } else if (pn < 13) {
#pragma unroll
                        for (int e = 0; e < 8; ++e) v[e] = v[e] * sigm(v[e]);
                        st_bf16x8(HGs + (size_t)row * 512 + (pn - 11) * 256 + c, v);
                    } else if (pn < 21) {
#pragma unroll
                        for (int e = 0; e < 8; ++e) v[e] = sigm(v[e]);
                        st_bf16x8(MG + (size_t)row * 2048 + (pn - 13) * 256 + c, v);
                    } else { if (c < 24) { f32x4 o0, o1;
#pragma unroll
                            for (int e = 0; e < 4; ++e) { o0[e] = sigm(v[e]); o1[e] = sigm(v[4 + e]); }
                            float* d = GT + (size_t)row * 24 + c; *(f32x4*)d = o0; *(f32x4*)(d + 4) = o1; } }
                }
            }
    }
};

__device__ __forceinline__ void ld_bf16x8(const bf16_t* src, float (&v)[8]) { const u32x4 w = *(const u32x4*)src;
    v[0] = __builtin_bit_cast(float, w.x << 16); v[1] = __builtin_bit_cast(float, w.x & 0xffff0000u); v[2] = __builtin_bit_cast(float, w.y << 16); v[3] = __builtin_bit_cast(float, w.y & 0xffff0000u);
    v[4] = __builtin_bit_cast(float, w.z << 16); v[5] = __builtin_bit_cast(float, w.z & 0xffff0000u); v[6] = __builtin_bit_cast(float, w.w << 16); v[7] = __builtin_bit_cast(float, w.w & 0xffff0000u); }
struct MergeOrder {
    StaticOrder so;
    __device__ void init(int M, int N, int G, int c) { so.init(M, N, G, c); }
    __device__ bool next(int i, Unit& u) const { if (!so.next(i >> 1, u)) return false; u.sel = i & 1; return true; }
    __device__ __forceinline__ void a_ready(const Unit&) const {}
    __device__ __forceinline__ void done(const Unit&) const {}
};
struct EpiMerge {
    static constexpr bool PERM = true, AFTER_DRAIN = false;
    __device__ __forceinline__ bool keep(const Unit&) const { return false; }
    const bf16_t* MG; bf16_t* MIX;
    __device__ __forceinline__ void operator()(const f32x4 (&acc)[2][2][4][2], const Unit& u, int wr, int wc, int fr, int fq) const {
        int row0 = u.pm * BM + wr * 64 + fr; int col0 = u.pn * BM + wc * 32 + 8 * fq; asm volatile("" : "+v"(row0), "+v"(col0));
#pragma unroll
        for (int ai = 0; ai < 2; ++ai)
#pragma unroll
            for (int m = 0; m < 4; ++m) { const int row = row0 + ai * HALF + m * 16;
#pragma unroll
                for (int bj = 0; bj < 2; ++bj) { const int col = col0 + bj * HALF;
                    float g[8], v[8]; ld_bf16x8(MG + (size_t)row * 2048 + (u.sel ? 1024 : 0) + col, g);
#pragma unroll
                    for (int e = 0; e < 4; ++e) { v[e] = acc[ai][bj][m][0][e] * g[e]; v[4 + e] = acc[ai][bj][m][1][e] * g[4 + e]; }
                    bf16_t* dst = MIX + (size_t)row * 1024 + col;
                    if (u.sel) { float o[8]; ld_bf16x8(dst, o);
#pragma unroll
                        for (int e = 0; e < 8; ++e) v[e] += o[e]; }
                    st_bf16x8(dst, v); } }
    }
};
struct EpiOut {
    static constexpr bool PERM = false, AFTER_DRAIN = false;
    __device__ __forceinline__ bool keep(const Unit&) const { return false; }
    const float* X; float* O;
    __device__ __forceinline__ void operator()(const f32x4 (&acc)[2][2][4][2], const Unit& u, int wr, int wc, int fr, int fq) const {
        int row0 = u.pm * BM + wr * 64 + fr; int col0 = u.pn * BM + wc * 32 + 4 * fq; asm volatile("" : "+v"(row0), "+v"(col0));
#pragma unroll
        for (int ai = 0; ai < 2; ++ai)
#pragma unroll
            for (int m = 0; m < 4; ++m) { const size_t ro = (size_t)(row0 + ai * HALF + m * 16) * 1024 + col0;
#pragma unroll
                for (int bj = 0; bj < 2; ++bj)
#pragma unroll
                    for (int n = 0; n < 2; ++n) { const size_t o = ro + bj * HALF + n * 16; *(f32x4*)(O + o) = *(const f32x4*)(X + o) + acc[ai][bj][m][n]; } }
    }
};
struct MoeOrder {
    const volatile PG8_LAS int* tp;
    int G, c;
    __device__ bool next(int i, Unit& u) const {
        const int L = i * G + c; const int ntile = __builtin_amdgcn_readfirstlane(tp[32]);
        if (L >= 4 * ntile) return false;
        const int rt = L >> 2, nt = L & 3; int e = 0;
        for (int q = 1; q < 32; ++q) e += (__builtin_amdgcn_readfirstlane(tp[q]) <= rt) ? 1 : 0;
        u.pm = rt; u.pn = e * 4 + nt; u.sel = 0; return true;
    }
    __device__ __forceinline__ void a_ready(const Unit&) const {}
    __device__ __forceinline__ void done(const Unit&) const {}
};
struct EpiGU {
    static constexpr bool PERM = true, AFTER_DRAIN = false;
    __device__ __forceinline__ bool keep(const Unit&) const { return false; }
    const float* RS; bf16_t* HID;
    __device__ __forceinline__ void operator()(const f32x4 (&acc)[2][2][4][2], const Unit& u, int wr, int wc, int fr, int fq) const {
        int row0 = u.pm * BM + wr * 64 + fr; int col0 = (u.pn & 3) * 128 + wc * 32 + 8 * fq; asm volatile("" : "+v"(row0), "+v"(col0));
#pragma unroll
        for (int ai = 0; ai < 2; ++ai)
#pragma unroll
            for (int m = 0; m < 4; ++m) { const int row = row0 + ai * HALF + m * 16; const float r = RS[row]; float v[8];
#pragma unroll
                for (int e = 0; e < 4; ++e) { const float g0 = acc[ai][0][m][0][e] * r, g1 = acc[ai][0][m][1][e] * r; v[e] = g0 * sigm(g0) * (acc[ai][1][m][0][e] * r); v[4 + e] = g1 * sigm(g1) * (acc[ai][1][m][1][e] * r); }
                st_bf16x8(HID + (size_t)row * 512 + col0, v); }
    }
};
struct EpiDown {
    static constexpr bool PERM = true, AFTER_DRAIN = false;
    __device__ __forceinline__ bool keep(const Unit&) const { return false; }
    bf16_t* Y;
    __device__ __forceinline__ void operator()(const f32x4 (&acc)[2][2][4][2], const Unit& u, int wr, int wc, int fr, int fq) const {
        int row0 = u.pm * BM + wr * 64 + fr; int col0 = (u.pn & 3) * BM + wc * 32 + 8 * fq; asm volatile("" : "+v"(row0), "+v"(col0));
#pragma unroll
        for (int ai = 0; ai < 2; ++ai)
#pragma unroll
            for (int m = 0; m < 4; ++m) { const int row = row0 + ai * HALF + m * 16;
#pragma unroll
                for (int bj = 0; bj < 2; ++bj) { float v[8];
#pragma unroll
                    for (int e = 0; e < 4; ++e) { v[e] = acc[ai][bj][m][0][e]; v[4 + e] = acc[ai][bj][m][1][e]; }
                    st_bf16x8(Y + (size_t)row * 1024 + col0 + bj * HALF, v); } }
    }
};

template <class Epi, class Sched, bool ALIGN_EPI = false, bool SP2 = false>
__device__ __forceinline__ void gemm_phase(PG8_LAS unsigned char* lds, const Gemm g, const Sched& S, const Epi& E) {
    int tid_ = threadIdx.x; asm volatile("" : "+v"(tid_));
    const int tid = tid_, wid = __builtin_amdgcn_readfirstlane(tid >> 6), lane = tid & 63, wr = wid >> 2, wc = wid & 3, fr = lane & 15, fq = lane >> 4;
    const int K = g.K, nt = K / BK;
    unsigned voffA[2], voffB[2];
#pragma unroll
    for (int i = 0; i < 2; ++i) { int R, C; stage_rc(tid * 16 + i * 8192, R, C); const int Rb = Epi::PERM ? ((R & ~31) + perm32(R & 31)) : R;
        voffA[i] = (unsigned)(R * K + C) * 2u; voffB[i] = (unsigned)(Rb * K + C) * 2u; }
    const size_t kstep = (size_t)(BK * 2);
    const size_t hstep = (size_t)HALF * K * 2;
    const size_t tstep = 2 * hstep;
    const unsigned ldsw = (unsigned)wid * 1024u;
    const int aoff = lds_byte(wr * 64 + fr, fq * 8), boff = lds_byte(wc * 32 + fr, fq * 8);
#define PG8_SA(b, h) (((b) * 2 + (h)) * HTB)
#define PG8_SB(b, h) ((4 + (b) * 2 + (h)) * HTB)
#define PG8_STAGE(bufoff, gbase, voff) do { _Pragma("unroll") for (int _i = 0; _i < 2; ++_i) \
        __builtin_amdgcn_global_load_lds((const unsigned*)((const char*)(gbase) + (voff)[_i]), (PG8_LAS unsigned*)(lds + (bufoff) + ldsw + _i * 8192), 16, 0, 0); } while (0)
#define PG8_LDA(dst, b, h) do { _Pragma("unroll") for (int m = 0; m < 4; ++m) _Pragma("unroll") for (int k = 0; k < 2; ++k) dst[m][k] = *(const PG8_LAS bf16x8*)(lds + PG8_SA(b, h) + aoff + m * 2048 + k * 1024); } while (0)
#define PG8_LDB(dst, b, h) do { _Pragma("unroll") for (int n = 0; n < 2; ++n) _Pragma("unroll") for (int k = 0; k < 2; ++k) dst[n][k] = *(const PG8_LAS bf16x8*)(lds + PG8_SB(b, h) + boff + n * 2048 + k * 1024); } while (0)
#define PG8_MMA(ai, bj, At, Bt) do { __builtin_amdgcn_s_setprio(1); _Pragma("unroll") for (int m = 0; m < 4; ++m) _Pragma("unroll") for (int n = 0; n < 2; ++n) _Pragma("unroll") for (int k = 0; k < 2; ++k) \
        acc[ai][bj][m][n] = __builtin_amdgcn_mfma_f32_16x16x32_bf16(Bt[n][k], At[m][k], acc[ai][bj][m][n], 0, 0, 0); __builtin_amdgcn_s_setprio(0); } while (0)
#define PG8_WAIT_V(n) asm volatile("s_waitcnt vmcnt(" #n ")" ::: "memory")
#define PG8_WAIT_L(n) asm volatile("s_waitcnt lgkmcnt(" #n ")" ::: "memory")
#define PG8_BAR __builtin_amdgcn_s_barrier()
#define PG8_SCHED __builtin_amdgcn_sched_barrier(0)
    Unit cur, nxt; int ui = 0;
    if (!S.next(0, cur)) return;
    f32x4 acc[2][2][4][2];
#pragma unroll
    for (int a = 0; a < 2; ++a)
#pragma unroll
        for (int b = 0; b < 2; ++b)
#pragma unroll
            for (int m = 0; m < 4; ++m)
#pragma unroll
                for (int n = 0; n < 2; ++n) acc[a][b][m][n] = (f32x4){0.f, 0.f, 0.f, 0.f};
    bf16x8 At[4][2], B0[2][2], B1[2][2];
    const char* cA = (const char*)(cur.sel ? g.A2 : g.A) + (size_t)cur.pm * tstep; const char* cB = (const char*)(cur.sel ? g.Bt2 : g.Bt) + (size_t)cur.pn * tstep;
    S.a_ready(cur);
    if constexpr (SP2) {
        PG8_STAGE(PG8_SB(0, 0), cB, voffB); PG8_STAGE(PG8_SB(0, 1), cB + hstep, voffB); PG8_STAGE(PG8_SA(0, 0), cA, voffA); PG8_STAGE(PG8_SA(0, 1), cA + hstep, voffA);
        if (wr == 1) PG8_BAR;
        PG8_WAIT_V(2); PG8_BAR;
        PG8_STAGE(PG8_SB(1, 0), cB + kstep, voffB); PG8_STAGE(PG8_SA(1, 0), cA + kstep, voffA); PG8_STAGE(PG8_SB(1, 1), cB + hstep + kstep, voffB);
        PG8_WAIT_V(6); PG8_BAR;
    } else {
        PG8_STAGE(PG8_SB(0, 0), cB, voffB); PG8_STAGE(PG8_SA(0, 0), cA, voffA); PG8_STAGE(PG8_SB(0, 1), cB + hstep, voffB); PG8_STAGE(PG8_SA(0, 1), cA + hstep, voffA);
        if (wr == 1) PG8_BAR;
        PG8_WAIT_V(4); PG8_BAR;
        PG8_STAGE(PG8_SB(1, 0), cB + kstep, voffB); PG8_STAGE(PG8_SA(1, 0), cA + kstep, voffA); PG8_STAGE(PG8_SB(1, 1), cB + hstep + kstep, voffB);
        PG8_WAIT_V(6); PG8_BAR;
    }
    for (;;) {
        const bool has_next = S.next(ui + 1, nxt);
        const char* nA = has_next ? (const char*)(nxt.sel ? g.A2 : g.A) + (size_t)nxt.pm * tstep : cA; const char* nB = has_next ? (const char*)(nxt.sel ? g.Bt2 : g.Bt) + (size_t)nxt.pn * tstep : cB;
        for (int t = 0; t < nt; t += 2) {
            const bool last = (t == nt - 2);
            const char* a1 = cA + (size_t)(t + 1) * kstep;
            const char* a2 = last ? nA : cA + (size_t)(t + 2) * kstep; const char* b2 = last ? nB : cB + (size_t)(t + 2) * kstep;
            const char* a3 = a2 + kstep; const char* b3 = b2 + kstep;
            if (last && has_next) S.a_ready(nxt);
            if constexpr (SP2) {
            PG8_LDB(B0, 0, 0); PG8_LDB(B1, 0, 1); PG8_SCHED; PG8_LDA(At, 0, 0); PG8_STAGE(PG8_SA(1, 1), a1 + hstep, voffA);
            PG8_WAIT_V(8); PG8_WAIT_L(0); PG8_BAR; PG8_MMA(0, 0, At, B0); PG8_MMA(0, 1, At, B1); PG8_BAR; PG8_SCHED;
            PG8_LDA(At, 0, 1); PG8_STAGE(PG8_SB(0, 0), b2, voffB); PG8_STAGE(PG8_SB(0, 1), b2 + hstep, voffB); PG8_STAGE(PG8_SA(0, 0), a2, voffA);
            PG8_WAIT_V(8); PG8_WAIT_L(0); PG8_BAR; PG8_MMA(1, 0, At, B0); PG8_MMA(1, 1, At, B1); PG8_BAR; PG8_SCHED;
            PG8_LDB(B0, 1, 0); PG8_LDB(B1, 1, 1); PG8_SCHED; PG8_LDA(At, 1, 0); PG8_STAGE(PG8_SA(0, 1), a2 + hstep, voffA);
            PG8_WAIT_V(8); PG8_WAIT_L(0); PG8_BAR; PG8_MMA(0, 0, At, B0); PG8_MMA(0, 1, At, B1); PG8_BAR; PG8_SCHED;
            PG8_LDA(At, 1, 1); PG8_STAGE(PG8_SB(1, 0), b3, voffB); PG8_STAGE(PG8_SB(1, 1), b3 + hstep, voffB); PG8_STAGE(PG8_SA(1, 0), a3, voffA);
            PG8_WAIT_V(8); PG8_WAIT_L(0); PG8_BAR; PG8_MMA(1, 0, At, B0); PG8_MMA(1, 1, At, B1); PG8_BAR; PG8_SCHED;
            } else {
            PG8_LDB(B0, 0, 0); PG8_SCHED; PG8_LDA(At, 0, 0); PG8_STAGE(PG8_SA(1, 1), a1 + hstep, voffA);
            PG8_WAIT_L(8); PG8_BAR; PG8_WAIT_L(0); PG8_MMA(0, 0, At, B0); PG8_BAR; PG8_SCHED;
            PG8_LDB(B1, 0, 1); PG8_STAGE(PG8_SB(0, 0), b2, voffB);
            PG8_BAR; PG8_WAIT_L(0); PG8_MMA(0, 1, At, B1); PG8_BAR;
            PG8_LDA(At, 0, 1); PG8_STAGE(PG8_SA(0, 0), a2, voffA);
            PG8_BAR; PG8_WAIT_L(0); PG8_MMA(1, 0, At, B0); PG8_BAR; PG8_SCHED;
            PG8_STAGE(PG8_SB(0, 1), b2 + hstep, voffB);
            PG8_WAIT_V(6); PG8_BAR; PG8_MMA(1, 1, At, B1); PG8_BAR;
            PG8_LDB(B0, 1, 0); PG8_SCHED; PG8_LDA(At, 1, 0); PG8_STAGE(PG8_SA(0, 1), a2 + hstep, voffA);
            PG8_WAIT_L(8); PG8_BAR; PG8_WAIT_L(0); PG8_MMA(0, 0, At, B0); PG8_BAR; PG8_SCHED;
            PG8_LDB(B1, 1, 1); PG8_STAGE(PG8_SB(1, 0), b3, voffB);
            PG8_BAR; PG8_WAIT_L(0); PG8_MMA(0, 1, At, B1); PG8_BAR;
            PG8_LDA(At, 1, 1); PG8_STAGE(PG8_SA(1, 0), a3, voffA);
            PG8_BAR; PG8_WAIT_L(0); PG8_MMA(1, 0, At, B0); PG8_BAR; PG8_SCHED;
            PG8_STAGE(PG8_SB(1, 1), b3 + hstep, voffB);
            PG8_WAIT_V(6); PG8_BAR; PG8_MMA(1, 1, At, B1); PG8_BAR;
            }
        }
        if constexpr (ALIGN_EPI) { if (wr == 0) PG8_BAR; }
        if constexpr (!Epi::AFTER_DRAIN) { E(acc, cur, wr, wc, fr, fq); S.done(cur); }
        if (!has_next) break;
        if (!E.keep(cur)) {
#pragma unroll
        for (int a = 0; a < 2; ++a)
#pragma unroll
            for (int b = 0; b < 2; ++b)
#pragma unroll
                for (int m = 0; m < 4; ++m)
#pragma unroll
                    for (int n = 0; n < 2; ++n) acc[a][b][m][n] = (f32x4){0.f, 0.f, 0.f, 0.f};
        }
        cur = nxt; cA = nA; cB = nB; ++ui;
        if constexpr (ALIGN_EPI) { if (wr == 1) PG8_BAR; }
    }
    PG8_WAIT_V(0);
    if constexpr (!ALIGN_EPI) { if (wr == 0) PG8_BAR; }
    PG8_BAR;
    if constexpr (Epi::AFTER_DRAIN) { E.fused(acc, cur, wr, wc, fr, fq, lds, wid, lane); S.done(cur); }
#undef PG8_SA
#undef PG8_SB
#undef PG8_STAGE
#undef PG8_LDA
#undef PG8_LDB
#undef PG8_MMA
#undef PG8_WAIT_V
#undef PG8_WAIT_L
#undef PG8_BAR
#undef PG8_SCHED
}
}

#define GAS __attribute__((address_space(1)))
#define LAS __attribute__((address_space(3)))
typedef unsigned short bf16;
typedef unsigned v4u __attribute__((ext_vector_type(4)));
typedef float f32x4 __attribute__((ext_vector_type(4)));
typedef short bf16x8 __attribute__((ext_vector_type(8)));
typedef GAS unsigned gu32;
typedef GAS unsigned long long gu64;
#define RLX_AGENT __ATOMIC_RELAXED, __HIP_MEMORY_SCOPE_AGENT
#define LDS_WAIT() asm volatile("s_waitcnt lgkmcnt(0)" ::: "memory")
#define VM_WAIT() asm volatile("s_waitcnt vmcnt(0)" ::: "memory")
__device__ __forceinline__ unsigned long long rt() { return __builtin_amdgcn_s_memrealtime(); }
__device__ __forceinline__ unsigned f2bf(float f) { unsigned u = __builtin_bit_cast(unsigned, f); return (u + 0x7fffu + ((u >> 16) & 1u)) >> 16; }
__device__ __forceinline__ unsigned pk2(float lo, float hi) { return f2bf(lo) | (f2bf(hi) << 16); }

#define XB_TMO      128
#define XB_XCNT(j)  (256  + 64 * (j))
#define XB_XSUB(j)  (1280 + 64 * (j))
#define XB_XGEN(j)  (2304 + 64 * (j))
#define XB_TOP      3328
#define XB_TOPGEN   3392
#define XCD_BAR_WORDS 3456
#define XB_SPIN_CAP (1u << 18)

__device__ __forceinline__ unsigned xb_ld(unsigned* p)              { return __hip_atomic_load(p, __ATOMIC_RELAXED, __HIP_MEMORY_SCOPE_AGENT); }
__device__ __forceinline__ unsigned xb_add(unsigned* p, unsigned v) { return __hip_atomic_fetch_add(p, v, __ATOMIC_RELAXED, __HIP_MEMORY_SCOPE_AGENT); }
__device__ __forceinline__ unsigned xb_xcc_id() { return (unsigned)__builtin_amdgcn_s_getreg((3 << 11) | 20) & 0xFu; }
#define XB_SPIN(cond, bar) do { unsigned _sp = 0; while (cond) { __builtin_amdgcn_s_sleep(1); \
    if ((++_sp & 255u) == 0u) { if (xb_ld(&(bar)[XB_TMO])) break; if (_sp > XB_SPIN_CAP) { atomicAdd(&(bar)[XB_TMO], 1u); break; } } } } while (0)

struct XcdBarrier {
    unsigned* bar; unsigned x;
    volatile LAS unsigned* st;
};

__device__ __forceinline__ XcdBarrier xcd_barrier_post(unsigned* bar, volatile LAS unsigned* st) {
    XcdBarrier b; b.bar = bar; b.x = xb_xcc_id(); b.st = st;
    if (threadIdx.x == 0) (void)xb_add(&bar[XB_XCNT(b.x)], 1u);
    return b;
}
__device__ __forceinline__ void xcd_barrier_complete(unsigned* bar, unsigned x, unsigned& nloc, unsigned& nx) {
    const unsigned G = gridDim.x * gridDim.y * gridDim.z;
    unsigned sum, cnt, mine, sp = 0u;
    for (;;) {
        sum = 0u; cnt = 0u; mine = 0u;
#pragma unroll
        for (unsigned j = 0; j < 16; ++j) { const unsigned c = xb_ld(&bar[XB_XCNT(j)]); sum += c; cnt += (c > 0u) ? 1u : 0u; mine = (j == x) ? c : mine; }
        if (sum == G) break;
        __builtin_amdgcn_s_sleep(1);
        if ((++sp & 255u) == 0u) { if (xb_ld(&bar[XB_TMO])) break; if (sp > XB_SPIN_CAP) { atomicAdd(&bar[XB_TMO], 1u); break; } }
    }
    nloc = mine > 0u ? mine : 1u; nx = cnt > 0u ? cnt : 1u;
}

__device__ __forceinline__ void xcd_barrier(const XcdBarrier& b) {
    asm volatile("s_waitcnt vmcnt(0)" ::: "memory");
    __syncthreads();
    if (threadIdx.x == 0) {
        unsigned* bar = b.bar;
        __builtin_amdgcn_s_waitcnt(0);
        unsigned nloc = b.st[0], nx = b.st[1];
        if (nloc == 0u) { xcd_barrier_complete(bar, b.x, nloc, nx); b.st[0] = nloc; b.st[1] = nx; }
        const unsigned old = xb_add(&bar[XB_XSUB(b.x)], 1u);
        const unsigned gen = old / nloc;
        if (old + 1u == (gen + 1u) * nloc) {
            __builtin_amdgcn_fence(__ATOMIC_RELEASE, "agent");
            asm volatile("s_waitcnt vmcnt(0)" ::: "memory");
            const unsigned og = xb_add(&bar[XB_TOP], 1u);
            const unsigned tg = og / nx;
            if (og + 1u == (tg + 1u) * nx) xb_add(&bar[XB_TOPGEN], 1u);
            else XB_SPIN(xb_ld(&bar[XB_TOPGEN]) == tg, bar);
            __builtin_amdgcn_fence(__ATOMIC_ACQUIRE, "agent");
            xb_add(&bar[XB_XGEN(b.x)], 1u);
            asm volatile("s_waitcnt vmcnt(0)" ::: "memory");
        } else {
            XB_SPIN(xb_ld(&bar[XB_XGEN(b.x)]) == gen, bar);
            __builtin_amdgcn_fence(__ATOMIC_ACQUIRE, "agent");
            asm volatile("s_waitcnt vmcnt(0)" ::: "memory");
        }
    }
    __syncthreads();
}
constexpr int NWAVES = 8;
constexpr int DM = 1024, NB = 2, SEQ = 8192, TOK = NB * SEQ;
constexpr int NC_IN = 5400, NPROJ = 5632;
constexpr int NCMP = 511, NSEL = 128, TOPN = 16, NE = 32, FF = 512;
constexpr size_t MiB = 1u << 20;
constexpr size_t WS_CTL = 0, CTL_ZERO_BYTES = 1 * MiB;
constexpr size_t WS_SMALL = 1 * MiB;
constexpr size_t WS_WIN = 2 * MiB;
constexpr size_t WS_WBRN = 13 * MiB, WS_WBRH = 14 * MiB, WS_WOUT = 15 * MiB, WS_WCMP = 17 * MiB;
constexpr size_t WS_WGU = 18 * MiB, WS_WD = 82 * MiB;
constexpr size_t WS_XN = 114 * MiB;
constexpr size_t WS_Q = 146 * MiB, WS_KV = 162 * MiB, WS_HQ = 186 * MiB, WS_HF = 202 * MiB, WS_HI = 234 * MiB, WS_HGS = 250 * MiB, WS_GT = 266 * MiB;
constexpr size_t WS_MISC = 276 * MiB;
constexpr size_t WS_END = 284 * MiB;
constexpr size_t WS_ONSA = 82 * MiB, WS_OHG = 50 * MiB;
constexpr size_t WS_ONSAB = 130 * MiB, WS_OHGB = 114 * MiB, WS_MIX = 218 * MiB;
constexpr int R_PAD = 40960;
constexpr size_t WS_H2S = 146 * MiB, WS_HID = 226 * MiB, WS_YB = 146 * MiB;
constexpr size_t OFF_WRH = 640 * 1024, OFF_WRL = 768 * 1024;
constexpr size_t M_EID = 4 * MiB, M_EW = 4 * MiB + 256 * 1024, M_SLOT = 4 * MiB + 512 * 1024, M_POS = 4 * MiB + 768 * 1024, M_RINV = 5 * MiB, M_RS = 5 * MiB + 256 * 1024;
constexpr size_t WS_ST = 18 * MiB, WS_DEC = 17 * MiB + 512 * 1024;
constexpr int CW_DBG = 20480;
#ifndef DBG_MODE
#define DBG_MODE 0
#endif
constexpr int MISC_TP = 16;
constexpr int CW_BAR = 4096;
constexpr int CW_CNT = 16384;
constexpr int SCR_BYTES = 143360;
constexpr int MISC_OFF = SCR_BYTES;
constexpr int LDS_BYTES = 147456;

__device__ __forceinline__ float wave_sum(float v) {
#pragma unroll
    for (int o = 1; o < 64; o <<= 1) v += __shfl_xor(v, o);
    return v;
}
__device__ __forceinline__ float wave_max(float v) {
#pragma unroll
    for (int o = 1; o < 64; o <<= 1) v = fmaxf(v, __shfl_xor(v, o));
    return v;
}
__device__ __forceinline__ float bf2f(bf16 b) { return __builtin_bit_cast(float, (unsigned)b << 16); }
__device__ __forceinline__ float sigmoidf_(float x) { return 1.0f / (1.0f + expf(-x)); }
__device__ __forceinline__ int perm_d(int dp) { return dp < 16 ? ((dp >> 1) + 8 * (dp & 1)) : dp; }
#define WAVE_LDS_FENCE() asm volatile("s_waitcnt lgkmcnt(0)" ::: "memory")

struct Params {
    const float *x, *attn_norm, *w_in, *w_cmp_k, *w_cmp_v, *cmp_pos, *hg_lb, *hg_norm, *w_br_nsa, *w_br_hg, *w_out, *ffn_norm, *w_grp, *b_grp, *w_rtr, *b_rtr, *w_gate, *w_up, *w_down, *final_norm;
    float* out; unsigned char* ws;
};

template <class F> __device__ __forceinline__ void tr_item(F srcf, int K, bf16* WT, int n0, int k0, float* scr, int lane) {
#pragma unroll 8
    for (int i = 0; i < 32; ++i) { const int kk = 2 * i + (lane >> 5); scr[kk * 33 + (lane & 31)] = srcf(k0 + kk, n0 + (lane & 31)); }
    WAVE_LDS_FENCE();
    const int c = lane & 7;
#pragma unroll
    for (int j = 0; j < 4; ++j) { const int n = (lane >> 3) + 8 * j; const float* s = scr + (8 * c) * 33 + n;
        v4u o; o.x = pk2(s[0 * 33], s[1 * 33]); o.y = pk2(s[2 * 33], s[3 * 33]); o.z = pk2(s[4 * 33], s[5 * 33]); o.w = pk2(s[6 * 33], s[7 * 33]);
        *(v4u*)(WT + (size_t)(n0 + n) * K + k0 + 8 * c) = o; }
    WAVE_LDS_FENCE();
}
__device__ __forceinline__ int win_src_col(int n) {
    if (n < 512) return (n & ~63) + perm_d(n & 63);
    if (n < 1280) { const int j = (n - 512) >> 7; const int d = n & 63; return (n & ~63) + ((j == 2 || j == 4) ? perm_d(d) : d); }
    if (n < 5376) return n + 24;
    if (n < 5400) return 1280 + (n - 5376);
    return -1;
}
__device__ __forceinline__ void p0_prologue(const Params& p, unsigned char* lds, int wave, int lane, int gw, int NGW, int gtid, int NGT) {
    float* scr = (float*)(lds + wave * 8448);
    bf16* Win_t = (bf16*)(p.ws + WS_WIN); bf16* Wbrn_t = (bf16*)(p.ws + WS_WBRN); bf16* Wbrh_t = (bf16*)(p.ws + WS_WBRH); bf16* Wout_t = (bf16*)(p.ws + WS_WOUT); bf16* Wcmp_t = (bf16*)(p.ws + WS_WCMP);
    constexpr int I_IN = 16 * (NPROJ / 32), I_BR = 8 * 32, I_OUT = 16 * 32, I_CMP = 32 * 4;
    constexpr int NITEMS = I_IN + 2 * I_BR + I_OUT + I_CMP;
    for (int it = gw; it < NITEMS; it += NGW) {
        int r = it;
        if (r < I_IN) { const int nblk = NPROJ / 32, kb = r / nblk, nb = r % nblk; const float* W = p.w_in;
            tr_item([W](int k, int n) { const int c = win_src_col(n); return c >= 0 ? W[(size_t)k * NC_IN + c] : 0.0f; }, DM, Win_t, 32 * nb, 64 * kb, scr, lane); continue; }
        r -= I_IN;
        if (r < I_BR) { const int kb = r / 32, nb = r % 32; const float* W = p.w_br_nsa; tr_item([W](int k, int n) { return W[(size_t)k * DM + n]; }, 512, Wbrn_t, 32 * nb, 64 * kb, scr, lane); continue; }
        r -= I_BR;
        if (r < I_BR) { const int kb = r / 32, nb = r % 32; const float* W = p.w_br_hg; tr_item([W](int k, int n) { return W[(size_t)k * DM + n]; }, 512, Wbrh_t, 32 * nb, 64 * kb, scr, lane); continue; }
        r -= I_BR;
        if (r < I_OUT) { const int kb = r / 32, nb = r % 32; const float* W = p.w_out; tr_item([W](int k, int n) { return W[(size_t)k * DM + n]; }, DM, Wout_t, 32 * nb, 64 * kb, scr, lane); continue; }
        r -= I_OUT;
        { const int kb = r / 4, nb = r % 4; const float* Wk = p.w_cmp_k; const float* Wv = p.w_cmp_v;
          tr_item([Wk, Wv](int k, int n) { return n < 64 ? Wk[(size_t)k * 64 + perm_d(n)] : Wv[(size_t)k * 64 + (n - 64)]; }, 2048, Wcmp_t, 32 * nb, 64 * kb, scr, lane); }
    }
    { bf16* Wh = (bf16*)(p.ws + WS_SMALL + OFF_WRH); bf16* Wl = (bf16*)(p.ws + WS_SMALL + OFF_WRL);
      for (int i = gtid; i < 48 * 1024; i += NGT) { const int c = i >> 10, k = i & 1023; const float w = c < 4 ? p.w_grp[k * 4 + c] : (c < 36 ? p.w_rtr[k * 32 + (c - 4)] : 0.0f);
          const unsigned hi = f2bf(w); Wh[i] = (bf16)hi; Wl[i] = (bf16)f2bf(w - __builtin_bit_cast(float, hi << 16)); } }
    { float* cbv = (float*)(p.ws + WS_SMALL + 4096);
      for (int c = gw; c < 128; c += NGW) { const float* W = c < 64 ? p.w_cmp_k : p.w_cmp_v; const int col = c < 64 ? perm_d(c) : c - 64; float a = 0.f;
          for (int ld = lane; ld < 2048; ld += 64) a = fmaf(p.cmp_pos[ld], W[(size_t)ld * 64 + col], a);
          a = wave_sum(a); if (lane == 0) cbv[c] = a; } }
    float* lbv = (float*)(p.ws + WS_SMALL); float* rope = (float*)(p.ws + WS_SMALL + 65536);
    for (int i = gtid; i < SEQ * 8; i += NGT) { const int pos = i >> 3, f = i & 7; const float inv = powf(500000.0f, -(float)f / 8.0f); const float ang = (float)pos * inv; float sn, cs; sincosf(ang, &sn, &cs); rope[2 * i] = cs; rope[2 * i + 1] = sn; }
    if (gtid < 512) { const float l0 = p.hg_lb[gtid], l1 = p.hg_lb[512 + gtid]; const float m = fmaxf(l0, l1); const float e0 = expf(l0 - m), e1 = expf(l1 - m); lbv[gtid] = e0 / (e0 + e1); }
    bf16* XN = (bf16*)(p.ws + WS_XN);
    for (int m = gw; m < TOK; m += NGW) {
        const f32x4* xr = (const f32x4*)(p.x + (size_t)m * DM) + lane; const f32x4* gr = (const f32x4*)p.attn_norm + lane;
        f32x4 v[4]; float s = 0.f;
#pragma unroll
        for (int j = 0; j < 4; ++j) { v[j] = xr[64 * j]; s += (v[j].x * v[j].x + v[j].y * v[j].y) + (v[j].z * v[j].z + v[j].w * v[j].w); }
        const float r = 1.0f / sqrtf(wave_sum(s) * (1.0f / DM) + 1e-6f);
        unsigned long long* o8 = (unsigned long long*)(XN + (size_t)m * DM) + lane;
#pragma unroll
        for (int j = 0; j < 4; ++j) { const f32x4 g = gr[64 * j]; o8[64 * j] = (unsigned long long)pk2(v[j].x * r * g.x, v[j].y * r * g.y) | ((unsigned long long)pk2(v[j].z * r * g.z, v[j].w * r * g.w) << 32); }
    }
}

__device__ __forceinline__ void s_compress(const Params& p, int lane, int gw, int NGW) {
    const bf16* KV = (const bf16*)(p.ws + WS_KV); const float* rope = (const float*)(p.ws + WS_SMALL + 65536);
    float* kc = (float*)(p.ws + WS_MISC + 2 * MiB); float* vc = (float*)(p.ws + WS_MISC + 3 * MiB);
    for (int it = gw; it < NB * NCMP * 4; it += NGW) {
        const int j = it & 1, g = (it >> 1) & 1, bn = it >> 2, b = bn / NCMP, n = bn % NCMP;
        const float* W = j == 0 ? p.w_cmp_k : p.w_cmp_v; const int sc = j == 0 ? perm_d(lane) : lane;
        float acc = 0.f;
        for (int l = 0; l < 32; ++l) {
            const bf16* src = KV + (size_t)(b * SEQ + 16 * n + l) * 768 + j * 128 + g * 64;
            for (int d = 0; d < 64; ++d) acc = fmaf(bf2f(src[d]) + p.cmp_pos[l * 64 + d], W[(size_t)(l * 64 + d) * 64 + sc], acc);
        }
        if (j == 0) { const float other = __shfl_xor(acc, 1);
            if (lane < 16) { const int i = lane >> 1; const float cs = rope[(size_t)(16 * n) * 16 + 2 * i], sn = rope[(size_t)(16 * n) * 16 + 2 * i + 1];
                acc = (lane & 1) ? (acc * cs + other * sn) : (acc * cs - other * sn); }
            kc[((size_t)(b * NCMP + n) * 2 + g) * 64 + lane] = acc;
        } else vc[((size_t)(b * NCMP + n) * 2 + g) * 64 + lane] = acc;
    }
}
__device__ __forceinline__ void s_cmp_attn(const Params& p, unsigned char* lds, int wave, int lane, int gw, int NGW) {
    float* wl = (float*)(lds + wave * 17472); float* qs = wl; float* pp = wl + 256; float* sc = pp + 4 * 512;
    const bf16* Q = (const bf16*)(p.ws + WS_Q); const float* GT = (const float*)(p.ws + WS_GT);
    const float* kc = (const float*)(p.ws + WS_MISC + 2 * MiB); const float* vc = (const float*)(p.ws + WS_MISC + 3 * MiB);
    float* onsa = (float*)(p.ws + WS_ONSA); int* selidx = (int*)(p.ws + WS_MISC);
    for (int it = gw; it < TOK * 2; it += NGW) {
        const int g = it & 1, m = it >> 1, b = m >> 13, s = m & 8191;
        WAVE_LDS_FENCE();
#pragma unroll
        for (int r = 0; r < 4; ++r) qs[r * 64 + lane] = bf2f(Q[(size_t)m * 512 + (g * 4 + r) * 64 + lane]);
        WAVE_LDS_FENCE();
        const int nvalid = s >= 31 ? (s - 31) / 16 + 1 : 0;
        float mx[4] = {-3.0e38f, -3.0e38f, -3.0e38f, -3.0e38f};
        for (int n = lane; n < nvalid; n += 64) {
            const float* kp = kc + ((size_t)(b * NCMP + n) * 2 + g) * 64;
            float d0 = 0.f, d1 = 0.f, d2 = 0.f, d3 = 0.f;
            for (int d = 0; d < 64; ++d) { const float kv = kp[d]; d0 = fmaf(qs[d], kv, d0); d1 = fmaf(qs[64 + d], kv, d1); d2 = fmaf(qs[128 + d], kv, d2); d3 = fmaf(qs[192 + d], kv, d3); }
            pp[n] = d0; pp[512 + n] = d1; pp[1024 + n] = d2; pp[1536 + n] = d3;
            mx[0] = fmaxf(mx[0], d0); mx[1] = fmaxf(mx[1], d1); mx[2] = fmaxf(mx[2], d2); mx[3] = fmaxf(mx[3], d3);
        }
        float sm[4];
#pragma unroll
        for (int r = 0; r < 4; ++r) { mx[r] = wave_max(mx[r]); float a = 0.f; for (int n = lane; n < nvalid; n += 64) { const float e = expf(pp[r * 512 + n] - mx[r]); pp[r * 512 + n] = e; a += e; } sm[r] = wave_sum(a); }
#pragma unroll
        for (int r = 0; r < 4; ++r) { const float inv = nvalid > 0 ? 1.0f / sm[r] : 0.f; for (int n = lane; n < nvalid; n += 64) pp[r * 512 + n] *= inv; }
        WAVE_LDS_FENCE();
        float o[4] = {0.f, 0.f, 0.f, 0.f};
        for (int n = 0; n < nvalid; ++n) { const float v = vc[((size_t)(b * NCMP + n) * 2 + g) * 64 + lane]; o[0] = fmaf(pp[n], v, o[0]); o[1] = fmaf(pp[512 + n], v, o[1]); o[2] = fmaf(pp[1024 + n], v, o[2]); o[3] = fmaf(pp[1536 + n], v, o[3]); }
#pragma unroll
        for (int r = 0; r < 4; ++r) { const int h = g * 4 + r; onsa[(size_t)m * 512 + h * 64 + lane] = GT[(size_t)m * 24 + h * 3 + 0] * o[r]; }
        const int jc = s >> 6;
        for (int j = lane; j < NSEL; j += 64) {
            float imp = 0.f;
            for (int n = 4 * j - 1; n <= 4 * j + 3; ++n) if (n >= 0 && n < nvalid) imp += (pp[n] + pp[512 + n]) + (pp[1024 + n] + pp[1536 + n]);
            float v; if (j == jc || j == 0) v = 1.0e4f; else if (64 * j <= s) v = imp; else v = -1.0f;
            sc[j] = v;
        }
        WAVE_LDS_FENCE();
        float v0 = sc[lane], v1 = sc[lane + 64];
        for (int k = 0; k < TOPN; ++k) {
            float bv; int bi;
            if (v0 >= v1) { bv = v0; bi = lane; } else { bv = v1; bi = lane + 64; }
#pragma unroll
            for (int o2 = 1; o2 < 64; o2 <<= 1) { const float ov = __shfl_xor(bv, o2); const int oi = __shfl_xor(bi, o2); if (ov > bv || (ov == bv && oi < bi)) { bv = ov; bi = oi; } }
            if (lane == 0) selidx[(size_t)it * TOPN + k] = bi;
            if (bi == lane) v0 = -3.0e38f; if (bi == lane + 64) v1 = -3.0e38f;
        }
    }
}
template <int MODE> __device__ __forceinline__ void s_sparse_attn(const Params& p, unsigned char* lds, int wave, int lane, int gw, int NGW) {
    float* wl = (float*)(lds + wave * 17472); float* qs = wl; float* pp = wl + 256; int* sel = (int*)(pp + 4 * 1024);
    const bf16* Q = (const bf16*)(p.ws + WS_Q); const bf16* KV = (const bf16*)(p.ws + WS_KV); const float* GT = (const float*)(p.ws + WS_GT);
    float* onsa = (float*)(p.ws + WS_ONSA); const int* selidx = (const int*)(p.ws + WS_MISC);
    constexpr int NCH = MODE == 0 ? 16 : 8; constexpr int KJ = MODE == 0 ? 2 : 4;
    for (int it = gw; it < TOK * 2; it += NGW) {
        const int g = it & 1, m = it >> 1, b = m >> 13, s = m & 8191;
        WAVE_LDS_FENCE();
#pragma unroll
        for (int r = 0; r < 4; ++r) qs[r * 64 + lane] = bf2f(Q[(size_t)m * 512 + (g * 4 + r) * 64 + lane]);
        if (MODE == 0 && lane < 16) sel[lane] = selidx[(size_t)it * TOPN + lane];
        WAVE_LDS_FENCE();
        float mx[4] = {-3.0e38f, -3.0e38f, -3.0e38f, -3.0e38f};
        for (int c = 0; c < NCH; ++c) {
            int kpos; bool valid;
            if (MODE == 0) { kpos = sel[c] * 64 + lane; valid = kpos <= s; } else { kpos = s - 511 + c * 64 + lane; valid = kpos >= 0; }
            const int idx = c * 64 + lane;
            if (valid) {
                const bf16* kp = KV + (size_t)(b * SEQ + kpos) * 768 + KJ * 128 + g * 64;
                float d0 = 0.f, d1 = 0.f, d2 = 0.f, d3 = 0.f;
                for (int d = 0; d < 64; ++d) { const float kv = bf2f(kp[d]); d0 = fmaf(qs[d], kv, d0); d1 = fmaf(qs[64 + d], kv, d1); d2 = fmaf(qs[128 + d], kv, d2); d3 = fmaf(qs[192 + d], kv, d3); }
                pp[idx] = d0; pp[1024 + idx] = d1; pp[2048 + idx] = d2; pp[3072 + idx] = d3;
                mx[0] = fmaxf(mx[0], d0); mx[1] = fmaxf(mx[1], d1); mx[2] = fmaxf(mx[2], d2); mx[3] = fmaxf(mx[3], d3);
            }
        }
        float sm[4];
#pragma unroll
        for (int r = 0; r < 4; ++r) { mx[r] = wave_max(mx[r]); float a = 0.f;
            for (int c = 0; c < NCH; ++c) { const int idx = c * 64 + lane; int kpos; bool valid;
                if (MODE == 0) { kpos = sel[c] * 64 + lane; valid = kpos <= s; } else { kpos = s - 511 + c * 64 + lane; valid = kpos >= 0; }
                float e = 0.f; if (valid) e = expf(pp[r * 1024 + idx] - mx[r]); pp[r * 1024 + idx] = e; a += e; }
            sm[r] = wave_sum(a); }
        WAVE_LDS_FENCE();
        float o[4] = {0.f, 0.f, 0.f, 0.f};
        for (int i = 0; i < NCH * 64; ++i) { int kpos; if (MODE == 0) kpos = sel[i >> 6] * 64 + (i & 63); else kpos = s - 511 + i;
            if (kpos < 0 || kpos > s) continue;
            const float v = bf2f(KV[(size_t)(b * SEQ + kpos) * 768 + (KJ + 1) * 128 + g * 64 + lane]);
            o[0] = fmaf(pp[i], v, o[0]); o[1] = fmaf(pp[1024 + i], v, o[1]); o[2] = fmaf(pp[2048 + i], v, o[2]); o[3] = fmaf(pp[3072 + i], v, o[3]); }
#pragma unroll
        for (int r = 0; r < 4; ++r) { const int h = g * 4 + r; const size_t oi = (size_t)m * 512 + h * 64 + lane; const float val = onsa[oi] + GT[(size_t)m * 24 + h * 3 + (MODE == 0 ? 1 : 2)] * o[r] / sm[r];
            if (MODE == 0) onsa[oi] = val; else ((bf16*)(p.ws + WS_ONSAB))[oi] = (bf16)f2bf(val); }
    }
}
__device__ __forceinline__ void s_hgrn(const Params& p, unsigned char* lds, int tid, int item) {
    float* qf = (float*)lds; float* ff = qf + 16 * 128; float* vv = ff + 16 * 128;
    const bf16* HQ = (const bf16*)(p.ws + WS_HQ); const float* HF = (const float*)(p.ws + WS_HF); const bf16* HI = (const bf16*)(p.ws + WS_HI); float* ohg = (float*)(p.ws + WS_OHG);
    const int b = item >> 2, hh = item & 3, j = tid >> 2, kq = tid & 3;
    float St[32];
#pragma unroll
    for (int i = 0; i < 32; ++i) St[i] = 0.f;
    for (int s0 = 0; s0 < SEQ; s0 += 16) {
        __syncthreads();
        for (int e = tid; e < 16 * 128; e += 512) { const int tt = e >> 7, k = e & 127; const size_t ro = (size_t)(b * SEQ + s0 + tt) * 512 + hh * 128 + k;
            qf[e] = bf2f(HQ[ro]); ff[e] = expf(HF[ro]); vv[e] = bf2f(HI[ro]); }
        __syncthreads();
        for (int tt = 0; tt < 16; ++tt) {
            const float v = vv[tt * 128 + j]; float o = 0.f;
#pragma unroll
            for (int i = 0; i < 32; ++i) { const int k = kq * 32 + i; const float f = ff[tt * 128 + k]; St[i] = fmaf(f, St[i], (1.0f - f) * v); o = fmaf(qf[tt * 128 + k], St[i], o); }
            o += __shfl_xor(o, 1); o += __shfl_xor(o, 2);
            if (kq == 0) ohg[(size_t)(b * SEQ + s0 + tt) * 512 + hh * 128 + j] = o;
        }
    }
    __syncthreads();
}
__device__ __forceinline__ void s_hg_post(const Params& p, int lane, int gw, int NGW) {
    float* ohg = (float*)(p.ws + WS_OHG); const bf16* HGs = (const bf16*)(p.ws + WS_HGS);
    for (int w = gw; w < TOK * 4; w += NGW) { const int m = w >> 2, hh = w & 3; float* o = ohg + (size_t)m * 512 + hh * 128;
        const float a = o[lane], b = o[lane + 64]; const float r = 1.0f / sqrtf(wave_sum(a * a + b * b) * (1.0f / 128.0f) + 1e-6f);
        const bf16* gr = HGs + (size_t)m * 512 + hh * 128;
        bf16* ob = (bf16*)(p.ws + WS_OHGB) + (size_t)m * 512 + hh * 128;
        ob[lane] = (bf16)f2bf(a * r * p.hg_norm[lane] * bf2f(gr[lane])); ob[lane + 64] = (bf16)f2bf(b * r * p.hg_norm[lane + 64] * bf2f(gr[lane + 64])); }
}
typedef short bf16x8_t __attribute__((ext_vector_type(8)));
typedef short v4i16_t __attribute__((ext_vector_type(4)));
__device__ __forceinline__ bf16x8_t tr_frag(const unsigned char* p0, const unsigned char* p1) {
    const v4i16_t lo = __builtin_amdgcn_ds_read_tr16_b64_v4i16((LAS v4i16_t*)p0), hi = __builtin_amdgcn_ds_read_tr16_b64_v4i16((LAS v4i16_t*)p1);
    return (bf16x8_t){lo[0], lo[1], lo[2], lo[3], hi[0], hi[1], hi[2], hi[3]};
}
constexpr int HG_BC = 0, HG_TOT = 33792;
constexpr int HG_V = 35840;
constexpr int HG_KMT = 53248;
constexpr int HG_QM = 53248, HG_QE = 70656, HG_KM = 88064, HG_AM = 105472, HG_RS = 114688;

__device__ __forceinline__ void hg_cumsum(const float* GK, unsigned char* lds, int tid) {
    float* bc = (float*)(lds + HG_BC); float* tot = (float*)(lds + HG_TOT);
    const int seg = tid >> 7, k = tid & 127; float loc[16];
#pragma unroll
    for (int i = 0; i < 16; ++i) loc[i] = GK[(size_t)(16 * seg + i) * 512 + k];
    float run = 0.f;
#pragma unroll
    for (int i = 0; i < 16; ++i) { run += loc[i]; loc[i] = run; }
    tot[seg * 128 + k] = run;
    __syncthreads();
    float add = 0.f;
    for (int s = 0; s < seg; ++s) add += tot[s * 128 + k];
#pragma unroll
    for (int i = 0; i < 16; ++i) bc[(16 * seg + i) * 132 + k] = loc[i] + add;
    __syncthreads();
}
__device__ __forceinline__ void hg_stage_v(const bf16* HI, int m0, int hh, unsigned char* lds, int tid) {
    const int row = tid >> 3, ch = tid & 7; const bf16* src = HI + (size_t)(m0 + row) * 512 + hh * 128 + 8 * ch; unsigned char* dst = lds + HG_V + row * 272 + 16 * ch;
    const v4u a = *(const v4u*)src, b = *(const v4u*)(src + 64); *(v4u*)dst = a; *(v4u*)(dst + 128) = b;
}
__device__ __forceinline__ void hg_local(const Params& p, unsigned char* lds, int tid, int wave, int lane, int bx, int G) {
    const float* HF = (const float*)(p.ws + WS_HF); const bf16* HI = (const bf16*)(p.ws + WS_HI); bf16* ST = (bf16*)(p.ws + WS_ST); float* DEC = (float*)(p.ws + WS_DEC);
    const float* bc = (const float*)(lds + HG_BC); const int kq = lane >> 4, fr = lane & 15;
    for (int it = bx; it < 1024; it += G) {
        const int b = it >> 9, hh = (it >> 7) & 3, c = it & 127, m0 = b * SEQ + c * 64;
        hg_cumsum(HF + (size_t)m0 * 512 + hh * 128, lds, tid);
        { const int seg = tid >> 7, k = tid & 127; const float ref = bc[31 * 132 + k]; unsigned w[8];
#pragma unroll
          for (int i = 0; i < 16; i += 2) { float km[2];
#pragma unroll
              for (int e = 0; e < 2; ++e) { const int s = 16 * seg + i + e; const float bs = bc[s * 132 + k]; const float prev = s > 0 ? bc[(s - 1) * 132 + k] : 0.f; km[e] = (1.0f - __expf(bs - prev)) * __expf(ref - bs); }
              w[i >> 1] = pk2(km[0], km[1]); }
          unsigned char* dst = lds + HG_KMT + k * 144 + 32 * seg; *(v4u*)dst = (v4u){w[0], w[1], w[2], w[3]}; *(v4u*)(dst + 16) = (v4u){w[4], w[5], w[6], w[7]}; }
        hg_stage_v(HI, m0, hh, lds, tid);
        if (tid < 128) DEC[(size_t)it * 128 + tid] = __expf(bc[63 * 132 + tid]);
        __syncthreads();
        f32x4 acc[8];
#pragma unroll
        for (int vt = 0; vt < 8; ++vt) acc[vt] = (f32x4){0.f, 0.f, 0.f, 0.f};
#pragma unroll
        for (int ks = 0; ks < 2; ++ks) { const bf16x8_t a = *(const bf16x8_t*)(lds + HG_KMT + (16 * wave + fr) * 144 + 64 * ks + 16 * kq);
            const unsigned char* vb = lds + HG_V + (32 * ks + 8 * kq + (fr >> 2)) * 272 + 8 * (fr & 3);
#pragma unroll
            for (int vt = 0; vt < 8; ++vt) { const bf16x8_t bfr = tr_frag(vb + 32 * vt, vb + 32 * vt + 4 * 272); acc[vt] = __builtin_amdgcn_mfma_f32_16x16x32_bf16(a, bfr, acc[vt], 0, 0, 0); } }
        float sc[4];
#pragma unroll
        for (int e = 0; e < 4; ++e) { const int k = 16 * wave + 4 * kq + e; sc[e] = __expf(bc[63 * 132 + k] - bc[31 * 132 + k]); }
#pragma unroll
        for (int vt = 0; vt < 8; ++vt) { const int v = 16 * vt + fr; const unsigned long long w = (unsigned long long)pk2(acc[vt][0] * sc[0], acc[vt][1] * sc[1]) | ((unsigned long long)pk2(acc[vt][2] * sc[2], acc[vt][3] * sc[3]) << 32);
            *(unsigned long long*)(ST + ((size_t)it * 128 + v) * 128 + 16 * wave + 4 * kq) = w; }
        __syncthreads();
    }
}
__device__ __forceinline__ void hg_scan(const Params& p, int gtid, int NGT) {
    bf16* ST = (bf16*)(p.ws + WS_ST); const float* DEC = (const float*)(p.ws + WS_DEC);
    for (int e = gtid; e < 8 * 16384; e += NGT) { const int bh = e >> 14, vk = e & 16383, k = vk & 127;
        bf16* base = ST + (size_t)bh * 128 * 16384 + vk; const float* dc = DEC + (size_t)bh * 128 * 128 + k; float S = 0.f;
#pragma unroll 8
        for (int c = 0; c < 128; ++c) { const float tmp = bf2f(base[(size_t)c * 16384]); base[(size_t)c * 16384] = (bf16)f2bf(S); S = dc[c * 128] * S + tmp; } }
}
template <bool DBG> __device__ __forceinline__ void hg_out(const Params& p, unsigned char* lds, int tid, int wave, int lane, int bx, int G, float& dnum, float& dden) {
    const float* HF = (const float*)(p.ws + WS_HF); const bf16* HI = (const bf16*)(p.ws + WS_HI); const bf16* HQ = (const bf16*)(p.ws + WS_HQ); const bf16* HGs = (const bf16*)(p.ws + WS_HGS);
    const bf16* ST = (const bf16*)(p.ws + WS_ST); bf16* OHGB = (bf16*)(p.ws + WS_OHGB);
    const float* bc = (const float*)(lds + HG_BC); float* RS = (float*)(lds + HG_RS); const int kq = lane >> 4, fr = lane & 15;
    for (int it = bx; it < 1024; it += G) {
        const int b = it >> 9, hh = (it >> 7) & 3, c = it & 127, m0 = b * SEQ + c * 64;
        hg_cumsum(HF + (size_t)m0 * 512 + hh * 128, lds, tid);
        { const int seg = tid >> 7, k = tid & 127; const float ref = bc[31 * 132 + k];
#pragma unroll 4
          for (int i = 0; i < 16; ++i) { const int t = 16 * seg + i; const float bt = bc[t * 132 + k]; const float prev = t > 0 ? bc[(t - 1) * 132 + k] : 0.f; const float q = bf2f(HQ[(size_t)(m0 + t) * 512 + hh * 128 + k]);
              const float em = __expf(bt - ref);
              *(bf16*)(lds + HG_QM + t * 272 + 2 * k) = (bf16)f2bf(q * em); *(bf16*)(lds + HG_QE + t * 272 + 2 * k) = (bf16)f2bf(q * __expf(bt));
              *(bf16*)(lds + HG_KM + t * 272 + 2 * k) = (bf16)f2bf((1.0f - __expf(bt - prev)) * __builtin_amdgcn_rcpf(em)); } }
        hg_stage_v(HI, m0, hh, lds, tid);
        __syncthreads();
        const int tt = wave >> 1;
        {
#pragma unroll
            for (int si = 0; si < 2; ++si) { const int st = 2 * (wave & 1) + si; f32x4 a4 = (f32x4){0.f, 0.f, 0.f, 0.f};
#pragma unroll
                for (int ks = 0; ks < 4; ++ks) { const bf16x8_t a = *(const bf16x8_t*)(lds + HG_QM + (16 * tt + fr) * 272 + 64 * ks + 16 * kq), bb = *(const bf16x8_t*)(lds + HG_KM + (16 * st + fr) * 272 + 64 * ks + 16 * kq);
                    a4 = __builtin_amdgcn_mfma_f32_16x16x32_bf16(a, bb, a4, 0, 0, 0); }
#pragma unroll
                for (int e = 0; e < 4; ++e) { const int t = 16 * tt + 4 * kq + e, s = 16 * st + fr; *(bf16*)(lds + HG_AM + t * 144 + 2 * s) = (bf16)f2bf(s <= t ? a4[e] : 0.f); } }
        }
        __syncthreads();
        f32x4 acc[4]; const int vh = wave & 1; const bf16* Sit = ST + (size_t)it * 16384;
#pragma unroll
        for (int vt = 0; vt < 4; ++vt) acc[vt] = (f32x4){0.f, 0.f, 0.f, 0.f};
#pragma unroll
        for (int ks = 0; ks < 4; ++ks) { const bf16x8_t a = *(const bf16x8_t*)(lds + HG_QE + (16 * tt + fr) * 272 + 64 * ks + 16 * kq);
#pragma unroll
            for (int vt = 0; vt < 4; ++vt) { const bf16x8_t bb = *(const bf16x8_t*)(Sit + (size_t)(64 * vh + 16 * vt + fr) * 128 + 32 * ks + 8 * kq); acc[vt] = __builtin_amdgcn_mfma_f32_16x16x32_bf16(a, bb, acc[vt], 0, 0, 0); } }
#pragma unroll
        for (int ks = 0; ks < 2; ++ks) { const bf16x8_t a = *(const bf16x8_t*)(lds + HG_AM + (16 * tt + fr) * 144 + 64 * ks + 16 * kq);
            const unsigned char* vb = lds + HG_V + (32 * ks + 8 * kq + (fr >> 2)) * 272 + 8 * (fr & 3) + 128 * vh;
#pragma unroll
            for (int vt = 0; vt < 4; ++vt) { const bf16x8_t bfr = tr_frag(vb + 32 * vt, vb + 32 * vt + 4 * 272); acc[vt] = __builtin_amdgcn_mfma_f32_16x16x32_bf16(a, bfr, acc[vt], 0, 0, 0); } }
        float ss[4];
#pragma unroll
        for (int e = 0; e < 4; ++e) { float s = 0.f;
#pragma unroll
            for (int vt = 0; vt < 4; ++vt) s += acc[vt][e] * acc[vt][e];
            s += __shfl_xor(s, 1); s += __shfl_xor(s, 2); s += __shfl_xor(s, 4); s += __shfl_xor(s, 8); ss[e] = s; }
        if (fr == 0) {
#pragma unroll
            for (int e = 0; e < 4; ++e) RS[(16 * tt + 4 * kq + e) * 2 + vh] = ss[e]; }
        __syncthreads();
#pragma unroll
        for (int e = 0; e < 4; ++e) { const int t = 16 * tt + 4 * kq + e; const float rinv = 1.0f / sqrtf((RS[t * 2] + RS[t * 2 + 1]) * (1.0f / 128.0f) + 1e-6f);
#pragma unroll
            for (int vt = 0; vt < 4; ++vt) { const int v = 64 * vh + 16 * vt + fr; const size_t oi = (size_t)(m0 + t) * 512 + hh * 128 + v; const float val = acc[vt][e] * rinv * p.hg_norm[v] * bf2f(HGs[oi]);
                if (DBG) { const float rf = bf2f(OHGB[oi]); dnum += (val - rf) * (val - rf); dden += rf * rf; } else OHGB[oi] = (bf16)f2bf(val); } }
        __syncthreads();
    }
}
constexpr size_t M_KC = 6 * MiB, M_VC = 6 * MiB + 512 * 1024;
constexpr size_t OFF_CB = 4096;
__device__ __forceinline__ void f_compress(const Params& p, unsigned char* lds, int tid, int wave, int lane, int bx, int G) {
    const bf16* KV = (const bf16*)(p.ws + WS_KV); const bf16* Wc = (const bf16*)(p.ws + WS_WCMP); const float* cb = (const float*)(p.ws + WS_SMALL + OFF_CB); const float* rope = (const float*)(p.ws + WS_SMALL + 65536);
    float* part = (float*)lds; const int kq = lane >> 4, fr = lane & 15;
    for (int it = bx; it < 256; it += G) {
        const int j = it & 1, nblk = (it >> 1) & 31, g = (it >> 6) & 1, b = it >> 7; const int n = 16 * nblk + fr;
        f32x4 acc[4];
#pragma unroll
        for (int ct = 0; ct < 4; ++ct) acc[ct] = (f32x4){0.f, 0.f, 0.f, 0.f};
#pragma unroll
        for (int kk = 0; kk < 8; ++kk) { const int ks = 8 * wave + kk, lt = ks >> 1, d0 = (ks & 1) * 32 + 8 * kq; int tr = 16 * n + lt; tr = tr > SEQ - 1 ? SEQ - 1 : tr;
            const bf16x8_t a = *(const bf16x8_t*)(KV + (size_t)(b * SEQ + tr) * 768 + j * 128 + g * 64 + d0);
#pragma unroll
            for (int ct = 0; ct < 4; ++ct) { const bf16x8_t bb = *(const bf16x8_t*)(Wc + (size_t)(j * 64 + 16 * ct + fr) * 2048 + 32 * ks + 8 * kq); acc[ct] = __builtin_amdgcn_mfma_f32_16x16x32_bf16(a, bb, acc[ct], 0, 0, 0); } }
#pragma unroll
        for (int ct = 0; ct < 4; ++ct)
#pragma unroll
            for (int e = 0; e < 4; ++e) part[wave * 1024 + (4 * kq + e) * 64 + 16 * ct + fr] = acc[ct][e];
        __syncthreads();
        { const int row = tid >> 5, cp = tid & 31, c0 = 2 * cp; float v0 = cb[j * 64 + c0], v1 = cb[j * 64 + c0 + 1];
#pragma unroll
          for (int w = 0; w < 8; ++w) { v0 += part[w * 1024 + row * 64 + c0]; v1 += part[w * 1024 + row * 64 + c0 + 1]; }
          const int nn = 16 * nblk + row;
          if (j == 0 && cp < 8) { const float cs = rope[(size_t)(16 * nn) * 16 + 2 * cp], sn = rope[(size_t)(16 * nn) * 16 + 2 * cp + 1]; const float t1 = v0, t2 = v1; v0 = t1 * cs - t2 * sn; v1 = t2 * cs + t1 * sn; }
          unsigned* dst = (unsigned*)((bf16*)(p.ws + WS_MISC + (j == 0 ? M_KC : M_VC)) + ((size_t)(b * 2 + g) * 512 + nn) * 64 + c0); *dst = pk2(v0, v1); }
        __syncthreads();
    }
}
constexpr int NS_KB = 0, NS_VB = 9216, NS_BUF = 18432;
constexpr int NS_PW = 36864;
constexpr int NS_PCS = 55296;
constexpr int NS_SELM = 120832, NS_QMASK = 121344;
struct NsaSt { f32x4 O[4]; float m[4], l[4]; };
struct U4 { unsigned a, b, c, d; };
__device__ __forceinline__ unsigned ns_bit(const U4 m, int j) { const unsigned w = j < 64 ? (j < 32 ? m.a : m.b) : (j < 96 ? m.c : m.d); return (w >> (j & 31)) & 1u; }
__device__ __forceinline__ void ns_setbit(U4& m, int bi) { const unsigned v = 1u << (bi & 31); const int q = bi >> 5; m.a |= q == 0 ? v : 0u; m.b |= q == 1 ? v : 0u; m.c |= q == 2 ? v : 0u; m.d |= q == 3 ? v : 0u; }
__device__ __forceinline__ void ns_reset(NsaSt& s) {
#pragma unroll
    for (int i = 0; i < 4; ++i) { s.O[i] = (f32x4){0.f, 0.f, 0.f, 0.f}; s.m[i] = -1.0e30f; s.l[i] = 0.f; } }
__device__ __forceinline__ void ns_scores(f32x4 (&s)[4], const bf16x8_t (&qa)[2], const unsigned char* KB, int kq, int fr) {
#pragma unroll
    for (int ct = 0; ct < 4; ++ct) { s[ct] = (f32x4){0.f, 0.f, 0.f, 0.f};
#pragma unroll
        for (int ks = 0; ks < 2; ++ks) { const bf16x8_t bb = *(const bf16x8_t*)(KB + (16 * ct + fr) * 144 + 64 * ks + 16 * kq); s[ct] = __builtin_amdgcn_mfma_f32_16x16x32_bf16(qa[ks], bb, s[ct], 0, 0, 0); } }
}
__device__ __forceinline__ void ns_pv(f32x4 (&O)[4], const f32x4 (&pr)[4], unsigned char* PW, const unsigned char* VB, int kq, int fr) {
#pragma unroll
    for (int ct = 0; ct < 4; ++ct)
#pragma unroll
        for (int e = 0; e < 4; ++e) *(bf16*)(PW + (4 * kq + e) * 144 + 2 * (16 * ct + fr)) = (bf16)f2bf(pr[ct][e]);
    WAVE_LDS_FENCE();
#pragma unroll
    for (int ks = 0; ks < 2; ++ks) { const bf16x8_t a = *(const bf16x8_t*)(PW + fr * 144 + 64 * ks + 16 * kq);
        const unsigned char* vb = VB + (32 * ks + 8 * kq + (fr >> 2)) * 144 + 8 * (fr & 3);
#pragma unroll
        for (int dt = 0; dt < 4; ++dt) { const bf16x8_t bfr = tr_frag(vb + 32 * dt, vb + 32 * dt + 4 * 144); O[dt] = __builtin_amdgcn_mfma_f32_16x16x32_bf16(a, bfr, O[dt], 0, 0, 0); } }
    WAVE_LDS_FENCE();
}
__device__ __forceinline__ void ns_online(NsaSt& st, f32x4 (&s)[4], const bool (&vm)[4], unsigned char* PW, const unsigned char* VB, int kq, int fr) {
    f32x4 pr[4];
#pragma unroll
    for (int e = 0; e < 4; ++e) { float mx = -1.0e30f;
#pragma unroll
        for (int ct = 0; ct < 4; ++ct) mx = fmaxf(mx, vm[ct] ? s[ct][e] : -1.0e30f);
        mx = fmaxf(mx, __shfl_xor(mx, 1)); mx = fmaxf(mx, __shfl_xor(mx, 2)); mx = fmaxf(mx, __shfl_xor(mx, 4)); mx = fmaxf(mx, __shfl_xor(mx, 8));
        const float mn = fmaxf(st.m[e], mx); const float al = __expf(st.m[e] - mn); st.m[e] = mn; float ps = 0.f;
#pragma unroll
        for (int ct = 0; ct < 4; ++ct) { const float pv = vm[ct] ? __expf(s[ct][e] - mn) : 0.f; pr[ct][e] = pv; ps += pv; }
        st.l[e] = st.l[e] * al + ps;
#pragma unroll
        for (int dt = 0; dt < 4; ++dt) st.O[dt][e] *= al; }
    ns_pv(st.O, pr, PW, VB, kq, fr);
}
__device__ __forceinline__ float ns_rowsum(float v) { v += __shfl_xor(v, 1); v += __shfl_xor(v, 2); v += __shfl_xor(v, 4); v += __shfl_xor(v, 8); return v; }
struct NsStage { v4u k, v; };
__device__ __forceinline__ void ns_load(NsStage& r, const bf16* Kp, const bf16* Vp, size_t stride, int tid) { const int row = tid >> 3, ch = tid & 7; r.k = *(const v4u*)(Kp + (size_t)row * stride + 8 * ch); r.v = *(const v4u*)(Vp + (size_t)row * stride + 8 * ch); }
__device__ __forceinline__ void ns_store(const NsStage& r, unsigned char* lds, int buf, int tid) { const int row = tid >> 3, ch = tid & 7; *(v4u*)(lds + buf * NS_BUF + NS_KB + row * 144 + 16 * ch) = r.k; *(v4u*)(lds + buf * NS_BUF + NS_VB + row * 144 + 16 * ch) = r.v; }

template <int DBG> __device__ __forceinline__ void f_nsa(const Params& p, unsigned char* lds, int tid, int wave, int lane, int bx, int G, float& dnum, float& dden) {
    const bf16* Q = (const bf16*)(p.ws + WS_Q); const bf16* KV = (const bf16*)(p.ws + WS_KV); const float* GT = (const float*)(p.ws + WS_GT);
    const bf16* KC = (const bf16*)(p.ws + WS_MISC + M_KC); const bf16* VC = (const bf16*)(p.ws + WS_MISC + M_VC); bf16* ONSAB = (bf16*)(p.ws + WS_ONSAB);
    const int kq = lane >> 4, fr = lane & 15;
    unsigned char* PW = lds + NS_PW + wave * 2304; float* PCS = (float*)(lds + NS_PCS); volatile unsigned* SELM = (volatile unsigned*)(lds + NS_SELM); volatile unsigned* QMASK = (volatile unsigned*)(lds + NS_QMASK);
    for (int it = bx; it < 1024; it += G) {
        const int ii = it >> 8, c8 = it & 255; const int tile = (ii & 1) ? 255 - c8 : c8;
        const int b = ii >> 1, gg = ii & 1;
        const int t0 = tile * 32, m0 = b * SEQ + t0, m0w = m0 + 4 * wave, tL = t0 + 4 * wave + kq;
        bf16x8_t qa[2];
#pragma unroll
        for (int ks = 0; ks < 2; ++ks) qa[ks] = *(const bf16x8_t*)(Q + (size_t)(m0w + (fr >> 2)) * 512 + (gg * 4 + (fr & 3)) * 64 + 32 * ks + 8 * kq);
        f32x4 oacc[4];
#pragma unroll
        for (int dt = 0; dt < 4; ++dt) oacc[dt] = (f32x4){0.f, 0.f, 0.f, 0.f};
        NsaSt st; NsStage sr; f32x4 s[4]; bool vm[4];
        const int nvL = tL >= 31 ? (tL - 31) / 16 + 1 : 0; const int nvT = (t0 + 31 - 31) / 16 + 1; const int NBc = (nvT + 63) >> 6;
        const bf16* KCb = KC + (size_t)(b * 2 + gg) * 512 * 64; const bf16* VCb = VC + (size_t)(b * 2 + gg) * 512 * 64;
        float rl[4];
        for (int pass = 0; pass < 2; ++pass) {
            if (pass == 0) ns_reset(st);
            else {
#pragma unroll
                for (int e = 0; e < 4; ++e) { const float L = ns_rowsum(st.l[e]); rl[e] = L > 0.f ? 1.0f / L : 0.f; }
#pragma unroll
                for (int dt = 0; dt < 4; ++dt) st.O[dt] = (f32x4){0.f, 0.f, 0.f, 0.f}; }
            ns_load(sr, KCb, VCb, 64, tid); ns_store(sr, lds, 0, tid); __syncthreads();
            for (int i = 0; i < NBc; ++i) {
                if (i + 1 < NBc) ns_load(sr, KCb + (size_t)(i + 1) * 64 * 64, VCb + (size_t)(i + 1) * 64 * 64, 64, tid);
                const unsigned char* KB = lds + (i & 1) * NS_BUF + NS_KB; const unsigned char* VB = lds + (i & 1) * NS_BUF + NS_VB;
                ns_scores(s, qa, KB, kq, fr);
#pragma unroll
                for (int ct = 0; ct < 4; ++ct) vm[ct] = (64 * i + 16 * ct + fr) < nvL;
                if (pass == 0) {
#pragma unroll
                    for (int e = 0; e < 4; ++e) { float mx = -1.0e30f;
#pragma unroll
                        for (int ct = 0; ct < 4; ++ct) mx = fmaxf(mx, vm[ct] ? s[ct][e] : -1.0e30f);
                        mx = fmaxf(mx, __shfl_xor(mx, 1)); mx = fmaxf(mx, __shfl_xor(mx, 2)); mx = fmaxf(mx, __shfl_xor(mx, 4)); mx = fmaxf(mx, __shfl_xor(mx, 8));
                        const float mn = fmaxf(st.m[e], mx); const float al = __expf(st.m[e] - mn); st.m[e] = mn; float ps = 0.f;
#pragma unroll
                        for (int ct = 0; ct < 4; ++ct) ps += vm[ct] ? __expf(s[ct][e] - mn) : 0.f;
                        st.l[e] = st.l[e] * al + ps; }
                } else { f32x4 pr[4];
#pragma unroll
                    for (int ct = 0; ct < 4; ++ct) { float ph = 0.f;
#pragma unroll
                        for (int e = 0; e < 4; ++e) { const float pv = vm[ct] ? __expf(s[ct][e] - st.m[e]) * rl[e] : 0.f; pr[ct][e] = pv; ph += pv; }
                        PCS[(4 * wave + kq) * 512 + 64 * i + 16 * ct + fr] = ph; }
                    ns_pv(st.O, pr, PW, VB, kq, fr); }
                if (i + 1 < NBc) ns_store(sr, lds, (i + 1) & 1, tid);
                __syncthreads();
            }
        }
#pragma unroll
        for (int e = 0; e < 4; ++e) { const float gate = GT[(size_t)(m0w + kq) * 24 + (gg * 4 + e) * 3 + 0];
#pragma unroll
            for (int dt = 0; dt < 4; ++dt) oacc[dt][e] = gate * st.O[dt][e]; }
        U4 qm = {0u, 0u, 0u, 0u};
        for (int tk = 0; tk < 4; ++tk) { const int t = t0 + 4 * wave + tk, nv = t >= 31 ? (t - 31) / 16 + 1 : 0, jc = t >> 6; U4 mk = {0u, 0u, 0u, 0u};
            if (DBG == 2) { const int* selidx = (const int*)(p.ws + WS_MISC) + ((size_t)(m0w + tk) * 2 + gg) * TOPN;
                for (int k = 0; k < TOPN; ++k) ns_setbit(mk, selidx[k]);
            } else {
                float v0, v1; const float* pc = PCS + (4 * wave + tk) * 512;
                { float i0 = 0.f, i1 = 0.f;
#pragma unroll
                  for (int d = -1; d <= 3; ++d) { const int n0 = 4 * lane + d, n1 = 4 * (lane + 64) + d; if (n0 >= 0 && n0 < nv) i0 += pc[n0]; if (n1 < nv) i1 += pc[n1]; }
                  v0 = (lane == jc || lane == 0) ? 1.0e4f : (64 * lane <= t ? i0 : -1.0f); v1 = (lane + 64 == jc) ? 1.0e4f : (64 * (lane + 64) <= t ? i1 : -1.0f); }
                for (int k = 0; k < TOPN; ++k) { float bv; int bi;
                    if (v0 >= v1) { bv = v0; bi = lane; } else { bv = v1; bi = lane + 64; }
#pragma unroll
                    for (int o2 = 1; o2 < 64; o2 <<= 1) { const float ov = __shfl_xor(bv, o2); const int oi = __shfl_xor(bi, o2); if (ov > bv || (ov == bv && oi < bi)) { bv = ov; bi = oi; } }
                    bi = __builtin_amdgcn_readfirstlane(bi);
                    ns_setbit(mk, bi);
                    if (bi == lane) v0 = -3.0e38f; if (bi == lane + 64) v1 = -3.0e38f; }
            }
            qm.a |= mk.a; qm.b |= mk.b; qm.c |= mk.c; qm.d |= mk.d;
            if (lane == 0) { SELM[(4 * wave + tk) * 4 + 0] = mk.a; SELM[(4 * wave + tk) * 4 + 1] = mk.b; SELM[(4 * wave + tk) * 4 + 2] = mk.c; SELM[(4 * wave + tk) * 4 + 3] = mk.d; }
            if (DBG == 3) {
                const int* selidx = (const int*)(p.ws + WS_MISC) + ((size_t)(m0w + tk) * 2 + gg) * TOPN; U4 rk = {0u, 0u, 0u, 0u};
                for (int k = 0; k < TOPN; ++k) ns_setbit(rk, selidx[k]);
                unsigned diff = 0u;
                for (int j2 = 0; j2 <= jc; ++j2) diff |= ns_bit(rk, j2) ^ ns_bit(mk, j2);
                if (lane == 0) { dnum += diff ? 1.0f : 0.0f; dden += 1.0f; } }
        }
        if (lane == 0) { QMASK[wave * 4 + 0] = qm.a; QMASK[wave * 4 + 1] = qm.b; QMASK[wave * 4 + 2] = qm.c; QMASK[wave * 4 + 3] = qm.d; }
        __syncthreads();
        U4 um;
        { unsigned u0 = 0u, u1 = 0u, u2 = 0u, u3 = 0u; for (int w = 0; w < 8; ++w) { u0 |= QMASK[w * 4 + 0]; u1 |= QMASK[w * 4 + 1]; u2 |= QMASK[w * 4 + 2]; u3 |= QMASK[w * 4 + 3]; }
          um.a = __builtin_amdgcn_readfirstlane(u0); um.b = __builtin_amdgcn_readfirstlane(u1); um.c = __builtin_amdgcn_readfirstlane(u2); um.d = __builtin_amdgcn_readfirstlane(u3); }
        {
            ns_reset(st);
            const int jmax = (t0 + 31) >> 6;
            auto nextj = [&](int from) -> int { for (int j = from; j <= jmax; ++j) if (ns_bit(um, j)) return j; return -1; };
            const bf16* Kg = KV + (size_t)(b * SEQ) * 768 + 256 + gg * 64; const bf16* Vg = KV + (size_t)(b * SEQ) * 768 + 384 + gg * 64;
            int j = nextj(0), i = 0;
            ns_load(sr, Kg + (size_t)(64 * j) * 768, Vg + (size_t)(64 * j) * 768, 768, tid); ns_store(sr, lds, 0, tid); __syncthreads();
            while (j >= 0) {
                const int jn = nextj(j + 1);
                if (jn >= 0) ns_load(sr, Kg + (size_t)(64 * jn) * 768, Vg + (size_t)(64 * jn) * 768, 768, tid);
                if (ns_bit(qm, j)) {
                    const unsigned char* KB = lds + (i & 1) * NS_BUF + NS_KB; const unsigned char* VB = lds + (i & 1) * NS_BUF + NS_VB;
                    ns_scores(s, qa, KB, kq, fr);
                    const bool selb = (SELM[(4 * wave + kq) * 4 + (j >> 5)] >> (j & 31)) & 1u;
#pragma unroll
                    for (int ct = 0; ct < 4; ++ct) vm[ct] = selb && (64 * j + 16 * ct + fr) <= tL;
                    ns_online(st, s, vm, PW, VB, kq, fr);
                }
                if (jn >= 0) ns_store(sr, lds, (i + 1) & 1, tid);
                __syncthreads();
                j = jn; ++i;
            }
#pragma unroll
            for (int e = 0; e < 4; ++e) { const float L = ns_rowsum(st.l[e]); const float gate = GT[(size_t)(m0w + kq) * 24 + (gg * 4 + e) * 3 + 1] * (L > 0.f ? 1.0f / L : 0.f);
#pragma unroll
                for (int dt = 0; dt < 4; ++dt) oacc[dt][e] += gate * st.O[dt][e]; }
        }
        {
            ns_reset(st);
            const int j0 = (t0 - 511) > 0 ? (t0 - 511) >> 6 : 0, j1 = (t0 + 31) >> 6;
            const bf16* Kg = KV + (size_t)(b * SEQ) * 768 + 512 + gg * 64; const bf16* Vg = KV + (size_t)(b * SEQ) * 768 + 640 + gg * 64;
            ns_load(sr, Kg + (size_t)(64 * j0) * 768, Vg + (size_t)(64 * j0) * 768, 768, tid); ns_store(sr, lds, 0, tid); __syncthreads();
            for (int j = j0, i = 0; j <= j1; ++j, ++i) {
                if (j + 1 <= j1) ns_load(sr, Kg + (size_t)(64 * (j + 1)) * 768, Vg + (size_t)(64 * (j + 1)) * 768, 768, tid);
                const unsigned char* KB = lds + (i & 1) * NS_BUF + NS_KB; const unsigned char* VB = lds + (i & 1) * NS_BUF + NS_VB;
                ns_scores(s, qa, KB, kq, fr);
#pragma unroll
                for (int ct = 0; ct < 4; ++ct) { const int kp = 64 * j + 16 * ct + fr; vm[ct] = kp <= tL && kp >= tL - 511; }
                ns_online(st, s, vm, PW, VB, kq, fr);
                if (j + 1 <= j1) ns_store(sr, lds, (i + 1) & 1, tid);
                __syncthreads();
            }
#pragma unroll
            for (int e = 0; e < 4; ++e) { const float L = ns_rowsum(st.l[e]); const float gate = GT[(size_t)(m0w + kq) * 24 + (gg * 4 + e) * 3 + 2] * (L > 0.f ? 1.0f / L : 0.f);
#pragma unroll
                for (int dt = 0; dt < 4; ++dt) oacc[dt][e] += gate * st.O[dt][e]; }
        }
#pragma unroll
        for (int e = 0; e < 4; ++e)
#pragma unroll
            for (int dt = 0; dt < 4; ++dt) { const size_t oi = (size_t)(m0w + kq) * 512 + (gg * 4 + e) * 64 + 16 * dt + fr; const float val = oacc[dt][e];
                if (DBG == 2) { const float rf = bf2f(ONSAB[oi]); dnum += (val - rf) * (val - rf); dden += rf * rf; } else if (DBG == 0) ONSAB[oi] = (bf16)f2bf(val); }
        __syncthreads();
    }
}
__device__ __forceinline__ void f_router(const Params& p, unsigned char* lds, int wave, int lane, int gw, int NGW) {
    { float* scr = (float*)(lds + wave * 8448); bf16* Wd_t = (bf16*)(p.ws + WS_WD); bf16* Wgu_t = (bf16*)(p.ws + WS_WGU);
      for (int r = gw; r < NE * 8 * 32; r += NGW) { const int e = r >> 8, rem = r & 255, kb = rem >> 5, nb = rem & 31; const float* W = p.w_down + (size_t)e * FF * DM;
          tr_item([W](int k, int n) { return W[(size_t)k * DM + n]; }, FF, Wd_t + (size_t)e * DM * FF, 32 * nb, 64 * kb, scr, lane); }
      for (int r = gw; r < NE * 16 * 32; r += NGW) { const int e = r >> 9, rem = r & 511, kb = rem >> 5, nb = rem & 31; const int n0 = 32 * nb, which = (n0 >> 7) & 1, cb = (n0 >> 8) * 128 + (n0 & 127) - n0;
          const float* W = (which ? p.w_up : p.w_gate) + (size_t)e * DM * FF;
          tr_item([W, cb](int k, int n) { return W[(size_t)k * FF + n + cb]; }, DM, Wgu_t + (size_t)e * 1024 * DM, n0, 64 * kb, scr, lane); } }
    __syncthreads();
    float* lg = (float*)(lds + wave * 4096); float* rr = lg + 16 * 48;
    const bf16* Wh = (const bf16*)(p.ws + WS_SMALL + OFF_WRH); const bf16* Wl = (const bf16*)(p.ws + WS_SMALL + OFF_WRL);
    int* eid = (int*)(p.ws + WS_MISC + M_EID); float* ew = (float*)(p.ws + WS_MISC + M_EW); int* slot = (int*)(p.ws + WS_MISC + M_SLOT); float* rinv = (float*)(p.ws + WS_MISC + M_RINV);
    int* cnt = (int*)(p.ws + WS_CTL) + CW_CNT;
    const int row = lane & 15, kq = lane >> 4;
    for (int it = gw; it < TOK / 16; it += NGW) {
        const int m0 = it * 16; const float* xr = p.out + (size_t)(m0 + row) * DM;
        f32x4 acc[3]; acc[0] = (f32x4){0.f, 0.f, 0.f, 0.f}; acc[1] = acc[0]; acc[2] = acc[0]; float ss = 0.f;
        for (int s = 0; s < 32; ++s) { const int k0 = 32 * s + 8 * kq;
            const f32x4 x0 = *(const f32x4*)(xr + k0), x1 = *(const f32x4*)(xr + k0 + 4); const f32x4 g0 = *(const f32x4*)(p.ffn_norm + k0), g1 = *(const f32x4*)(p.ffn_norm + k0 + 4);
            ss += (x0.x * x0.x + x0.y * x0.y) + (x0.z * x0.z + x0.w * x0.w) + (x1.x * x1.x + x1.y * x1.y) + (x1.z * x1.z + x1.w * x1.w);
            const f32x4 y0 = x0 * g0, y1 = x1 * g1; bf16x8_t ah, al;
#pragma unroll
            for (int j = 0; j < 4; ++j) { unsigned h = f2bf(y0[j]); ah[j] = (short)h; al[j] = (short)f2bf(y0[j] - __builtin_bit_cast(float, h << 16)); h = f2bf(y1[j]); ah[4 + j] = (short)h; al[4 + j] = (short)f2bf(y1[j] - __builtin_bit_cast(float, h << 16)); }
#pragma unroll
            for (int ct = 0; ct < 3; ++ct) { const bf16x8_t bh = *(const bf16x8_t*)(Wh + (size_t)(16 * ct + row) * DM + k0), bl = *(const bf16x8_t*)(Wl + (size_t)(16 * ct + row) * DM + k0);
                acc[ct] = __builtin_amdgcn_mfma_f32_16x16x32_bf16(ah, bh, acc[ct], 0, 0, 0); acc[ct] = __builtin_amdgcn_mfma_f32_16x16x32_bf16(ah, bl, acc[ct], 0, 0, 0); acc[ct] = __builtin_amdgcn_mfma_f32_16x16x32_bf16(al, bh, acc[ct], 0, 0, 0); } }
        ss += __shfl_xor(ss, 16); ss += __shfl_xor(ss, 32);
        const float ri = 1.0f / sqrtf(ss * (1.0f / DM) + 1e-6f);
        WAVE_LDS_FENCE();
        if (kq == 0) rr[row] = ri;
#pragma unroll
        for (int ct = 0; ct < 3; ++ct)
#pragma unroll
            for (int e = 0; e < 4; ++e) lg[(4 * kq + e) * 48 + 16 * ct + row] = acc[ct][e];
        WAVE_LDS_FENCE();
        if (lane < 16) { const int m = m0 + lane; const float rv = rr[lane]; const float* L = lg + lane * 48;
            float gl[4]; int gs = 0;
#pragma unroll
            for (int i = 0; i < 4; ++i) gl[i] = L[i] * rv + p.b_grp[i];
            float gm = gl[0];
#pragma unroll
            for (int i = 1; i < 4; ++i) if (gl[i] > gm) { gm = gl[i]; gs = i; }
            float den = 0.f;
#pragma unroll
            for (int i = 0; i < 4; ++i) den += expf(gl[i] - gm);
            const float gp = 1.0f / den;
            float el[8];
#pragma unroll
            for (int i = 0; i < 8; ++i) el[i] = L[4 + gs * 8 + i] * rv + p.b_rtr[gs * 8 + i];
            int i0 = 0; float b0 = el[0];
#pragma unroll
            for (int i = 1; i < 8; ++i) if (el[i] > b0) { b0 = el[i]; i0 = i; }
            int i1 = -1; float b1 = -3.0e38f;
#pragma unroll
            for (int i = 0; i < 8; ++i) if (i != i0 && el[i] > b1) { b1 = el[i]; i1 = i; }
            const float e1 = expf(b1 - b0); const float w0 = 1.0f / (1.0f + e1), w1 = e1 / (1.0f + e1);
            const int ea = gs * 8 + i0, eb = gs * 8 + i1;
            eid[m * 2] = ea; eid[m * 2 + 1] = eb; ew[m * 2] = w0 * gp; ew[m * 2 + 1] = w1 * gp; rinv[m] = rv;
            slot[m * 2] = atomicAdd(&cnt[ea], 1); slot[m * 2 + 1] = atomicAdd(&cnt[eb], 1); }
    }
}
__device__ __forceinline__ void f_fill(const Params& p, volatile LAS unsigned* MISC, int tid, int lane, int gw, int NGW) {
    const int* cnt = (const int*)(p.ws + WS_CTL) + CW_CNT;
    if (tid == 0) { unsigned a = 0; for (int q = 0; q < NE; ++q) { MISC[MISC_TP + q] = a; a += ((unsigned)__hip_atomic_load(cnt + q, __ATOMIC_RELAXED, __HIP_MEMORY_SCOPE_AGENT) + 255u) >> 8; } MISC[MISC_TP + NE] = a; }
    __syncthreads();
    const int* eid = (const int*)(p.ws + WS_MISC + M_EID); const int* slot = (const int*)(p.ws + WS_MISC + M_SLOT); int* pos = (int*)(p.ws + WS_MISC + M_POS);
    const float* rinv = (const float*)(p.ws + WS_MISC + M_RINV); float* rs = (float*)(p.ws + WS_MISC + M_RS); bf16* H2S = (bf16*)(p.ws + WS_H2S);
    for (int m = gw; m < TOK; m += NGW) {
        const int ra = (int)MISC[MISC_TP + eid[2 * m]] * 256 + slot[2 * m], rb = (int)MISC[MISC_TP + eid[2 * m + 1]] * 256 + slot[2 * m + 1];
        if (lane == 0) { pos[2 * m] = ra; pos[2 * m + 1] = rb; const float rv = rinv[m]; rs[ra] = rv; rs[rb] = rv; }
        const f32x4* xr = (const f32x4*)(p.out + (size_t)m * DM) + lane; const f32x4* gr = (const f32x4*)p.ffn_norm + lane;
        unsigned long long* oa = (unsigned long long*)(H2S + (size_t)ra * DM) + lane; unsigned long long* ob = (unsigned long long*)(H2S + (size_t)rb * DM) + lane;
#pragma unroll
        for (int j = 0; j < 4; ++j) { const f32x4 v = xr[64 * j] * gr[64 * j]; const unsigned long long w = (unsigned long long)pk2(v.x, v.y) | ((unsigned long long)pk2(v.z, v.w) << 32); oa[64 * j] = w; ob[64 * j] = w; }
    }
}
__device__ __forceinline__ void f_final(const Params& p, int lane, int gw, int NGW) {
    const bf16* Y = (const bf16*)(p.ws + WS_YB); const int* eid = (const int*)(p.ws + WS_MISC + M_EID); const float* ew = (const float*)(p.ws + WS_MISC + M_EW); const int* pos = (const int*)(p.ws + WS_MISC + M_POS);
    for (int t = gw; t < TOK; t += NGW) {
        int a = 0, b = 1; if (eid[t * 2 + 1] < eid[t * 2]) { a = 1; b = 0; }
        const float wa = ew[t * 2 + a], wb = ew[t * 2 + b];
        const unsigned long long* ya = (const unsigned long long*)(Y + (size_t)pos[t * 2 + a] * DM) + lane; const unsigned long long* yb = (const unsigned long long*)(Y + (size_t)pos[t * 2 + b] * DM) + lane;
        f32x4* xr = (f32x4*)(p.out + (size_t)t * DM) + lane; const f32x4* gr = (const f32x4*)p.final_norm + lane;
        f32x4 v[4]; float s = 0.f;
#pragma unroll
        for (int j = 0; j < 4; ++j) { const unsigned long long qa = ya[64 * j], qb = yb[64 * j]; const unsigned a0 = (unsigned)qa, a1 = (unsigned)(qa >> 32), b0 = (unsigned)qb, b1 = (unsigned)(qb >> 32);
            f32x4 fa, fb; fa.x = __builtin_bit_cast(float, a0 << 16); fa.y = __builtin_bit_cast(float, a0 & 0xffff0000u); fa.z = __builtin_bit_cast(float, a1 << 16); fa.w = __builtin_bit_cast(float, a1 & 0xffff0000u);
            fb.x = __builtin_bit_cast(float, b0 << 16); fb.y = __builtin_bit_cast(float, b0 & 0xffff0000u); fb.z = __builtin_bit_cast(float, b1 << 16); fb.w = __builtin_bit_cast(float, b1 & 0xffff0000u);
            v[j] = xr[64 * j] + (fa * wa + fb * wb); s += (v[j].x * v[j].x + v[j].y * v[j].y) + (v[j].z * v[j].z + v[j].w * v[j].w); }
        float r = 1.0f / sqrtf(wave_sum(s) * (1.0f / DM) + 1e-6f);
        if (DBG_MODE) { const float* dp = (const float*)(p.ws + WS_CTL) + CW_DBG; float num = 0.f, den = 0.f; for (int q = 0; q < 256; ++q) { num += dp[2 * q]; den += dp[2 * q + 1]; } r *= 1.0f + 10.0f * sqrtf(num / den); }
#pragma unroll
        for (int j = 0; j < 4; ++j) { const f32x4 g = gr[64 * j]; f32x4 w; w.x = v[j].x * r * g.x; w.y = v[j].y * r * g.y; w.z = v[j].z * r * g.z; w.w = v[j].w * r * g.w; xr[64 * j] = w; }
    }
}

struct Args { Params p; int pad0, pad1; };
__global__ void __launch_bounds__(NWAVES * 64, 2) mk_fwd(Args args) {
    extern __shared__ __attribute__((aligned(16))) unsigned char lds[];
    const Params& p = args.p;
    const int tid = threadIdx.x, lane = tid & 63, wave = __builtin_amdgcn_readfirstlane(tid >> 6);
    const int G = gridDim.x; const int bx = blockIdx.x; const int vcu = (G % 8 == 0) ? (bx % 8) * (G / 8) + bx / 8 : bx;
    const int gw = vcu * NWAVES + wave, NGW = G * NWAVES, gtid = bx * (NWAVES * 64) + tid, NGT = G * NWAVES * 64;
    volatile LAS unsigned* MISC = (volatile LAS unsigned*)((LAS unsigned char*)lds + MISC_OFF);
    for (int u = tid; u < (LDS_BYTES - MISC_OFF) / 4; u += NWAVES * 64) ((LAS unsigned*)((LAS unsigned char*)lds + MISC_OFF))[u] = 0u;
    __syncthreads();
    gu32* ctl = (gu32*)(p.ws + WS_CTL);
    XcdBarrier bar = xcd_barrier_post((unsigned*)(ctl + CW_BAR), MISC + 8);
#define GRID_BAR() xcd_barrier(bar)

    p0_prologue(p, lds, wave, lane, gw, NGW, gtid, NGT);
    GRID_BAR();
    {
        pg8::Gemm g{(const pg8::bf16_t*)(p.ws + WS_XN), (const pg8::bf16_t*)(p.ws + WS_WIN), TOK, NPROJ, DM, nullptr, nullptr}; pg8::StaticOrder S; S.init(TOK, NPROJ, G, bx);
        pg8::EpiProj E{(pg8::bf16_t*)(p.ws + WS_Q), (pg8::bf16_t*)(p.ws + WS_KV), (pg8::bf16_t*)(p.ws + WS_HQ), (pg8::bf16_t*)(p.ws + WS_HI), (pg8::bf16_t*)(p.ws + WS_HGS), (pg8::bf16_t*)p.out,
                       (float*)(p.ws + WS_HF), (float*)(p.ws + WS_GT), (const float*)(p.ws + WS_SMALL), (const float*)(p.ws + WS_SMALL + 65536)};
        pg8::gemm_phase<pg8::EpiProj, pg8::StaticOrder, true, true>((LAS unsigned char*)lds, g, S, E);
    }
    GRID_BAR();
#define DBG_REDUCE(dn, dd) do { dn = wave_sum(dn); dd = wave_sum(dd); float* red = (float*)lds; __syncthreads(); if (lane == 0) { red[2 * wave] = dn; red[2 * wave + 1] = dd; } __syncthreads(); \
      if (tid == 0) { float a_ = 0.f, b_ = 0.f; for (int q = 0; q < 8; ++q) { a_ += red[2 * q]; b_ += red[2 * q + 1]; } float* dp = (float*)(p.ws + WS_CTL) + CW_DBG; dp[2 * bx] = a_; dp[2 * bx + 1] = b_; } __syncthreads(); } while (0)
#if DBG_MODE == 0
    f_compress(p, lds, tid, wave, lane, bx, G);
    hg_local(p, lds, tid, wave, lane, bx, G);
    GRID_BAR();
    hg_scan(p, gtid, NGT);
    { float dn = 0.f, dd = 0.f; f_nsa<0>(p, lds, tid, wave, lane, bx, G, dn, dd); }
    GRID_BAR();
    { float dn = 0.f, dd = 0.f; hg_out<false>(p, lds, tid, wave, lane, bx, G, dn, dd); }
    GRID_BAR();
#else
    s_compress(p, lane, gw, NGW);
    hg_local(p, lds, tid, wave, lane, bx, G);
    GRID_BAR();
    hg_scan(p, gtid, NGT);
    if (DBG_MODE == 1 && bx < 8) s_hgrn(p, lds, tid, bx);
    __syncthreads();
    s_cmp_attn(p, lds, wave, lane, gw, NGW);
    GRID_BAR();
    s_sparse_attn<0>(p, lds, wave, lane, gw, NGW);
    __syncthreads();
    if (DBG_MODE != 1) { float dn = 0.f, dd = 0.f; hg_out<false>(p, lds, tid, wave, lane, bx, G, dn, dd); }
    GRID_BAR();
    s_sparse_attn<1>(p, lds, wave, lane, gw, NGW);
    if (DBG_MODE == 1) s_hg_post(p, lane, gw, NGW);
    GRID_BAR();
    if (DBG_MODE == 1) { float dn = 0.f, dd = 0.f; hg_out<true>(p, lds, tid, wave, lane, bx, G, dn, dd); DBG_REDUCE(dn, dd); }
    if (DBG_MODE >= 2) { f_compress(p, lds, tid, wave, lane, bx, G); GRID_BAR(); float dn = 0.f, dd = 0.f; f_nsa<DBG_MODE>(p, lds, tid, wave, lane, bx, G, dn, dd); DBG_REDUCE(dn, dd); }
    GRID_BAR();
#endif
    {
        pg8::Gemm g{(const pg8::bf16_t*)(p.ws + WS_ONSAB), (const pg8::bf16_t*)(p.ws + WS_WBRN), TOK, DM, 512, (const pg8::bf16_t*)(p.ws + WS_OHGB), (const pg8::bf16_t*)(p.ws + WS_WBRH)};
        pg8::MergeOrder S; S.init(TOK, DM, G, bx); pg8::EpiMerge E{(const pg8::bf16_t*)p.out, (pg8::bf16_t*)(p.ws + WS_MIX)};
        pg8::gemm_phase<pg8::EpiMerge, pg8::MergeOrder, true, true>((LAS unsigned char*)lds, g, S, E);
    }
    GRID_BAR();
    {
        pg8::Gemm g{(const pg8::bf16_t*)(p.ws + WS_MIX), (const pg8::bf16_t*)(p.ws + WS_WOUT), TOK, DM, DM, nullptr, nullptr};
        pg8::StaticOrder S; S.init(TOK, DM, G, bx); pg8::EpiOut E{p.x, p.out};
        pg8::gemm_phase<pg8::EpiOut, pg8::StaticOrder, true, true>((LAS unsigned char*)lds, g, S, E);
    }
    GRID_BAR();
    f_router(p, lds, wave, lane, gw, NGW);
    GRID_BAR();
    f_fill(p, MISC, tid, lane, gw, NGW);
    GRID_BAR();
    {
        pg8::MoeOrder S{(const volatile PG8_LAS int*)(MISC + MISC_TP), G, bx};
        { pg8::Gemm g{(const pg8::bf16_t*)(p.ws + WS_H2S), (const pg8::bf16_t*)(p.ws + WS_WGU), R_PAD, NE * 1024, DM, nullptr, nullptr};
          pg8::EpiGU E{(const float*)(p.ws + WS_MISC + M_RS), (pg8::bf16_t*)(p.ws + WS_HID)};
          pg8::gemm_phase<pg8::EpiGU, pg8::MoeOrder, true, true>((LAS unsigned char*)lds, g, S, E); }
        GRID_BAR();
        { pg8::Gemm g{(const pg8::bf16_t*)(p.ws + WS_HID), (const pg8::bf16_t*)(p.ws + WS_WD), R_PAD, NE * 1024, FF, nullptr, nullptr};
          pg8::EpiDown E{(pg8::bf16_t*)(p.ws + WS_YB)};
          pg8::gemm_phase<pg8::EpiDown, pg8::MoeOrder, true, true>((LAS unsigned char*)lds, g, S, E); }
    }
    GRID_BAR();
    f_final(p, lane, gw, NGW);
}

extern "C" void kernel_launch(void* const* d_in, const int* in_sizes, int n_in, void* d_out, int out_size, void* d_ws, size_t ws_size, hipStream_t stream) {
    static int grid = 0;
    if (grid == 0) {
        if (n_in != 20 || out_size != TOK * DM || ws_size < WS_END) { fprintf(stderr, "kernel_launch: unexpected problem (n_in %d, out %d, ws %zu)\n", n_in, out_size, ws_size); grid = -1; return; }
        int dev = 0, cus = 0, per_cu = 0;
        if (hipGetDevice(&dev) != hipSuccess || hipDeviceGetAttribute(&cus, hipDeviceAttributeMultiprocessorCount, dev) != hipSuccess) { grid = -1; return; }
        if (hipFuncSetAttribute((const void*)mk_fwd, hipFuncAttributeMaxDynamicSharedMemorySize, LDS_BYTES) != hipSuccess) { fprintf(stderr, "kernel_launch: hipFuncSetAttribute failed\n"); grid = -1; return; }
        if (hipOccupancyMaxActiveBlocksPerMultiprocessor(&per_cu, (const void*)mk_fwd, NWAVES * 64, LDS_BYTES) != hipSuccess || per_cu < 1) { fprintf(stderr, "kernel_launch: occupancy query says %d\n", per_cu); }
        (void)hipGetLastError();
        grid = cus;
    }
    if (grid < 0) return;
    if (hipMemsetAsync((char*)d_ws + WS_CTL, 0, CTL_ZERO_BYTES, stream) != hipSuccess) { fprintf(stderr, "kernel_launch: memset failed\n"); return; }
    Args a{};
    Params& p = a.p;
    p.x = (const float*)d_in[0]; p.attn_norm = (const float*)d_in[1]; p.w_in = (const float*)d_in[2]; p.w_cmp_k = (const float*)d_in[3]; p.w_cmp_v = (const float*)d_in[4]; p.cmp_pos = (const float*)d_in[5];
    p.hg_lb = (const float*)d_in[6]; p.hg_norm = (const float*)d_in[7]; p.w_br_nsa = (const float*)d_in[8]; p.w_br_hg = (const float*)d_in[9]; p.w_out = (const float*)d_in[10]; p.ffn_norm = (const float*)d_in[11];
    p.w_grp = (const float*)d_in[12]; p.b_grp = (const float*)d_in[13]; p.w_rtr = (const float*)d_in[14]; p.b_rtr = (const float*)d_in[15]; p.w_gate = (const float*)d_in[16]; p.w_up = (const float*)d_in[17];
    p.w_down = (const float*)d_in[18]; p.final_norm = (const float*)d_in[19]; p.out = (float*)d_out; p.ws = (unsigned char*)d_ws;
    hipLaunchKernelGGL(mk_fwd, dim3(grid), dim3(NWAVES * 64), LDS_BYTES, stream, a);
}
```

```cpp
#include <hip/hip_runtime.h>
#include <cstdio>
#include <cstdint>
namespace pg8 {
#define PG8_LAS __attribute__((address_space(3)))
typedef unsigned short bf16_t;
typedef short bf16x8 __attribute__((ext_vector_type(8)));
typedef float f32x4 __attribute__((ext_vector_type(4)));
typedef unsigned u32x4 __attribute__((ext_vector_type(4)));
constexpr int BM = 256, BK = 64, HALF = 128, HTB = HALF * BK * 2  , STAGE_BYTES = 8 * HTB, NXCD = 8, WGM = 8;

__host__ __device__ __forceinline__ int lds_byte(int r, int c) { const int st = (r >> 4) * 2 + (c >> 5), rr = r & 15, cc = c & 31, ob = rr * 64 + cc * 2; return st * 1024 + (ob ^ (((ob >> 9) & 1) << 5)); }
__host__ __device__ __forceinline__ void stage_rc(int b, int& R, int& C) { const int st = b / 1024, sb = b % 1024, swz = sb ^ (((sb >> 9) & 1) << 5); R = (st >> 1) * 16 + swz / 64; C = (st & 1) * 32 + (swz % 64) / 2; }
__host__ __device__ __forceinline__ int perm32(int rho) { const int n = rho >> 4, i = rho & 15; return 8 * (i >> 2) + 4 * n + (i & 3); }

struct Unit { int pm, pn, sel; };
struct Gemm { const bf16_t* A; const bf16_t* Bt; int M, N, K; const bf16_t* A2; const bf16_t* Bt2; };

struct StaticOrder {
    int nM, nN, nwg, G, c;
    __host__ __device__ void init(int M, int N, int G_, int c_) { nM = M / BM; nN = N / BM; nwg = nM * nN; G = G_; c = c_; }
    __host__ __device__ bool next(int i, Unit& u) const {
        const long L = (long)i * G + c; if (L >= nwg) return false;
        int wgid = (int)L; { const int q = nwg / NXCD, r = nwg % NXCD, xcd = wgid % NXCD, off = wgid / NXCD; wgid = (xcd < r ? xcd * (q + 1) : r * (q + 1) + (xcd - r) * q) + off; }
        const int nig = WGM * nN, gid = wgid / nig, fm = gid * WGM, gsz = (nM - fm) < WGM ? (nM - fm) : WGM;
        u.pm = fm + ((wgid % nig) % gsz); u.pn = (wgid % nig) / gsz; u.sel = 0; return true;
    }
    __device__ __forceinline__ void a_ready(const Unit&) const {}
    __device__ __forceinline__ void done(const Unit&) const {}
};

__device__ __forceinline__ unsigned cvt_pk_bf16(float lo, float hi) { unsigned r; asm volatile("v_cvt_pk_bf16_f32 %0, %1, %2" : "=v"(r) : "v"(lo), "v"(hi)); return r; }
__device__ __forceinline__ float sigm(float x) { return __builtin_amdgcn_rcpf(1.0f + __expf(-x)); }
__device__ __forceinline__ void rot2(float& a, float& b, float c, float s) { const float t1 = a, t2 = b; a = t1 * c - t2 * s; b = t2 * c + t1 * s; }
__device__ __forceinline__ void st_bf16x8(bf16_t* dst, const float (&v)[8]) { u32x4 w; w.x = cvt_pk_bf16(v[0], v[1]); w.y = cvt_pk_bf16(v[2], v[3]); w.z = cvt_pk_bf16(v[4], v[5]); w.w = cvt_pk_bf16(v[6], v[7]); *(u32x4*)dst = w; }
struct EpiProj {
    static constexpr bool PERM = true, AFTER_DRAIN = false;
    __device__ __forceinline__ bool keep(const Unit&) const { return false; }
    bf16_t *Q, *KV, *HQ, *HI, *HGs, *MG; float *HF, *GT; const float* lb; const float* rope;
    __device__ __forceinline__ void operator()(const f32x4 (&acc)[2][2][4][2], const Unit& u, int wr, int wc, int fr, int fq) const {
        const int pn = u.pn; int row0 = u.pm * BM + wr * 64 + fr; int cw = wc * 32 + 8 * fq; asm volatile("" : "+v"(row0), "+v"(cw));
#pragma unroll
        for (int ai = 0; ai < 2; ++ai)
#pragma unroll
            for (int m = 0; m < 4; ++m) {
                const int row = row0 + ai * HALF + m * 16; const int pos = row & 8191;
#pragma unroll
                for (int bj = 0; bj < 2; ++bj) {
                    float v[8];
#pragma unroll
                    for (int e = 0; e < 4; ++e) { v[e] = acc[ai][bj][m][0][e]; v[4 + e] = acc[ai][bj][m][1][e]; }
                    const int c = bj * HALF + cw;
                    if (pn < 5) {
                        bool dorope; bf16_t* dst; float sc; int col;
                        if (pn < 2) { col = pn * 256 + c; dorope = (col & 63) < 16; dst = Q + (size_t)row * 512 + col; sc = 0.18033688011112042f;     }
                        else { col = (pn - 2) * 256 + c; const int j = col >> 7; dorope = ((col & 63) < 16) && (j == 2 || j == 4); dst = KV + (size_t)row * 768 + col; sc = 1.0f; }
                        if (dorope) { const int i0 = (col & 63) >> 1; const float* rp = rope + (size_t)pos * 16 + i0 * 2;
                            const f32x4 r0 = *(const f32x4*)rp; const f32x4 r1 = *(const f32x4*)(rp + 4);
                            rot2(v[0], v[1], r0[0], r0[1]); rot2(v[2], v[3], r0[2], r0[3]); rot2(v[4], v[5], r1[0], r1[1]); rot2(v[6], v[7], r1[2], r1[3]); }
#pragma unroll
                        for (int e = 0; e < 8; ++e) v[e] *= sc;
                        st_bf16x8(dst, v);
                    } else if (pn < 7) { st_bf16x8(HQ + (size_t)row * 512 + (pn - 5) * 256 + c, v);
                    } else if (pn < 9) { const int cc = (pn - 7) * 256 + c; const f32x4 l0 = *(const f32x4*)(lb + cc), l1 = *(const f32x4*)(lb + cc + 4);
                        f32x4 o0, o1;
#pragma unroll
                        for (int e = 0; e < 4; ++e) { o0[e] = __logf(l0[e] + (1.0f - l0[e]) * sigm(v[e])); o1[e] = __logf(l1[e] + (1.0f - l1[e]) * sigm(v[4 + e])); }
                        float* d = HF + (size_t)row * 512 + cc; *(f32x4*)d = o0; *(f32x4*)(d + 4) = o1;
                    } else if (pn < 11) { st_bf16x8(HI + (size_t)row * 512 + (pn - 9) * 256 + c, v);
                    } else if (pn < 13) {
#pragma unroll
                        for (int e = 0; e < 8; ++e) v[e] = v[e] * sigm(v[e]);
                        st_bf16x8(HGs + (size_t)row * 512 + (pn - 11) * 256 + c, v);
                    } else if (pn < 21) {
#pragma unroll
                        for (int e = 0; e < 8; ++e) v[e] = sigm(v[e]);
                        st_bf16x8(MG + (size_t)row * 2048 + (pn - 13) * 256 + c, v);
                    } else { if (c < 24) { f32x4 o0, o1;
#pragma unroll
                            for (int e = 0; e < 4; ++e) { o0[e] = sigm(v[e]); o1[e] = sigm(v[4 + e]); }
                            float* d = GT + (size_t)row * 24 + c; *(f32x4*)d = o0; *(f32x4*)(d + 4) = o1; } }
                }
            }
    }
};

__device__ __forceinline__ void ld_bf16x8(const bf16_t* src, float (&v)[8]) { const u32x4 w = *(const u32x4*)src;
    v[0] = __builtin_bit_cast(float, w.x << 16); v[1] = __builtin_bit_cast(float, w.x & 0xffff0000u); v[2] = __builtin_bit_cast(float, w.y << 16); v[3] = __builtin_bit_cast(float, w.y & 0xffff0000u);
    v[4] = __builtin_bit_cast(float, w.z << 16); v[5] = __builtin_bit_cast(float, w.z & 0xffff0000u); v[6] = __builtin_bit_cast(float, w.w << 16); v[7] = __builtin_bit_cast(float, w.w & 0xffff0000u); }
struct MergeOrder {
    StaticOrder so;
    __device__ void init(int M, int N, int G, int c) { so.init(M, N, G, c); }
    __device__ bool next(int i, Unit& u) const { if (!so.next(i >> 1, u)) return false; u.sel = i & 1; return true; }
    __device__ __forceinline__ void a_ready(const Unit&) const {}
    __device__ __forceinline__ void done(const Unit&) const {}
};
struct EpiMerge {
    static constexpr bool PERM = true, AFTER_DRAIN = false;
    __device__ __forceinline__ bool keep(const Unit&) const { return false; }
    const bf16_t* MG; bf16_t* MIX;
    __device__ __forceinline__ void operator()(const f32x4 (&acc)[2][2][4][2], const Unit& u, int wr, int wc, int fr, int fq) const {
        int row0 = u.pm * BM + wr * 64 + fr; int col0 = u.pn * BM + wc * 32 + 8 * fq; asm volatile("" : "+v"(row0), "+v"(col0));
#pragma unroll
        for (int ai = 0; ai < 2; ++ai)
#pragma unroll
            for (int m = 0; m < 4; ++m) { const int row = row0 + ai * HALF + m * 16;
#pragma unroll
                for (int bj = 0; bj < 2; ++bj) { const int col = col0 + bj * HALF;
                    float g[8], v[8]; ld_bf16x8(MG + (size_t)row * 2048 + (u.sel ? 1024 : 0) + col, g);
#pragma unroll
                    for (int e = 0; e < 4; ++e) { v[e] = acc[ai][bj][m][0][e] * g[e]; v[4 + e] = acc[ai][bj][m][1][e] * g[4 + e]; }
                    bf16_t* dst = MIX + (size_t)row * 1024 + col;
                    if (u.sel) { float o[8]; ld_bf16x8(dst, o);
#pragma unroll
                        for (int e = 0; e < 8; ++e) v[e] += o[e]; }
                    st_bf16x8(dst, v); } }
    }
};
struct EpiOut {
    static constexpr bool PERM = false, AFTER_DRAIN = false;
    __device__ __forceinline__ bool keep(const Unit&) const { return false; }
    const float* X; float* O;
    __device__ __forceinline__ void operator()(const f32x4 (&acc)[2][2][4][2], const Unit& u, int wr, int wc, int fr, int fq) const {
        int row0 = u.pm * BM + wr * 64 + fr; int col0 = u.pn * BM + wc * 32 + 4 * fq; asm volatile("" : "+v"(row0), "+v"(col0));
#pragma unroll
        for (int ai = 0; ai < 2; ++ai)
#pragma unroll
            for (int m = 0; m < 4; ++m) { const size_t ro = (size_t)(row0 + ai * HALF + m * 16) * 1024 + col0;
#pragma unroll
                for (int bj = 0; bj < 2; ++bj)
#pragma unroll
                    for (int n = 0; n < 2; ++n) { const size_t o = ro + bj * HALF + n * 16; *(f32x4*)(O + o) = *(const f32x4*)(X + o) + acc[ai][bj][m][n]; } }
    }
};
struct MoeOrder {
    const volatile PG8_LAS int* tp;
    int G, c;
    __device__ bool next(int i, Unit& u) const {
        const int L = i * G + c; const int ntile = __builtin_amdgcn_readfirstlane(tp[32]);
        if (L >= 4 * ntile) return false;
        const int rt = L >> 2, nt = L & 3; int e = 0;
        for (int q = 1; q < 32; ++q) e += (__builtin_amdgcn_readfirstlane(tp[q]) <= rt) ? 1 : 0;
        u.pm = rt; u.pn = e * 4 + nt; u.sel = 0; return true;
    }
    __device__ __forceinline__ void a_ready(const Unit&) const {}
    __device__ __forceinline__ void done(const Unit&) const {}
};
struct EpiGU {
    static constexpr bool PERM = true, AFTER_DRAIN = false;
    __device__ __forceinline__ bool keep(const Unit&) const { return false; }
    const float* RS; bf16_t* HID;
    __device__ __forceinline__ void operator()(const f32x4 (&acc)[2][2][4][2], const Unit& u, int wr, int wc, int fr, int fq) const {
        int row0 = u.pm * BM + wr * 64 + fr; int col0 = (u.pn & 3) * 128 + wc * 32 + 8 * fq; asm volatile("" : "+v"(row0), "+v"(col0));
#pragma unroll
        for (int ai = 0; ai < 2; ++ai)
#pragma unroll
            for (int m = 0; m < 4; ++m) { const int row = row0 + ai * HALF + m * 16; const float r = RS[row]; float v[8];
#pragma unroll
                for (int e = 0; e < 4; ++e) { const float g0 = acc[ai][0][m][0][e] * r, g1 = acc[ai][0][m][1][e] * r; v[e] = g0 * sigm(g0) * (acc[ai][1][m][0][e] * r); v[4 + e] = g1 * sigm(g1) * (acc[ai][1][m][1][e] * r); }
                st_bf16x8(HID + (size_t)row * 512 + col0, v); }
    }
};
struct EpiDown {
    static constexpr bool PERM = true, AFTER_DRAIN = false;
    __device__ __forceinline__ bool keep(const Unit&) const { return false; }
    bf16_t* Y;
    __device__ __forceinline__ void operator()(const f32x4 (&acc)[2][2][4][2], const Unit& u, int wr, int wc, int fr, int fq) const {
        int row0 = u.pm * BM + wr * 64 + fr; int col0 = (u.pn & 3) * BM + wc * 32 + 8 * fq; asm volatile("" : "+v"(row0), "+v"(col0));
#pragma unroll
        for (int ai = 0; ai < 2; ++ai)
#pragma unroll
            for (int m = 0; m < 4; ++m) { const int row = row0 + ai * HALF + m * 16;
#pragma unroll
                for (int bj = 0; bj < 2; ++bj) { float v[8];
#pragma unroll
                    for (int e = 0; e < 4; ++e) { v[e] = acc[ai][bj][m][0][e]; v[4 + e] = acc[ai][bj][m][1][e]; }
                    st_bf16x8(Y + (size_t)row * 1024 + col0 + bj * HALF, v); } }
    }
};

template <class Epi, class Sched, bool ALIGN_EPI = false, bool SP2 = false>
__device__ __forceinline__ void gemm_phase(PG8_LAS unsigned char* lds, const Gemm g, const Sched& S, const Epi& E) {
    int tid_ = threadIdx.x; asm volatile("" : "+v"(tid_));
    const int tid = tid_, wid = __builtin_amdgcn_readfirstlane(tid >> 6), lane = tid & 63, wr = wid >> 2, wc = wid & 3, fr = lane & 15, fq = lane >> 4;
    const int K = g.K, nt = K / BK;
    unsigned voffA[2], voffB[2];
#pragma unroll
    for (int i = 0; i < 2; ++i) { int R, C; stage_rc(tid * 16 + i * 8192, R, C); const int Rb = Epi::PERM ? ((R & ~31) + perm32(R & 31)) : R;
        voffA[i] = (unsigned)(R * K + C) * 2u; voffB[i] = (unsigned)(Rb * K + C) * 2u; }
    const size_t kstep = (size_t)(BK * 2);
    const size_t hstep = (size_t)HALF * K * 2;
    const size_t tstep = 2 * hstep;
    const unsigned ldsw = (unsigned)wid * 1024u;
    const int aoff = lds_byte(wr * 64 + fr, fq * 8), boff = lds_byte(wc * 32 + fr, fq * 8);
#define PG8_SA(b, h) (((b) * 2 + (h)) * HTB)
#define PG8_SB(b, h) ((4 + (b) * 2 + (h)) * HTB)
#define PG8_STAGE(bufoff, gbase, voff) do { _Pragma("unroll") for (int _i = 0; _i < 2; ++_i) \
        __builtin_amdgcn_global_load_lds((const unsigned*)((const char*)(gbase) + (voff)[_i]), (PG8_LAS unsigned*)(lds + (bufoff) + ldsw + _i * 8192), 16, 0, 0); } while (0)
#define PG8_LDA(dst, b, h) do { _Pragma("unroll") for (int m = 0; m < 4; ++m) _Pragma("unroll") for (int k = 0; k < 2; ++k) dst[m][k] = *(const PG8_LAS bf16x8*)(lds + PG8_SA(b, h) + aoff + m * 2048 + k * 1024); } while (0)
#define PG8_LDB(dst, b, h) do { _Pragma("unroll") for (int n = 0; n < 2; ++n) _Pragma("unroll") for (int k = 0; k < 2; ++k) dst[n][k] = *(const PG8_LAS bf16x8*)(lds + PG8_SB(b, h) + boff + n * 2048 + k * 1024); } while (0)
#define PG8_MMA(ai, bj, At, Bt) do { __builtin_amdgcn_s_setprio(1); _Pragma("unroll") for (int m = 0; m < 4; ++m) _Pragma("unroll") for (int n = 0; n < 2; ++n) _Pragma("unroll") for (int k = 0; k < 2; ++k) \
        acc[ai][bj][m][n] = __builtin_amdgcn_mfma_f32_16x16x32_bf16(Bt[n][k], At[m][k], acc[ai][bj][m][n], 0, 0, 0); __builtin_amdgcn_s_setprio(0); } while (0)
#define PG8_WAIT_V(n) asm volatile("s_waitcnt vmcnt(" #n ")" ::: "memory")
#define PG8_WAIT_L(n) asm volatile("s_waitcnt lgkmcnt(" #n ")" ::: "memory")
#define PG8_BAR __builtin_amdgcn_s_barrier()
#define PG8_SCHED __builtin_amdgcn_sched_barrier(0)
    Unit cur, nxt; int ui = 0;
    if (!S.next(0, cur)) return;
    f32x4 acc[2][2][4][2];
#pragma unroll
    for (int a = 0; a < 2; ++a)
#pragma unroll
        for (int b = 0; b < 2; ++b)
#pragma unroll
            for (int m = 0; m < 4; ++m)
#pragma unroll
                for (int n = 0; n < 2; ++n) acc[a][b][m][n] = (f32x4){0.f, 0.f, 0.f, 0.f};
    bf16x8 At[4][2], B0[2][2], B1[2][2];
    const char* cA = (const char*)(cur.sel ? g.A2 : g.A) + (size_t)cur.pm * tstep; const char* cB = (const char*)(cur.sel ? g.Bt2 : g.Bt) + (size_t)cur.pn * tstep;
    S.a_ready(cur);
    if constexpr (SP2) {
        PG8_STAGE(PG8_SB(0, 0), cB, voffB); PG8_STAGE(PG8_SB(0, 1), cB + hstep, voffB); PG8_STAGE(PG8_SA(0, 0), cA, voffA); PG8_STAGE(PG8_SA(0, 1), cA + hstep, voffA);
        if (wr == 1) PG8_BAR;
        PG8_WAIT_V(2); PG8_BAR;
        PG8_STAGE(PG8_SB(1, 0), cB + kstep, voffB); PG8_STAGE(PG8_SA(1, 0), cA + kstep, voffA); PG8_STAGE(PG8_SB(1, 1), cB + hstep + kstep, voffB);
        PG8_WAIT_V(6); PG8_BAR;
    } else {
        PG8_STAGE(PG8_SB(0, 0), cB, voffB); PG8_STAGE(PG8_SA(0, 0), cA, voffA); PG8_STAGE(PG8_SB(0, 1), cB + hstep, voffB); PG8_STAGE(PG8_SA(0, 1), cA + hstep, voffA);
        if (wr == 1) PG8_BAR;
        PG8_WAIT_V(4); PG8_BAR;
        PG8_STAGE(PG8_SB(1, 0), cB + kstep, voffB); PG8_STAGE(PG8_SA(1, 0), cA + kstep, voffA); PG8_STAGE(PG8_SB(1, 1), cB + hstep + kstep, voffB);
        PG8_WAIT_V(6); PG8_BAR;
    }
    for (;;) {
        const bool has_next = S.next(ui + 1, nxt);
        const char* nA = has_next ? (const char*)(nxt.sel ? g.A2 : g.A) + (size_t)nxt.pm * tstep : cA; const char* nB = has_next ? (const char*)(nxt.sel ? g.Bt2 : g.Bt) + (size_t)nxt.pn * tstep : cB;
        for (int t = 0; t < nt; t += 2) {
            const bool last = (t == nt - 2);
            const char* a1 = cA + (size_t)(t + 1) * kstep;
            const char* a2 = last ? nA : cA + (size_t)(t + 2) * kstep; const char* b2 = last ? nB : cB + (size_t)(t + 2) * kstep;
            const char* a3 = a2 + kstep; const char* b3 = b2 + kstep;
            if (last && has_next) S.a_ready(nxt);
            if constexpr (SP2) {
            PG8_LDB(B0, 0, 0); PG8_LDB(B1, 0, 1); PG8_SCHED; PG8_LDA(At, 0, 0); PG8_STAGE(PG8_SA(1, 1), a1 + hstep, voffA);
            PG8_WAIT_V(8); PG8_WAIT_L(0); PG8_BAR; PG8_MMA(0, 0, At, B0); PG8_MMA(0, 1, At, B1); PG8_BAR; PG8_SCHED;
            PG8_LDA(At, 0, 1); PG8_STAGE(PG8_SB(0, 0), b2, voffB); PG8_STAGE(PG8_SB(0, 1), b2 + hstep, voffB); PG8_STAGE(PG8_SA(0, 0), a2, voffA);
            PG8_WAIT_V(8); PG8_WAIT_L(0); PG8_BAR; PG8_MMA(1, 0, At, B0); PG8_MMA(1, 1, At, B1); PG8_BAR; PG8_SCHED;
            PG8_LDB(B0, 1, 0); PG8_LDB(B1, 1, 1); PG8_SCHED; PG8_LDA(At, 1, 0); PG8_STAGE(PG8_SA(0, 1), a2 + hstep, voffA);
            PG8_WAIT_V(8); PG8_WAIT_L(0); PG8_BAR; PG8_MMA(0, 0, At, B0); PG8_MMA(0, 1, At, B1); PG8_BAR; PG8_SCHED;
            PG8_LDA(At, 1, 1); PG8_STAGE(PG8_SB(1, 0), b3, voffB); PG8_STAGE(PG8_SB(1, 1), b3 + hstep, voffB); PG8_STAGE(PG8_SA(1, 0), a3, voffA);
            PG8_WAIT_V(8); PG8_WAIT_L(0); PG8_BAR; PG8_MMA(1, 0, At, B0); PG8_MMA(1, 1, At, B1); PG8_BAR; PG8_SCHED;
            } else {
            PG8_LDB(B0, 0, 0); PG8_SCHED; PG8_LDA(At, 0, 0); PG8_STAGE(PG8_SA(1, 1), a1 + hstep, voffA);
            PG8_WAIT_L(8); PG8_BAR; PG8_WAIT_L(0); PG8_MMA(0, 0, At, B0); PG8_BAR; PG8_SCHED;
            PG8_LDB(B1, 0, 1); PG8_STAGE(PG8_SB(0, 0), b2, voffB);
            PG8_BAR; PG8_WAIT_L(0); PG8_MMA(0, 1, At, B1); PG8_BAR;
            PG8_LDA(At, 0, 1); PG8_STAGE(PG8_SA(0, 0), a2, voffA);
            PG8_BAR; PG8_WAIT_L(0); PG8_MMA(1, 0, At, B0); PG8_BAR; PG8_SCHED;
            PG8_STAGE(PG8_SB(0, 1), b2 + hstep, voffB);
            PG8_WAIT_V(6); PG8_BAR; PG8_MMA(1, 1, At, B1); PG8_BAR;
            PG8_LDB(B0, 1, 0); PG8_SCHED; PG8_LDA(At, 1, 0); PG8_STAGE(PG8_SA(0, 1), a2 + hstep, voffA);
            PG8_WAIT_L(8); PG8_BAR; PG8_WAIT_L(0); PG8_MMA(0, 0, At, B0); PG8_BAR; PG8_SCHED;
            PG8_LDB(B1, 1, 1); PG8_STAGE(PG8_SB(1, 0), b3, voffB);
            PG8_BAR; PG8_WAIT_L(0); PG8_MMA(0, 1, At, B1); PG8_BAR;
            PG8_LDA(At, 1, 1); PG8_STAGE(PG8_SA(1, 0), a3, voffA);
            PG8_BAR; PG8_WAIT_L(0); PG8_MMA(1, 0, At, B0); PG8_BAR; PG8_SCHED;
            PG8_STAGE(PG8_SB(1, 1), b3 + hstep, voffB);
            PG8_WAIT_V(6); PG8_BAR; PG8_MMA(1, 1, At, B1); PG8_BAR;
            }
        }
        if constexpr (ALIGN_EPI) { if (wr == 0) PG8_BAR; }
        if constexpr (!Epi::AFTER_DRAIN) { E(acc, cur, wr, wc, fr, fq); S.done(cur); }
        if (!has_next) break;
        if (!E.keep(cur)) {
#pragma unroll
        for (int a = 0; a < 2; ++a)
#pragma unroll
            for (int b = 0; b < 2; ++b)
#pragma unroll
                for (int m = 0; m < 4; ++m)
#pragma unroll
                    for (int n = 0; n < 2; ++n) acc[a][b][m][n] = (f32x4){0.f, 0.f, 0.f, 0.f};
        }
        cur = nxt; cA = nA; cB = nB; ++ui;
        if constexpr (ALIGN_EPI) { if (wr == 1) PG8_BAR; }
    }
    PG8_WAIT_V(0);
    if constexpr (!ALIGN_EPI) { if (wr == 0) PG8_BAR; }
    PG8_BAR;
    if constexpr (Epi::AFTER_DRAIN) { E.fused(acc, cur, wr, wc, fr, fq, lds, wid, lane); S.done(cur); }
#undef PG8_SA
#undef PG8_SB
#undef PG8_STAGE
#undef PG8_LDA
#undef PG8_LDB
#undef PG8_MMA
#undef PG8_WAIT_V
#undef PG8_WAIT_L
#undef PG8_BAR
#undef PG8_SCHED
}
}

#define GAS __attribute__((address_space(1)))
#define LAS __attribute__((address_space(3)))
typedef unsigned short bf16;
typedef unsigned v4u __attribute__((ext_vector_type(4)));
typedef float f32x4 __attribute__((ext_vector_type(4)));
typedef short bf16x8 __attribute__((ext_vector_type(8)));
typedef GAS unsigned gu32;
typedef GAS unsigned long long gu64;
#define RLX_AGENT __ATOMIC_RELAXED, __HIP_MEMORY_SCOPE_AGENT
#define LDS_WAIT() asm volatile("s_waitcnt lgkmcnt(0)" ::: "memory")
#define VM_WAIT() asm volatile("s_waitcnt vmcnt(0)" ::: "memory")
__device__ __forceinline__ unsigned long long rt() { return __builtin_amdgcn_s_memrealtime(); }
typedef float f32x2_hw __attribute__((ext_vector_type(2))); typedef __bf16 bf16x2_hw __attribute__((ext_vector_type(2)));
__device__ __forceinline__ unsigned pk2(float lo, float hi) { const f32x2_hw v = {lo, hi}; return __builtin_bit_cast(unsigned, __builtin_convertvector(v, bf16x2_hw)); }
__device__ __forceinline__ unsigned f2bf(float f) { return pk2(f, 0.0f) & 0xffffu; }

#define XB_TMO      128
#define XB_XCNT(j)  (256  + 64 * (j))
#define XB_XSUB(j)  (1280 + 64 * (j))
#define XB_XGEN(j)  (2304 + 64 * (j))
#define XB_TOP      3328
#define XB_TOPGEN   3392
#define XCD_BAR_WORDS 3456
#define XB_SPIN_CAP (1u << 18)

__device__ __forceinline__ unsigned xb_ld(unsigned* p)              { return __hip_atomic_load(p, __ATOMIC_RELAXED, __HIP_MEMORY_SCOPE_AGENT); }
__device__ __forceinline__ unsigned xb_add(unsigned* p, unsigned v) { return __hip_atomic_fetch_add(p, v, __ATOMIC_RELAXED, __HIP_MEMORY_SCOPE_AGENT); }
__device__ __forceinline__ unsigned xb_xcc_id() { return (unsigned)__builtin_amdgcn_s_getreg((3 << 11) | 20) & 0xFu; }
#define XB_SPIN(cond, bar) do { unsigned _sp = 0; while (cond) { __builtin_amdgcn_s_sleep(1); \
    if ((++_sp & 255u) == 0u) { if (xb_ld(&(bar)[XB_TMO])) break; if (_sp > XB_SPIN_CAP) { atomicAdd(&(bar)[XB_TMO], 1u); break; } } } } while (0)

struct XcdBarrier {
    unsigned* bar; unsigned x;
    volatile LAS unsigned* st;
};

__device__ __forceinline__ XcdBarrier xcd_barrier_post(unsigned* bar, volatile LAS unsigned* st) {
    XcdBarrier b; b.bar = bar; b.x = xb_xcc_id(); b.st = st;
    if (threadIdx.x == 0) (void)xb_add(&bar[XB_XCNT(b.x)], 1u);
    return b;
}
__device__ __forceinline__ void xcd_barrier_complete(unsigned* bar, unsigned x, unsigned& nloc, unsigned& nx) {
    const unsigned G = gridDim.x * gridDim.y * gridDim.z;
    unsigned sum, cnt, mine, sp = 0u;
    for (;;) {
        sum = 0u; cnt = 0u; mine = 0u;
#pragma unroll
        for (unsigned j = 0; j < 16; ++j) { const unsigned c = xb_ld(&bar[XB_XCNT(j)]); sum += c; cnt += (c > 0u) ? 1u : 0u; mine = (j == x) ? c : mine; }
        if (sum == G) break;
        __builtin_amdgcn_s_sleep(1);
        if ((++sp & 255u) == 0u) { if (xb_ld(&bar[XB_TMO])) break; if (sp > XB_SPIN_CAP) { atomicAdd(&bar[XB_TMO], 1u); break; } }
    }
    nloc = mine > 0u ? mine : 1u; nx = cnt > 0u ? cnt : 1u;
}

__device__ __forceinline__ void xcd_barrier(const XcdBarrier& b) {
    asm volatile("s_waitcnt vmcnt(0)" ::: "memory");
    __syncthreads();
    if (threadIdx.x == 0) {
        unsigned* bar = b.bar;
        __builtin_amdgcn_s_waitcnt(0);
        unsigned nloc = b.st[0], nx = b.st[1];
        if (nloc == 0u) { xcd_barrier_complete(bar, b.x, nloc, nx); b.st[0] = nloc; b.st[1] = nx; }
        const unsigned old = xb_add(&bar[XB_XSUB(b.x)], 1u);
        const unsigned gen = old / nloc;
        if (old + 1u == (gen + 1u) * nloc) {
            __builtin_amdgcn_fence(__ATOMIC_RELEASE, "agent");
            asm volatile("s_waitcnt vmcnt(0)" ::: "memory");
            const unsigned og = xb_add(&bar[XB_TOP], 1u);
            const unsigned tg = og / nx;
            if (og + 1u == (tg + 1u) * nx) xb_add(&bar[XB_TOPGEN], 1u);
            else XB_SPIN(xb_ld(&bar[XB_TOPGEN]) == tg, bar);
            __builtin_amdgcn_fence(__ATOMIC_ACQUIRE, "agent");
            xb_add(&bar[XB_XGEN(b.x)], 1u);
            asm volatile("s_waitcnt vmcnt(0)" ::: "memory");
        } else {
            XB_SPIN(xb_ld(&bar[XB_XGEN(b.x)]) == gen, bar);
            __builtin_amdgcn_fence(__ATOMIC_ACQUIRE, "agent");
            asm volatile("s_waitcnt vmcnt(0)" ::: "memory");
        }
    }
    __syncthreads();
}
constexpr int NWAVES = 8;
constexpr int DM = 1024, NB = 2, SEQ = 8192, TOK = NB * SEQ;
constexpr int NC_IN = 5400, NPROJ = 5632;
constexpr int NCMP = 511, NSEL = 128, TOPN = 16, NE = 32, FF = 512;
constexpr size_t MiB = 1u << 20;
constexpr size_t WS_CTL = 0, CTL_ZERO_BYTES = 1 * MiB;
constexpr size_t WS_SMALL = 1 * MiB;
constexpr size_t WS_WIN = 2 * MiB;
constexpr size_t WS_WBRN = 13 * MiB, WS_WBRH = 14 * MiB, WS_WOUT = 15 * MiB, WS_WCMP = 17 * MiB;
constexpr size_t WS_WGU = 18 * MiB, WS_WD = 82 * MiB;
constexpr size_t WS_XN = 114 * MiB;
constexpr size_t WS_Q = 146 * MiB, WS_KV = 162 * MiB, WS_HQ = 186 * MiB, WS_HF = 202 * MiB, WS_HI = 234 * MiB, WS_HGS = 250 * MiB, WS_GT = 266 * MiB;
constexpr size_t WS_MISC = 276 * MiB;
constexpr size_t WS_END = 284 * MiB;
constexpr size_t WS_ONSA = 82 * MiB, WS_OHG = 50 * MiB;
constexpr size_t WS_ONSAB = 130 * MiB, WS_OHGB = 114 * MiB, WS_MIX = 218 * MiB;
constexpr int R_PAD = 40960;
constexpr size_t WS_H2S = 146 * MiB, WS_HID = 226 * MiB, WS_YB = 146 * MiB;
constexpr size_t OFF_WRH = 640 * 1024, OFF_WRL = 768 * 1024;
constexpr size_t M_EID = 4 * MiB, M_EW = 4 * MiB + 256 * 1024, M_SLOT = 4 * MiB + 512 * 1024, M_POS = 4 * MiB + 768 * 1024, M_RINV = 5 * MiB, M_RS = 5 * MiB + 256 * 1024;
constexpr size_t WS_ST = 18 * MiB, WS_DEC = 17 * MiB + 512 * 1024;
constexpr int CW_DBG = 20480;
#ifndef TS_A
#define TS_A 0
#define TS_B 1
#endif
#ifndef DUP_PHASE
#define DUP_PHASE 0
#endif
#define REP(k) for (int rep_ = 0; rep_ < (DUP_PHASE == (k) ? 2 : 1); ++rep_)
#ifndef DBG_MODE
#define DBG_MODE 0
#endif
constexpr int MISC_TP = 16;
constexpr int CW_BAR = 4096;
constexpr int CW_CNT = 16384;
constexpr int SCR_BYTES = 143360;
constexpr int MISC_OFF = SCR_BYTES;
constexpr int LDS_BYTES = 147456;

__device__ __forceinline__ float wave_sum(float v) {
#pragma unroll
    for (int o = 1; o < 64; o <<= 1) v += __shfl_xor(v, o);
    return v;
}
__device__ __forceinline__ float wave_max(float v) {
#pragma unroll
    for (int o = 1; o < 64; o <<= 1) v = fmaxf(v, __shfl_xor(v, o));
    return v;
}
__device__ __forceinline__ float bf2f(bf16 b) { return __builtin_bit_cast(float, (unsigned)b << 16); }
__device__ __forceinline__ float sigmoidf_(float x) { return 1.0f / (1.0f + expf(-x)); }
__device__ __forceinline__ int perm_d(int dp) { return dp < 16 ? ((dp >> 1) + 8 * (dp & 1)) : dp; }
#define WAVE_LDS_FENCE() asm volatile("s_waitcnt lgkmcnt(0)" ::: "memory")

struct Params {
    const float *x, *attn_norm, *w_in, *w_cmp_k, *w_cmp_v, *cmp_pos, *hg_lb, *hg_norm, *w_br_nsa, *w_br_hg, *w_out, *ffn_norm, *w_grp, *b_grp, *w_rtr, *b_rtr, *w_gate, *w_up, *w_down, *final_norm;
    float* out; unsigned char* ws;
};

template <class F> __device__ __forceinline__ void tr_item(F srcf, int K, bf16* WT, int n0, int k0, float* scr, int lane) {
#pragma unroll 8
    for (int i = 0; i < 32; ++i) { const int kk = 2 * i + (lane >> 5); scr[kk * 33 + (lane & 31)] = srcf(k0 + kk, n0 + (lane & 31)); }
    WAVE_LDS_FENCE();
    const int c = lane & 7;
#pragma unroll
    for (int j = 0; j < 4; ++j) { const int n = (lane >> 3) + 8 * j; const float* s = scr + (8 * c) * 33 + n;
        v4u o; o.x = pk2(s[0 * 33], s[1 * 33]); o.y = pk2(s[2 * 33], s[3 * 33]); o.z = pk2(s[4 * 33], s[5 * 33]); o.w = pk2(s[6 * 33], s[7 * 33]);
        *(v4u*)(WT + (size_t)(n0 + n) * K + k0 + 8 * c) = o; }
    WAVE_LDS_FENCE();
}
__device__ __forceinline__ int win_src_col(int n) {
    if (n < 512) return (n & ~63) + perm_d(n & 63);
    if (n < 1280) { const int j = (n - 512) >> 7; const int d = n & 63; return (n & ~63) + ((j == 2 || j == 4) ? perm_d(d) : d); }
    if (n < 5376) return n + 24;
    if (n < 5400) return 1280 + (n - 5376);
    return -1;
}
__device__ __forceinline__ void p0_prologue(const Params& p, unsigned char* lds, int wave, int lane, int gw, int NGW, int gtid, int NGT) {
    float* scr = (float*)(lds + wave * 8448);
    bf16* Win_t = (bf16*)(p.ws + WS_WIN); bf16* Wbrn_t = (bf16*)(p.ws + WS_WBRN); bf16* Wbrh_t = (bf16*)(p.ws + WS_WBRH); bf16* Wout_t = (bf16*)(p.ws + WS_WOUT); bf16* Wcmp_t = (bf16*)(p.ws + WS_WCMP);
    constexpr int I_IN = 16 * (NPROJ / 32), I_BR = 8 * 32, I_OUT = 16 * 32, I_CMP = 32 * 4;
    constexpr int NITEMS = I_IN + 2 * I_BR + I_OUT + I_CMP;
    for (int it = gw; it < NITEMS; it += NGW) {
        int r = it;
        if (r < I_IN) { const int nblk = NPROJ / 32, kb = r / nblk, nb = r % nblk; const float* W = p.w_in;
            tr_item([W](int k, int n) { const int c = win_src_col(n); return c >= 0 ? W[(size_t)k * NC_IN + c] : 0.0f; }, DM, Win_t, 32 * nb, 64 * kb, scr, lane); continue; }
        r -= I_IN;
        if (r < I_BR) { const int kb = r / 32, nb = r % 32; const float* W = p.w_br_nsa; tr_item([W](int k, int n) { return W[(size_t)k * DM + n]; }, 512, Wbrn_t, 32 * nb, 64 * kb, scr, lane); continue; }
        r -= I_BR;
        if (r < I_BR) { const int kb = r / 32, nb = r % 32; const float* W = p.w_br_hg; tr_item([W](int k, int n) { return W[(size_t)k * DM + n]; }, 512, Wbrh_t, 32 * nb, 64 * kb, scr, lane); continue; }
        r -= I_BR;
        if (r < I_OUT) { const int kb = r / 32, nb = r % 32; const float* W = p.w_out; tr_item([W](int k, int n) { return W[(size_t)k * DM + n]; }, DM, Wout_t, 32 * nb, 64 * kb, scr, lane); continue; }
        r -= I_OUT;
        { const int kb = r / 4, nb = r % 4; const float* Wk = p.w_cmp_k; const float* Wv = p.w_cmp_v;
          tr_item([Wk, Wv](int k, int n) { return n < 64 ? Wk[(size_t)k * 64 + perm_d(n)] : Wv[(size_t)k * 64 + (n - 64)]; }, 2048, Wcmp_t, 32 * nb, 64 * kb, scr, lane); }
    }
    { bf16* Wh = (bf16*)(p.ws + WS_SMALL + OFF_WRH); bf16* Wl = (bf16*)(p.ws + WS_SMALL + OFF_WRL);
      for (int i = gtid; i < 48 * 1024; i += NGT) { const int c = i >> 10, k = i & 1023; const float w = c < 4 ? p.w_grp[k * 4 + c] : (c < 36 ? p.w_rtr[k * 32 + (c - 4)] : 0.0f);
          const unsigned hi = f2bf(w); Wh[i] = (bf16)hi; Wl[i] = (bf16)f2bf(w - __builtin_bit_cast(float, hi << 16)); } }
    { float* cbv = (float*)(p.ws + WS_SMALL + 4096);
      for (int c = gw; c < 128; c += NGW) { const float* W = c < 64 ? p.w_cmp_k : p.w_cmp_v; const int col = c < 64 ? perm_d(c) : c - 64; float a = 0.f;
          for (int ld = lane; ld < 2048; ld += 64) a = fmaf(p.cmp_pos[ld], W[(size_t)ld * 64 + col], a);
          a = wave_sum(a); if (lane == 0) cbv[c] = a; } }
    float* lbv = (float*)(p.ws + WS_SMALL); float* rope = (float*)(p.ws + WS_SMALL + 65536);
    for (int i = gtid; i < SEQ * 8; i += NGT) { const int pos = i >> 3, f = i & 7; const float inv = powf(500000.0f, -(float)f / 8.0f); const float ang = (float)pos * inv; float sn, cs; sincosf(ang, &sn, &cs); rope[2 * i] = cs; rope[2 * i + 1] = sn; }
    if (gtid < 512) { const float l0 = p.hg_lb[gtid], l1 = p.hg_lb[512 + gtid]; const float m = fmaxf(l0, l1); const float e0 = expf(l0 - m), e1 = expf(l1 - m); lbv[gtid] = e0 / (e0 + e1); }
    bf16* XN = (bf16*)(p.ws + WS_XN);
    for (int m = gw; m < TOK; m += NGW) {
        const f32x4* xr = (const f32x4*)(p.x + (size_t)m * DM) + lane; const f32x4* gr = (const f32x4*)p.attn_norm + lane;
        f32x4 v[4]; float s = 0.f;
#pragma unroll
        for (int j = 0; j < 4; ++j) { v[j] = xr[64 * j]; s += (v[j].x * v[j].x + v[j].y * v[j].y) + (v[j].z * v[j].z + v[j].w * v[j].w); }
        const float r = 1.0f / sqrtf(wave_sum(s) * (1.0f / DM) + 1e-6f);
        unsigned long long* o8 = (unsigned long long*)(XN + (size_t)m * DM) + lane;
#pragma unroll
        for (int j = 0; j < 4; ++j) { const f32x4 g = gr[64 * j]; o8[64 * j] = (unsigned long long)pk2(v[j].x * r * g.x, v[j].y * r * g.y) | ((unsigned long long)pk2(v[j].z * r * g.z, v[j].w * r * g.w) << 32); }
    }
}

__device__ __forceinline__ void s_compress(const Params& p, int lane, int gw, int NGW) {
    const bf16* KV = (const bf16*)(p.ws + WS_KV); const float* rope = (const float*)(p.ws + WS_SMALL + 65536);
    float* kc = (float*)(p.ws + WS_MISC + 2 * MiB); float* vc = (float*)(p.ws + WS_MISC + 3 * MiB);
    for (int it = gw; it < NB * NCMP * 4; it += NGW) {
        const int j = it & 1, g = (it >> 1) & 1, bn = it >> 2, b = bn / NCMP, n = bn % NCMP;
        const float* W = j == 0 ? p.w_cmp_k : p.w_cmp_v; const int sc = j == 0 ? perm_d(lane) : lane;
        float acc = 0.f;
        for (int l = 0; l < 32; ++l) {
            const bf16* src = KV + (size_t)(b * SEQ + 16 * n + l) * 768 + j * 128 + g * 64;
            for (int d = 0; d < 64; ++d) acc = fmaf(bf2f(src[d]) + p.cmp_pos[l * 64 + d], W[(size_t)(l * 64 + d) * 64 + sc], acc);
        }
        if (j == 0) { const float other = __shfl_xor(acc, 1);
            if (lane < 16) { const int i = lane >> 1; const float cs = rope[(size_t)(16 * n) * 16 + 2 * i], sn = rope[(size_t)(16 * n) * 16 + 2 * i + 1];
                acc = (lane & 1) ? (acc * cs + other * sn) : (acc * cs - other * sn); }
            kc[((size_t)(b * NCMP + n) * 2 + g) * 64 + lane] = acc;
        } else vc[((size_t)(b * NCMP + n) * 2 + g) * 64 + lane] = acc;
    }
}
__device__ __forceinline__ void s_cmp_attn(const Params& p, unsigned char* lds, int wave, int lane, int gw, int NGW) {
    float* wl = (float*)(lds + wave * 17472); float* qs = wl; float* pp = wl + 256; float* sc = pp + 4 * 512;
    const bf16* Q = (const bf16*)(p.ws + WS_Q); const float* GT = (const float*)(p.ws + WS_GT);
    const float* kc = (const float*)(p.ws + WS_MISC + 2 * MiB); const float* vc = (const float*)(p.ws + WS_MISC + 3 * MiB);
    float* onsa = (float*)(p.ws + WS_ONSA); int* selidx = (int*)(p.ws + WS_MISC);
    for (int it = gw; it < TOK * 2; it += NGW) {
        const int g = it & 1, m = it >> 1, b = m >> 13, s = m & 8191;
        WAVE_LDS_FENCE();
#pragma unroll
        for (int r = 0; r < 4; ++r) qs[r * 64 + lane] = bf2f(Q[(size_t)m * 512 + (g * 4 + r) * 64 + lane]);
        WAVE_LDS_FENCE();
        const int nvalid = s >= 31 ? (s - 31) / 16 + 1 : 0;
        float mx[4] = {-3.0e38f, -3.0e38f, -3.0e38f, -3.0e38f};
        for (int n = lane; n < nvalid; n += 64) {
            const float* kp = kc + ((size_t)(b * NCMP + n) * 2 + g) * 64;
            float d0 = 0.f, d1 = 0.f, d2 = 0.f, d3 = 0.f;
            for (int d = 0; d < 64; ++d) { const float kv = kp[d]; d0 = fmaf(qs[d], kv, d0); d1 = fmaf(qs[64 + d], kv, d1); d2 = fmaf(qs[128 + d], kv, d2); d3 = fmaf(qs[192 + d], kv, d3); }
            pp[n] = d0; pp[512 + n] = d1; pp[1024 + n] = d2; pp[1536 + n] = d3;
            mx[0] = fmaxf(mx[0], d0); mx[1] = fmaxf(mx[1], d1); mx[2] = fmaxf(mx[2], d2); mx[3] = fmaxf(mx[3], d3);
        }
        float sm[4];
#pragma unroll
        for (int r = 0; r < 4; ++r) { mx[r] = wave_max(mx[r]); float a = 0.f; for (int n = lane; n < nvalid; n += 64) { const float e = exp2f(pp[r * 512 + n] - mx[r]); pp[r * 512 + n] = e; a += e; } sm[r] = wave_sum(a); }
#pragma unroll
        for (int r = 0; r < 4; ++r) { const float inv = nvalid > 0 ? 1.0f / sm[r] : 0.f; for (int n = lane; n < nvalid; n += 64) pp[r * 512 + n] *= inv; }
        WAVE_LDS_FENCE();
        float o[4] = {0.f, 0.f, 0.f, 0.f};
        for (int n = 0; n < nvalid; ++n) { const float v = vc[((size_t)(b * NCMP + n) * 2 + g) * 64 + lane]; o[0] = fmaf(pp[n], v, o[0]); o[1] = fmaf(pp[512 + n], v, o[1]); o[2] = fmaf(pp[1024 + n], v, o[2]); o[3] = fmaf(pp[1536 + n], v, o[3]); }
#pragma unroll
        for (int r = 0; r < 4; ++r) { const int h = g * 4 + r; onsa[(size_t)m * 512 + h * 64 + lane] = GT[(size_t)m * 24 + h * 3 + 0] * o[r]; }
        const int jc = s >> 6;
        for (int j = lane; j < NSEL; j += 64) {
            float imp = 0.f;
            for (int n = 4 * j - 1; n <= 4 * j + 3; ++n) if (n >= 0 && n < nvalid) imp += (pp[n] + pp[512 + n]) + (pp[1024 + n] + pp[1536 + n]);
            float v; if (j == jc || j == 0) v = 1.0e4f; else if (64 * j <= s) v = imp; else v = -1.0f;
            sc[j] = v;
        }
        WAVE_LDS_FENCE();
        float v0 = sc[lane], v1 = sc[lane + 64];
        for (int k = 0; k < TOPN; ++k) {
            float bv; int bi;
            if (v0 >= v1) { bv = v0; bi = lane; } else { bv = v1; bi = lane + 64; }
#pragma unroll
            for (int o2 = 1; o2 < 64; o2 <<= 1) { const float ov = __shfl_xor(bv, o2); const int oi = __shfl_xor(bi, o2); if (ov > bv || (ov == bv && oi < bi)) { bv = ov; bi = oi; } }
            if (lane == 0) selidx[(size_t)it * TOPN + k] = bi;
            if (bi == lane) v0 = -3.0e38f; if (bi == lane + 64) v1 = -3.0e38f;
        }
    }
}
template <int MODE> __device__ __forceinline__ void s_sparse_attn(const Params& p, unsigned char* lds, int wave, int lane, int gw, int NGW) {
    float* wl = (float*)(lds + wave * 17472); float* qs = wl; float* pp = wl + 256; int* sel = (int*)(pp + 4 * 1024);
    const bf16* Q = (const bf16*)(p.ws + WS_Q); const bf16* KV = (const bf16*)(p.ws + WS_KV); const float* GT = (const float*)(p.ws + WS_GT);
    float* onsa = (float*)(p.ws + WS_ONSA); const int* selidx = (const int*)(p.ws + WS_MISC);
    constexpr int NCH = MODE == 0 ? 16 : 8; constexpr int KJ = MODE == 0 ? 2 : 4;
    for (int it = gw; it < TOK * 2; it += NGW) {
        const int g = it & 1, m = it >> 1, b = m >> 13, s = m & 8191;
        WAVE_LDS_FENCE();
#pragma unroll
        for (int r = 0; r < 4; ++r) qs[r * 64 + lane] = bf2f(Q[(size_t)m * 512 + (g * 4 + r) * 64 + lane]);
        if (MODE == 0 && lane < 16) sel[lane] = selidx[(size_t)it * TOPN + lane];
        WAVE_LDS_FENCE();
        float mx[4] = {-3.0e38f, -3.0e38f, -3.0e38f, -3.0e38f};
        for (int c = 0; c < NCH; ++c) {
            int kpos; bool valid;
            if (MODE == 0) { kpos = sel[c] * 64 + lane; valid = kpos <= s; } else { kpos = s - 511 + c * 64 + lane; valid = kpos >= 0; }
            const int idx = c * 64 + lane;
            if (valid) {
                const bf16* kp = KV + (size_t)(b * SEQ + kpos) * 768 + KJ * 128 + g * 64;
                float d0 = 0.f, d1 = 0.f, d2 = 0.f, d3 = 0.f;
                for (int d = 0; d < 64; ++d) { const float kv = bf2f(kp[d]); d0 = fmaf(qs[d], kv, d0); d1 = fmaf(qs[64 + d], kv, d1); d2 = fmaf(qs[128 + d], kv, d2); d3 = fmaf(qs[192 + d], kv, d3); }
                pp[idx] = d0; pp[1024 + idx] = d1; pp[2048 + idx] = d2; pp[3072 + idx] = d3;
                mx[0] = fmaxf(mx[0], d0); mx[1] = fmaxf(mx[1], d1); mx[2] = fmaxf(mx[2], d2); mx[3] = fmaxf(mx[3], d3);
            }
        }
        float sm[4];
#pragma unroll
        for (int r = 0; r < 4; ++r) { mx[r] = wave_max(mx[r]); float a = 0.f;
            for (int c = 0; c < NCH; ++c) { const int idx = c * 64 + lane; int kpos; bool valid;
                if (MODE == 0) { kpos = sel[c] * 64 + lane; valid = kpos <= s; } else { kpos = s - 511 + c * 64 + lane; valid = kpos >= 0; }
                float e = 0.f; if (valid) e = exp2f(pp[r * 1024 + idx] - mx[r]); pp[r * 1024 + idx] = e; a += e; }
            sm[r] = wave_sum(a); }
        WAVE_LDS_FENCE();
        float o[4] = {0.f, 0.f, 0.f, 0.f};
        for (int i = 0; i < NCH * 64; ++i) { int kpos; if (MODE == 0) kpos = sel[i >> 6] * 64 + (i & 63); else kpos = s - 511 + i;
            if (kpos < 0 || kpos > s) continue;
            const float v = bf2f(KV[(size_t)(b * SEQ + kpos) * 768 + (KJ + 1) * 128 + g * 64 + lane]);
            o[0] = fmaf(pp[i], v, o[0]); o[1] = fmaf(pp[1024 + i], v, o[1]); o[2] = fmaf(pp[2048 + i], v, o[2]); o[3] = fmaf(pp[3072 + i], v, o[3]); }
#pragma unroll
        for (int r = 0; r < 4; ++r) { const int h = g * 4 + r; const size_t oi = (size_t)m * 512 + h * 64 + lane; const float val = onsa[oi] + GT[(size_t)m * 24 + h * 3 + (MODE == 0 ? 1 : 2)] * o[r] / sm[r];
            if (MODE == 0) onsa[oi] = val; else ((bf16*)(p.ws + WS_ONSAB))[oi] = (bf16)f2bf(val); }
    }
}
__device__ __forceinline__ void s_hgrn(const Params& p, unsigned char* lds, int tid, int item) {
    float* qf = (float*)lds; float* ff = qf + 16 * 128; float* vv = ff + 16 * 128;
    const bf16* HQ = (const bf16*)(p.ws + WS_HQ); const float* HF = (const float*)(p.ws + WS_HF); const bf16* HI = (const bf16*)(p.ws + WS_HI); float* ohg = (float*)(p.ws + WS_OHG);
    const int b = item >> 2, hh = item & 3, j = tid >> 2, kq = tid & 3;
    float St[32];
#pragma unroll
    for (int i = 0; i < 32; ++i) St[i] = 0.f;
    for (int s0 = 0; s0 < SEQ; s0 += 16) {
        __syncthreads();
        for (int e = tid; e < 16 * 128; e += 512) { const int tt = e >> 7, k = e & 127; const size_t ro = (size_t)(b * SEQ + s0 + tt) * 512 + hh * 128 + k;
            qf[e] = bf2f(HQ[ro]); ff[e] = expf(HF[ro]); vv[e] = bf2f(HI[ro]); }
        __syncthreads();
        for (int tt = 0; tt < 16; ++tt) {
            const float v = vv[tt * 128 + j]; float o = 0.f;
#pragma unroll
            for (int i = 0; i < 32; ++i) { const int k = kq * 32 + i; const float f = ff[tt * 128 + k]; St[i] = fmaf(f, St[i], (1.0f - f) * v); o = fmaf(qf[tt * 128 + k], St[i], o); }
            o += __shfl_xor(o, 1); o += __shfl_xor(o, 2);
            if (kq == 0) ohg[(size_t)(b * SEQ + s0 + tt) * 512 + hh * 128 + j] = o;
        }
    }
    __syncthreads();
}
__device__ __forceinline__ void s_hg_post(const Params& p, int lane, int gw, int NGW) {
    float* ohg = (float*)(p.ws + WS_OHG); const bf16* HGs = (const bf16*)(p.ws + WS_HGS);
    for (int w = gw; w < TOK * 4; w += NGW) { const int m = w >> 2, hh = w & 3; float* o = ohg + (size_t)m * 512 + hh * 128;
        const float a = o[lane], b = o[lane + 64]; const float r = 1.0f / sqrtf(wave_sum(a * a + b * b) * (1.0f / 128.0f) + 1e-6f);
        const bf16* gr = HGs + (size_t)m * 512 + hh * 128;
        bf16* ob = (bf16*)(p.ws + WS_OHGB) + (size_t)m * 512 + hh * 128;
        ob[lane] = (bf16)f2bf(a * r * p.hg_norm[lane] * bf2f(gr[lane])); ob[lane + 64] = (bf16)f2bf(b * r * p.hg_norm[lane + 64] * bf2f(gr[lane + 64])); }
}
typedef short bf16x8_t __attribute__((ext_vector_type(8)));
typedef short v4i16_t __attribute__((ext_vector_type(4)));
__device__ __forceinline__ bf16x8_t tr_frag(const unsigned char* p0, const unsigned char* p1) {
    const v4i16_t lo = __builtin_amdgcn_ds_read_tr16_b64_v4i16((LAS v4i16_t*)p0), hi = __builtin_amdgcn_ds_read_tr16_b64_v4i16((LAS v4i16_t*)p1);
    return (bf16x8_t){lo[0], lo[1], lo[2], lo[3], hi[0], hi[1], hi[2], hi[3]};
}
constexpr int HG_BC = 0, HG_TOT = 33792;
constexpr int HG_V = 35840;
constexpr int HG_KMT = 53248;
constexpr int HG_QM = 53248, HG_QE = 70656, HG_KM = 88064, HG_AM = 105472, HG_RS = 114688;

__device__ __forceinline__ void hg_cumsum(const float* GK, unsigned char* lds, int tid) {
    float* bc = (float*)(lds + HG_BC); float* tot = (float*)(lds + HG_TOT);
    const int seg = tid >> 7, k = tid & 127; float loc[16];
#pragma unroll
    for (int i = 0; i < 16; ++i) loc[i] = GK[(size_t)(16 * seg + i) * 512 + k];
    float run = 0.f;
#pragma unroll
    for (int i = 0; i < 16; ++i) { run += loc[i]; loc[i] = run; }
    tot[seg * 128 + k] = run;
    __syncthreads();
    float add = 0.f;
    for (int s = 0; s < seg; ++s) add += tot[s * 128 + k];
#pragma unroll
    for (int i = 0; i < 16; ++i) bc[(16 * seg + i) * 132 + k] = loc[i] + add;
    __syncthreads();
}
__device__ __forceinline__ void hg_stage_v(const bf16* HI, int m0, int hh, unsigned char* lds, int tid) {
    const int row = tid >> 3, ch = tid & 7; const bf16* src = HI + (size_t)(m0 + row) * 512 + hh * 128 + 8 * ch; unsigned char* dst = lds + HG_V + row * 272 + 16 * ch;
    const v4u a = *(const v4u*)src, b = *(const v4u*)(src + 64); *(v4u*)dst = a; *(v4u*)(dst + 128) = b;
}
__device__ __forceinline__ void hg_local(const Params& p, unsigned char* lds, int tid, int wave, int lane, int bx, int G) {
    const float* HF = (const float*)(p.ws + WS_HF); const bf16* HI = (const bf16*)(p.ws + WS_HI); bf16* ST = (bf16*)(p.ws + WS_ST); float* DEC = (float*)(p.ws + WS_DEC);
    const float* bc = (const float*)(lds + HG_BC); const int kq = lane >> 4, fr = lane & 15;
    for (int it = bx; it < 1024; it += G) {
        const int b = it >> 9, hh = (it >> 7) & 3, c = it & 127, m0 = b * SEQ + c * 64;
        hg_cumsum(HF + (size_t)m0 * 512 + hh * 128, lds, tid);
        { const int seg = tid >> 7, k = tid & 127; const float ref = bc[31 * 132 + k]; unsigned w[8];
#pragma unroll
          for (int i = 0; i < 16; i += 2) { float km[2];
#pragma unroll
              for (int e = 0; e < 2; ++e) { const int s = 16 * seg + i + e; const float bs = bc[s * 132 + k]; const float prev = s > 0 ? bc[(s - 1) * 132 + k] : 0.f; km[e] = (1.0f - __expf(bs - prev)) * __expf(ref - bs); }
              w[i >> 1] = pk2(km[0], km[1]); }
          unsigned char* dst = lds + HG_KMT + k * 144 + 32 * seg; *(v4u*)dst = (v4u){w[0], w[1], w[2], w[3]}; *(v4u*)(dst + 16) = (v4u){w[4], w[5], w[6], w[7]}; }
        hg_stage_v(HI, m0, hh, lds, tid);
        if (tid < 128) DEC[(size_t)it * 128 + tid] = __expf(bc[63 * 132 + tid]);
        __syncthreads();
        f32x4 acc[8];
#pragma unroll
        for (int vt = 0; vt < 8; ++vt) acc[vt] = (f32x4){0.f, 0.f, 0.f, 0.f};
#pragma unroll
        for (int ks = 0; ks < 2; ++ks) { const bf16x8_t a = *(const bf16x8_t*)(lds + HG_KMT + (16 * wave + fr) * 144 + 64 * ks + 16 * kq);
            const unsigned char* vb = lds + HG_V + (32 * ks + 8 * kq + (fr >> 2)) * 272 + 8 * (fr & 3);
#pragma unroll
            for (int vt = 0; vt < 8; ++vt) { const bf16x8_t bfr = tr_frag(vb + 32 * vt, vb + 32 * vt + 4 * 272); acc[vt] = __builtin_amdgcn_mfma_f32_16x16x32_bf16(a, bfr, acc[vt], 0, 0, 0); } }
        float sc[4];
#pragma unroll
        for (int e = 0; e < 4; ++e) { const int k = 16 * wave + 4 * kq + e; sc[e] = __expf(bc[63 * 132 + k] - bc[31 * 132 + k]); }
#pragma unroll
        for (int vt = 0; vt < 8; ++vt) { const int v = 16 * vt + fr; const unsigned long long w = (unsigned long long)pk2(acc[vt][0] * sc[0], acc[vt][1] * sc[1]) | ((unsigned long long)pk2(acc[vt][2] * sc[2], acc[vt][3] * sc[3]) << 32);
            *(unsigned long long*)(ST + ((size_t)it * 128 + v) * 128 + 16 * wave + 4 * kq) = w; }
        __syncthreads();
    }
}
__device__ __forceinline__ void hg_scan(const Params& p, int gtid, int NGT) {
    bf16* ST = (bf16*)(p.ws + WS_ST); const float* DEC = (const float*)(p.ws + WS_DEC);
    for (int e = gtid; e < 8 * 16384; e += NGT) { const int bh = e >> 14, vk = e & 16383, k = vk & 127;
        bf16* base = ST + (size_t)bh * 128 * 16384 + vk; const float* dc = DEC + (size_t)bh * 128 * 128 + k; float S = 0.f;
#pragma unroll 8
        for (int c = 0; c < 128; ++c) { const float tmp = bf2f(base[(size_t)c * 16384]); base[(size_t)c * 16384] = (bf16)f2bf(S); S = dc[c * 128] * S + tmp; } }
}
template <bool DBG> __device__ __forceinline__ void hg_out(const Params& p, unsigned char* lds, int tid, int wave, int lane, int bx, int G, float& dnum, float& dden) {
    const float* HF = (const float*)(p.ws + WS_HF); const bf16* HI = (const bf16*)(p.ws + WS_HI); const bf16* HQ = (const bf16*)(p.ws + WS_HQ); const bf16* HGs = (const bf16*)(p.ws + WS_HGS);
    const bf16* ST = (const bf16*)(p.ws + WS_ST); bf16* OHGB = (bf16*)(p.ws + WS_OHGB);
    const float* bc = (const float*)(lds + HG_BC); float* RS = (float*)(lds + HG_RS); const int kq = lane >> 4, fr = lane & 15;
    for (int it = bx; it < 1024; it += G) {
        const int b = it >> 9, hh = (it >> 7) & 3, c = it & 127, m0 = b * SEQ + c * 64;
        hg_cumsum(HF + (size_t)m0 * 512 + hh * 128, lds, tid);
        { const int seg = tid >> 7, k = tid & 127; const float ref = bc[31 * 132 + k];
#pragma unroll 4
          for (int i = 0; i < 16; ++i) { const int t = 16 * seg + i; const float bt = bc[t * 132 + k]; const float prev = t > 0 ? bc[(t - 1) * 132 + k] : 0.f; const float q = bf2f(HQ[(size_t)(m0 + t) * 512 + hh * 128 + k]);
              const float em = __expf(bt - ref);
              *(bf16*)(lds + HG_QM + t * 272 + 2 * k) = (bf16)f2bf(q * em); *(bf16*)(lds + HG_QE + t * 272 + 2 * k) = (bf16)f2bf(q * __expf(bt));
              *(bf16*)(lds + HG_KM + t * 272 + 2 * k) = (bf16)f2bf((1.0f - __expf(bt - prev)) * __builtin_amdgcn_rcpf(em)); } }
        hg_stage_v(HI, m0, hh, lds, tid);
        __syncthreads();
        const int tt = wave >> 1;
        {
#pragma unroll
            for (int si = 0; si < 2; ++si) { const int st = 2 * (wave & 1) + si; f32x4 a4 = (f32x4){0.f, 0.f, 0.f, 0.f};
#pragma unroll
                for (int ks = 0; ks < 4; ++ks) { const bf16x8_t a = *(const bf16x8_t*)(lds + HG_QM + (16 * tt + fr) * 272 + 64 * ks + 16 * kq), bb = *(const bf16x8_t*)(lds + HG_KM + (16 * st + fr) * 272 + 64 * ks + 16 * kq);
                    a4 = __builtin_amdgcn_mfma_f32_16x16x32_bf16(a, bb, a4, 0, 0, 0); }
#pragma unroll
                for (int e = 0; e < 4; ++e) { const int t = 16 * tt + 4 * kq + e, s = 16 * st + fr; *(bf16*)(lds + HG_AM + t * 144 + 2 * s) = (bf16)f2bf(s <= t ? a4[e] : 0.f); } }
        }
        __syncthreads();
        f32x4 acc[4]; const int vh = wave & 1; const bf16* Sit = ST + (size_t)it * 16384;
#pragma unroll
        for (int vt = 0; vt < 4; ++vt) acc[vt] = (f32x4){0.f, 0.f, 0.f, 0.f};
#pragma unroll
        for (int ks = 0; ks < 4; ++ks) { const bf16x8_t a = *(const bf16x8_t*)(lds + HG_QE + (16 * tt + fr) * 272 + 64 * ks + 16 * kq);
#pragma unroll
            for (int vt = 0; vt < 4; ++vt) { const bf16x8_t bb = *(const bf16x8_t*)(Sit + (size_t)(64 * vh + 16 * vt + fr) * 128 + 32 * ks + 8 * kq); acc[vt] = __builtin_amdgcn_mfma_f32_16x16x32_bf16(a, bb, acc[vt], 0, 0, 0); } }
#pragma unroll
        for (int ks = 0; ks < 2; ++ks) { const bf16x8_t a = *(const bf16x8_t*)(lds + HG_AM + (16 * tt + fr) * 144 + 64 * ks + 16 * kq);
            const unsigned char* vb = lds + HG_V + (32 * ks + 8 * kq + (fr >> 2)) * 272 + 8 * (fr & 3) + 128 * vh;
#pragma unroll
            for (int vt = 0; vt < 4; ++vt) { const bf16x8_t bfr = tr_frag(vb + 32 * vt, vb + 32 * vt + 4 * 272); acc[vt] = __builtin_amdgcn_mfma_f32_16x16x32_bf16(a, bfr, acc[vt], 0, 0, 0); } }
        float ss[4];
#pragma unroll
        for (int e = 0; e < 4; ++e) { float s = 0.f;
#pragma unroll
            for (int vt = 0; vt < 4; ++vt) s += acc[vt][e] * acc[vt][e];
            s += __shfl_xor(s, 1); s += __shfl_xor(s, 2); s += __shfl_xor(s, 4); s += __shfl_xor(s, 8); ss[e] = s; }
        if (fr == 0) {
#pragma unroll
            for (int e = 0; e < 4; ++e) RS[(16 * tt + 4 * kq + e) * 2 + vh] = ss[e]; }
        __syncthreads();
#pragma unroll
        for (int e = 0; e < 4; ++e) { const int t = 16 * tt + 4 * kq + e; const float rinv = 1.0f / sqrtf((RS[t * 2] + RS[t * 2 + 1]) * (1.0f / 128.0f) + 1e-6f);
#pragma unroll
            for (int vt = 0; vt < 4; ++vt) { const int v = 64 * vh + 16 * vt + fr; const size_t oi = (size_t)(m0 + t) * 512 + hh * 128 + v; const float val = acc[vt][e] * rinv * p.hg_norm[v] * bf2f(HGs[oi]);
                if (DBG) { const float rf = bf2f(OHGB[oi]); dnum += (val - rf) * (val - rf); dden += rf * rf; } else OHGB[oi] = (bf16)f2bf(val); } }
        __syncthreads();
    }
}
constexpr size_t M_KC = 6 * MiB, M_VC = 6 * MiB + 512 * 1024;
constexpr size_t OFF_CB = 4096;
__device__ __forceinline__ void f_compress(const Params& p, unsigned char* lds, int tid, int wave, int lane, int bx, int G) {
    const bf16* KV = (const bf16*)(p.ws + WS_KV); const bf16* Wc = (const bf16*)(p.ws + WS_WCMP); const float* cb = (const float*)(p.ws + WS_SMALL + OFF_CB); const float* rope = (const float*)(p.ws + WS_SMALL + 65536);
    float* part = (float*)lds; const int kq = lane >> 4, fr = lane & 15;
    for (int it = bx; it < 256; it += G) {
        const int j = it & 1, nblk = (it >> 1) & 31, g = (it >> 6) & 1, b = it >> 7; const int n = 16 * nblk + fr;
        f32x4 acc[4];
#pragma unroll
        for (int ct = 0; ct < 4; ++ct) acc[ct] = (f32x4){0.f, 0.f, 0.f, 0.f};
#pragma unroll
        for (int kk = 0; kk < 8; ++kk) { const int ks = 8 * wave + kk, lt = ks >> 1, d0 = (ks & 1) * 32 + 8 * kq; int tr = 16 * n + lt; tr = tr > SEQ - 1 ? SEQ - 1 : tr;
            const bf16x8_t a = *(const bf16x8_t*)(KV + (size_t)(b * SEQ + tr) * 768 + j * 128 + g * 64 + d0);
#pragma unroll
            for (int ct = 0; ct < 4; ++ct) { const bf16x8_t bb = *(const bf16x8_t*)(Wc + (size_t)(j * 64 + 16 * ct + fr) * 2048 + 32 * ks + 8 * kq); acc[ct] = __builtin_amdgcn_mfma_f32_16x16x32_bf16(a, bb, acc[ct], 0, 0, 0); } }
#pragma unroll
        for (int ct = 0; ct < 4; ++ct)
#pragma unroll
            for (int e = 0; e < 4; ++e) part[wave * 1024 + (4 * kq + e) * 64 + 16 * ct + fr] = acc[ct][e];
        __syncthreads();
        { const int row = tid >> 5, cp = tid & 31, c0 = 2 * cp; float v0 = cb[j * 64 + c0], v1 = cb[j * 64 + c0 + 1];
#pragma unroll
          for (int w = 0; w < 8; ++w) { v0 += part[w * 1024 + row * 64 + c0]; v1 += part[w * 1024 + row * 64 + c0 + 1]; }
          const int nn = 16 * nblk + row;
          if (j == 0 && cp < 8) { const float cs = rope[(size_t)(16 * nn) * 16 + 2 * cp], sn = rope[(size_t)(16 * nn) * 16 + 2 * cp + 1]; const float t1 = v0, t2 = v1; v0 = t1 * cs - t2 * sn; v1 = t2 * cs + t1 * sn; }
          unsigned* dst = (unsigned*)((bf16*)(p.ws + WS_MISC + (j == 0 ? M_KC : M_VC)) + ((size_t)(b * 2 + g) * 512 + nn) * 64 + c0); *dst = pk2(v0, v1); }
        __syncthreads();
    }
}
constexpr int NS_KB = 0, NS_VB = 9216, NS_BUF = 18432;
constexpr int NS_IMPA = 36864, NS_IMPB = 53248;
constexpr int NS_SELM = 69632, NS_QMASK = 70144;
template <int CTRL> __device__ __forceinline__ float dpp_f(float v) { return __builtin_bit_cast(float, __builtin_amdgcn_update_dpp(0, __builtin_bit_cast(int, v), CTRL, 0xf, 0xf, true)); }
template <int CTRL> __device__ __forceinline__ unsigned dpp_u(unsigned v) { return (unsigned)__builtin_amdgcn_update_dpp(0, (int)v, CTRL, 0xf, 0xf, true); }
struct U4 { unsigned a, b, c, d; };
__device__ __forceinline__ unsigned ns_bit(const U4 m, int j) { const unsigned w = j < 64 ? (j < 32 ? m.a : m.b) : (j < 96 ? m.c : m.d); return (w >> (j & 31)) & 1u; }
__device__ __forceinline__ void ns_setbit(U4& m, int bi) { const unsigned v = 1u << (bi & 31); const int q = bi >> 5; m.a |= q == 0 ? v : 0u; m.b |= q == 1 ? v : 0u; m.c |= q == 2 ? v : 0u; m.d |= q == 3 ? v : 0u; }
struct NsaSt { f32x4 O[4]; float m, l; };
__device__ __forceinline__ void ns_reset(NsaSt& s) {
#pragma unroll
    for (int i = 0; i < 4; ++i) s.O[i] = (f32x4){0.f, 0.f, 0.f, 0.f};
    s.m = -1.0e30f; s.l = 0.f; }
__device__ __forceinline__ void ns_scores(f32x4 (&s)[4], const bf16x8_t (&qa)[2], const unsigned char* KB, int kq, int fr) {
#pragma unroll
    for (int ct = 0; ct < 4; ++ct) { s[ct] = (f32x4){0.f, 0.f, 0.f, 0.f};
#pragma unroll
        for (int ks = 0; ks < 2; ++ks) { const bf16x8_t kk = *(const bf16x8_t*)(KB + (16 * ct + fr) * 144 + 64 * ks + 16 * kq); s[ct] = __builtin_amdgcn_mfma_f32_16x16x32_bf16(kk, qa[ks], s[ct], 0, 0, 0); } }
}
__device__ __forceinline__ void ns_pv(f32x4 (&O)[4], const f32x4 (&pr)[4], const unsigned char* VB, int kq, int fr) {
#pragma unroll
    for (int ks = 0; ks < 2; ++ks) { bf16x8_t pb; const unsigned w0 = pk2(pr[2 * ks][0], pr[2 * ks][1]), w1 = pk2(pr[2 * ks][2], pr[2 * ks][3]), w2 = pk2(pr[2 * ks + 1][0], pr[2 * ks + 1][1]), w3 = pk2(pr[2 * ks + 1][2], pr[2 * ks + 1][3]);
        pb = __builtin_bit_cast(bf16x8_t, (v4u){w0, w1, w2, w3});
        const unsigned char* vb = VB + (32 * ks + 4 * kq + (fr >> 2)) * 144 + 8 * (fr & 3);
#pragma unroll
        for (int dt = 0; dt < 4; ++dt) { const bf16x8_t va = tr_frag(vb + 32 * dt, vb + 32 * dt + 16 * 144); O[dt] = __builtin_amdgcn_mfma_f32_16x16x32_bf16(va, pb, O[dt], 0, 0, 0); } }
}
__device__ __forceinline__ void ns_online(NsaSt& st, f32x4 (&s)[4], const unsigned (&vm)[4], const unsigned char* VB, int kq, int fr) {
    float mx = -1.0e30f;
#pragma unroll
    for (int ct = 0; ct < 4; ++ct)
#pragma unroll
        for (int e = 0; e < 4; ++e) mx = fmaxf(mx, (vm[ct] >> e) & 1u ? s[ct][e] : -1.0e30f);
    mx = fmaxf(mx, __shfl_xor(mx, 16)); mx = fmaxf(mx, __shfl_xor(mx, 32));
    const float mn = fmaxf(st.m, mx); const float al = __builtin_amdgcn_exp2f(st.m - mn); st.m = mn; float ps = 0.f; f32x4 pr[4];
#pragma unroll
    for (int ct = 0; ct < 4; ++ct)
#pragma unroll
        for (int e = 0; e < 4; ++e) { const float pv = (vm[ct] >> e) & 1u ? __builtin_amdgcn_exp2f(s[ct][e] - mn) : 0.f; pr[ct][e] = pv; ps += pv; }
    st.l = st.l * al + ps;
    if (__any(al != 1.0f)) {
#pragma unroll
        for (int dt = 0; dt < 4; ++dt) st.O[dt] *= al; }
    ns_pv(st.O, pr, VB, kq, fr);
}
__device__ __forceinline__ void ns_online_full(NsaSt& st, f32x4 (&s)[4], bool lv, const unsigned char* VB, int kq, int fr) {
    float m0 = fmaxf(fmaxf(s[0][0], s[0][1]), fmaxf(s[0][2], s[0][3])), m1 = fmaxf(fmaxf(s[1][0], s[1][1]), fmaxf(s[1][2], s[1][3])), m2 = fmaxf(fmaxf(s[2][0], s[2][1]), fmaxf(s[2][2], s[2][3])), m3 = fmaxf(fmaxf(s[3][0], s[3][1]), fmaxf(s[3][2], s[3][3]));
    float mx = lv ? fmaxf(fmaxf(m0, m1), fmaxf(m2, m3)) : -1.0e30f;
    mx = fmaxf(mx, __shfl_xor(mx, 16)); mx = fmaxf(mx, __shfl_xor(mx, 32));
    const float mn = fmaxf(st.m, mx); const float al = __builtin_amdgcn_exp2f(st.m - mn); st.m = mn; const float sub = lv ? mn : 3.0e38f; float ps = 0.f; f32x4 pr[4];
#pragma unroll
    for (int ct = 0; ct < 4; ++ct)
#pragma unroll
        for (int e = 0; e < 4; ++e) { const float pv = __builtin_amdgcn_exp2f(s[ct][e] - sub); pr[ct][e] = pv; ps += pv; }
    st.l = st.l * al + ps;
    if (__any(al != 1.0f)) {
#pragma unroll
        for (int dt = 0; dt < 4; ++dt) st.O[dt] *= al; }
    ns_pv(st.O, pr, VB, kq, fr);
}
__device__ __forceinline__ float ns_rowsum(float v) { v += __shfl_xor(v, 16); v += __shfl_xor(v, 32); return v; }
struct NsStage { v4u k, v; };
__device__ __forceinline__ void ns_load(NsStage& r, const bf16* Kp, const bf16* Vp, size_t stride, int tid) { const int row = tid >> 3, ch = tid & 7; r.k = *(const v4u*)(Kp + (size_t)row * stride + 8 * ch); r.v = *(const v4u*)(Vp + (size_t)row * stride + 8 * ch); }
__device__ __forceinline__ void ns_store(const NsStage& r, unsigned char* lds, int buf, int tid) { const int row = tid >> 3, ch = tid & 7; *(v4u*)(lds + buf * NS_BUF + NS_KB + row * 144 + 16 * ch) = r.k; *(v4u*)(lds + buf * NS_BUF + NS_VB + row * 144 + 16 * ch) = r.v; }
template <class NextF, class CompF> __device__ __forceinline__ void ns_pipe(const bf16* Kg, const bf16* Vg, size_t stride, int jfirst, NextF next, CompF comp, unsigned char* lds, int tid) {
    NsStage ra, rb; int j0 = jfirst, j1 = next(j0), j2 = j1 >= 0 ? next(j1) : -1;
    ns_load(ra, Kg + (size_t)(64 * j0) * stride, Vg + (size_t)(64 * j0) * stride, stride, tid); ns_store(ra, lds, 0, tid);
    if (j1 >= 0) ns_load(ra, Kg + (size_t)(64 * j1) * stride, Vg + (size_t)(64 * j1) * stride, stride, tid);
    __syncthreads();
    int i = 0;
    for (;;) {
        if (j2 >= 0) ns_load(rb, Kg + (size_t)(64 * j2) * stride, Vg + (size_t)(64 * j2) * stride, stride, tid);
        comp(j0, i & 1);
        if (j1 >= 0) ns_store(ra, lds, (i + 1) & 1, tid);
        __syncthreads();
        j0 = j1; j1 = j2; j2 = j1 >= 0 ? next(j1) : -1; ++i;
        if (j0 < 0) break;
        if (j2 >= 0) ns_load(ra, Kg + (size_t)(64 * j2) * stride, Vg + (size_t)(64 * j2) * stride, stride, tid);
        comp(j0, i & 1);
        if (j1 >= 0) ns_store(rb, lds, (i + 1) & 1, tid);
        __syncthreads();
        j0 = j1; j1 = j2; j2 = j1 >= 0 ? next(j1) : -1; ++i;
        if (j0 < 0) break;
    }
}
template <int DBG> __device__ __forceinline__ void f_nsa(const Params& p, unsigned char* lds, int tid, int wave, int lane, int bx, int G, float& dnum, float& dden) {
    const bf16* Q = (const bf16*)(p.ws + WS_Q); const bf16* KV = (const bf16*)(p.ws + WS_KV); const float* GT = (const float*)(p.ws + WS_GT);
    const bf16* KC = (const bf16*)(p.ws + WS_MISC + M_KC); const bf16* VC = (const bf16*)(p.ws + WS_MISC + M_VC); bf16* ONSAB = (bf16*)(p.ws + WS_ONSAB);
    const int kq = lane >> 4, fr = lane & 15, tkl = fr >> 2, hd = fr & 3;
    float* IMPA = (float*)(lds + NS_IMPA); float* IMPB = (float*)(lds + NS_IMPB); volatile unsigned* SELM = (volatile unsigned*)(lds + NS_SELM); volatile unsigned* QMASK = (volatile unsigned*)(lds + NS_QMASK);
    for (int it = bx; it < 1024; it += G) {
        int b, gg, tile;
        if (G == 256) {
            const int k = it >> 8, xcd = bx & 7, bg = xcd >> 1, w64 = (bx >> 3) * 2 + (xcd & 1), tq = w64 + 64 * (k >> 1); b = bg >> 1; gg = bg & 1; tile = (k & 1) ? 255 - tq : tq;
        } else { const int ii = it >> 8, c8 = it & 255; tile = (ii & 1) ? 255 - c8 : c8; b = ii >> 1; gg = ii & 1; }
        const int t0 = tile * 32, m0 = b * SEQ + t0, m0w = m0 + 4 * wave, tL = t0 + 4 * wave + tkl;
        bf16x8_t qa[2];
#pragma unroll
        for (int ks = 0; ks < 2; ++ks) qa[ks] = *(const bf16x8_t*)(Q + (size_t)(m0w + tkl) * 512 + (gg * 4 + hd) * 64 + 32 * ks + 8 * kq);
        f32x4 oacc[4];
#pragma unroll
        for (int dt = 0; dt < 4; ++dt) oacc[dt] = (f32x4){0.f, 0.f, 0.f, 0.f};
        NsaSt st;
        const int nvL = tL >= 31 ? (tL - 31) / 16 + 1 : 0; const int nvT = t0 / 16 + 1; const int NBc = (nvT + 63) >> 6;
        const bf16* KCb = KC + (size_t)(b * 2 + gg) * 512 * 64; const bf16* VCb = VC + (size_t)(b * 2 + gg) * 512 * 64;
        auto nextc = [&](int j) -> int { return j + 1 < NBc ? j + 1 : -1; };
        ns_reset(st);
        ns_pipe(KCb, VCb, 64, 0, nextc, [&](int i, int buf) {
            f32x4 s[4]; ns_scores(s, qa, lds + buf * NS_BUF + NS_KB, kq, fr);
            float mx = -1.0e30f;
#pragma unroll
            for (int ct = 0; ct < 4; ++ct)
#pragma unroll
                for (int e = 0; e < 4; ++e) mx = fmaxf(mx, (64 * i + 16 * ct + 4 * kq + e) < nvL ? s[ct][e] : -1.0e30f);
            mx = fmaxf(mx, __shfl_xor(mx, 16)); mx = fmaxf(mx, __shfl_xor(mx, 32));
            const float mn = fmaxf(st.m, mx); const float al = __builtin_amdgcn_exp2f(st.m - mn); st.m = mn; float ps = 0.f;
#pragma unroll
            for (int ct = 0; ct < 4; ++ct)
#pragma unroll
                for (int e = 0; e < 4; ++e) ps += (64 * i + 16 * ct + 4 * kq + e) < nvL ? __builtin_amdgcn_exp2f(s[ct][e] - mn) : 0.f;
            st.l = st.l * al + ps;
        }, lds, tid);
        const float Lc = ns_rowsum(st.l); const float rl = Lc > 0.f ? 1.0f / Lc : 0.f;
        ns_pipe(KCb, VCb, 64, 0, nextc, [&](int i, int buf) {
            f32x4 s[4]; f32x4 pr[4]; ns_scores(s, qa, lds + buf * NS_BUF + NS_KB, kq, fr);
#pragma unroll
            for (int ct = 0; ct < 4; ++ct) {
#pragma unroll
                for (int e = 0; e < 4; ++e) pr[ct][e] = (64 * i + 16 * ct + 4 * kq + e) < nvL ? __builtin_amdgcn_exp2f(s[ct][e] - st.m) * rl : 0.f;
                float own = (pr[ct][0] + pr[ct][1]) + (pr[ct][2] + pr[ct][3]), spill = pr[ct][3];
                own += dpp_f<0xB1>(own); own += dpp_f<0x4E>(own); spill += dpp_f<0xB1>(spill); spill += dpp_f<0x4E>(spill);
                if (hd == 0) { const int jj = 16 * i + 4 * ct + kq; IMPA[(4 * wave + tkl) * 128 + jj] = own; if (jj + 1 < 128) IMPB[(4 * wave + tkl) * 128 + jj + 1] = spill; } }
            ns_pv(st.O, pr, lds + buf * NS_BUF + NS_VB, kq, fr);
        }, lds, tid);
        const float gate_c = GT[(size_t)(m0w + tkl) * 24 + (gg * 4 + hd) * 3 + 0];
#pragma unroll
        for (int dt = 0; dt < 4; ++dt) oacc[dt] = st.O[dt] * gate_c;
        U4 qm = {0u, 0u, 0u, 0u};
        for (int tk = 0; tk < 4; ++tk) { const int t = t0 + 4 * wave + tk, jc = t >> 6; U4 mk = {0u, 0u, 0u, 0u};
            if (DBG == 2) { const int* selidx = (const int*)(p.ws + WS_MISC) + ((size_t)(m0w + tk) * 2 + gg) * TOPN;
                for (int k = 0; k < TOPN; ++k) ns_setbit(mk, selidx[k]);
            } else {
                const float* ia = IMPA + (4 * wave + tk) * 128; const float* ib = IMPB + (4 * wave + tk) * 128; const int jw = 16 * NBc;
                unsigned k0, k1;
                { const int ja = lane, jb = lane + 64;
                  const float i0 = (ja < jw ? ia[ja] : 0.f) + ((ja >= 1 && ja <= jw) ? ib[ja] : 0.f), i1 = (jb < jw ? ia[jb] : 0.f) + (jb <= jw ? ib[jb] : 0.f);
                  const unsigned c0 = (ja == jc || ja == 0) ? 0x7f000000u : (64 * ja <= t ? (__builtin_bit_cast(unsigned, i0) & 0xffffff80u) + 0x80u : 0u), c1 = (jb == jc) ? 0x7f000000u : (64 * jb <= t ? (__builtin_bit_cast(unsigned, i1) & 0xffffff80u) + 0x80u : 0u);
                  k0 = c0 | (unsigned)(127 - ja); k1 = c1 | (unsigned)(127 - jb); }
                for (int k = 0; k < TOPN; ++k) { unsigned m = k0 > k1 ? k0 : k1;
                    { unsigned o; o = dpp_u<0x128>(m); m = m > o ? m : o; o = dpp_u<0x124>(m); m = m > o ? m : o; o = dpp_u<0x122>(m); m = m > o ? m : o; o = dpp_u<0x121>(m); m = m > o ? m : o; }
                    const unsigned r0 = (unsigned)__builtin_amdgcn_readlane((int)m, 0), r1 = (unsigned)__builtin_amdgcn_readlane((int)m, 16), r2 = (unsigned)__builtin_amdgcn_readlane((int)m, 32), r3 = (unsigned)__builtin_amdgcn_readlane((int)m, 48);
                    const unsigned ra = r0 > r1 ? r0 : r1, rb = r2 > r3 ? r2 : r3, best = ra > rb ? ra : rb; const int bi = 127 - (int)(best & 127u);
                    ns_setbit(mk, bi);
                    if (k0 == best) k0 = 0u; if (k1 == best) k1 = 0u; }
            }
            qm.a |= mk.a; qm.b |= mk.b; qm.c |= mk.c; qm.d |= mk.d;
            if (lane == 0) { SELM[(4 * wave + tk) * 4 + 0] = mk.a; SELM[(4 * wave + tk) * 4 + 1] = mk.b; SELM[(4 * wave + tk) * 4 + 2] = mk.c; SELM[(4 * wave + tk) * 4 + 3] = mk.d; }
            if (DBG == 3) {
                const int* selidx = (const int*)(p.ws + WS_MISC) + ((size_t)(m0w + tk) * 2 + gg) * TOPN; U4 rk = {0u, 0u, 0u, 0u};
                for (int k = 0; k < TOPN; ++k) ns_setbit(rk, selidx[k]);
                unsigned diff = 0u;
                for (int j2 = 0; j2 <= jc; ++j2) diff |= ns_bit(rk, j2) ^ ns_bit(mk, j2);
                if (lane == 0) { dnum += diff ? 1.0f : 0.0f; dden += 1.0f; } }
        }
        if (lane == 0) { QMASK[wave * 4 + 0] = qm.a; QMASK[wave * 4 + 1] = qm.b; QMASK[wave * 4 + 2] = qm.c; QMASK[wave * 4 + 3] = qm.d; }
        __syncthreads();
        U4 um;
        { unsigned u0 = 0u, u1 = 0u, u2 = 0u, u3 = 0u; for (int w = 0; w < 8; ++w) { u0 |= QMASK[w * 4 + 0]; u1 |= QMASK[w * 4 + 1]; u2 |= QMASK[w * 4 + 2]; u3 |= QMASK[w * 4 + 3]; }
          um.a = __builtin_amdgcn_readfirstlane(u0); um.b = __builtin_amdgcn_readfirstlane(u1); um.c = __builtin_amdgcn_readfirstlane(u2); um.d = __builtin_amdgcn_readfirstlane(u3); }
        {
            ns_reset(st);
            const int jmax = (t0 + 31) >> 6;
            auto nextj = [&](int from) -> int { for (int j = from + 1; j <= jmax; ++j) if (ns_bit(um, j)) return j; return -1; };
            ns_pipe(KV + (size_t)(b * SEQ) * 768 + 256 + gg * 64, KV + (size_t)(b * SEQ) * 768 + 384 + gg * 64, 768, 0, nextj, [&](int j, int buf) {
                if (ns_bit(qm, j)) { f32x4 s[4];
                    ns_scores(s, qa, lds + buf * NS_BUF + NS_KB, kq, fr);
                    const bool selb = (SELM[(4 * wave + tkl) * 4 + (j >> 5)] >> (j & 31)) & 1u;
                    if (64 * j + 63 <= t0 + 4 * wave) ns_online_full(st, s, selb, lds + buf * NS_BUF + NS_VB, kq, fr);
                    else { unsigned vm[4];
#pragma unroll
                        for (int ct = 0; ct < 4; ++ct) { unsigned v = 0u;
#pragma unroll
                            for (int e = 0; e < 4; ++e) v |= (selb && (64 * j + 16 * ct + 4 * kq + e) <= tL) ? (1u << e) : 0u;
                            vm[ct] = v; }
                        ns_online(st, s, vm, lds + buf * NS_BUF + NS_VB, kq, fr); } }
            }, lds, tid);
            const float L = ns_rowsum(st.l); const float gate = GT[(size_t)(m0w + tkl) * 24 + (gg * 4 + hd) * 3 + 1] * (L > 0.f ? 1.0f / L : 0.f);
#pragma unroll
            for (int dt = 0; dt < 4; ++dt) oacc[dt] += st.O[dt] * gate;
        }
        {
            ns_reset(st);
            const int j0 = (t0 - 511) > 0 ? (t0 - 511) >> 6 : 0, j1 = (t0 + 31) >> 6;
            ns_pipe(KV + (size_t)(b * SEQ) * 768 + 512 + gg * 64, KV + (size_t)(b * SEQ) * 768 + 640 + gg * 64, 768, j0, [&](int j) -> int { return j + 1 <= j1 ? j + 1 : -1; }, [&](int j, int buf) {
                f32x4 s[4];
                ns_scores(s, qa, lds + buf * NS_BUF + NS_KB, kq, fr);
                if (64 * j + 63 <= t0 + 4 * wave && 64 * j >= t0 + 4 * wave + 3 - 511) ns_online_full(st, s, true, lds + buf * NS_BUF + NS_VB, kq, fr);
                else { unsigned vm[4];
#pragma unroll
                    for (int ct = 0; ct < 4; ++ct) { unsigned v = 0u;
#pragma unroll
                        for (int e = 0; e < 4; ++e) { const int kp = 64 * j + 16 * ct + 4 * kq + e; v |= (kp <= tL && kp >= tL - 511) ? (1u << e) : 0u; }
                        vm[ct] = v; }
                    ns_online(st, s, vm, lds + buf * NS_BUF + NS_VB, kq, fr); }
            }, lds, tid);
            const float L = ns_rowsum(st.l); const float gate = GT[(size_t)(m0w + tkl) * 24 + (gg * 4 + hd) * 3 + 2] * (L > 0.f ? 1.0f / L : 0.f);
#pragma unroll
            for (int dt = 0; dt < 4; ++dt) oacc[dt] += st.O[dt] * gate;
        }
#pragma unroll
        for (int dt = 0; dt < 4; ++dt) { const size_t oi = (size_t)(m0w + tkl) * 512 + (gg * 4 + hd) * 64 + 16 * dt + 4 * kq;
            if (DBG == 2) {
#pragma unroll
                for (int e = 0; e < 4; ++e) { const float rf = bf2f(ONSAB[oi + e]); dnum += (oacc[dt][e] - rf) * (oacc[dt][e] - rf); dden += rf * rf; }
            } else if (DBG == 0) *(unsigned long long*)(ONSAB + oi) = (unsigned long long)pk2(oacc[dt][0], oacc[dt][1]) | ((unsigned long long)pk2(oacc[dt][2], oacc[dt][3]) << 32); }
        __syncthreads();
    }
}
__device__ __forceinline__ void f_router(const Params& p, unsigned char* lds, int wave, int lane, int gw, int NGW) {
    REP(8) { float* scr = (float*)(lds + wave * 8448); bf16* Wd_t = (bf16*)(p.ws + WS_WD); bf16* Wgu_t = (bf16*)(p.ws + WS_WGU);
      for (int r = gw; r < NE * 8 * 32; r += NGW) { const int e = r >> 8, rem = r & 255, kb = rem >> 5, nb = rem & 31; const float* W = p.w_down + (size_t)e * FF * DM;
          tr_item([W](int k, int n) { return W[(size_t)k * DM + n]; }, FF, Wd_t + (size_t)e * DM * FF, 32 * nb, 64 * kb, scr, lane); }
      for (int r = gw; r < NE * 16 * 32; r += NGW) { const int e = r >> 9, rem = r & 511, kb = rem >> 5, nb = rem & 31; const int n0 = 32 * nb, which = (n0 >> 7) & 1, cb = (n0 >> 8) * 128 + (n0 & 127) - n0;
          const float* W = (which ? p.w_up : p.w_gate) + (size_t)e * DM * FF;
          tr_item([W, cb](int k, int n) { return W[(size_t)k * FF + n + cb]; }, DM, Wgu_t + (size_t)e * 1024 * DM, n0, 64 * kb, scr, lane); } }
    __syncthreads();
    float* lg = (float*)(lds + wave * 4096); float* rr = lg + 16 * 48;
    const bf16* Wh = (const bf16*)(p.ws + WS_SMALL + OFF_WRH); const bf16* Wl = (const bf16*)(p.ws + WS_SMALL + OFF_WRL);
    int* eid = (int*)(p.ws + WS_MISC + M_EID); float* ew = (float*)(p.ws + WS_MISC + M_EW); int* slot = (int*)(p.ws + WS_MISC + M_SLOT); float* rinv = (float*)(p.ws + WS_MISC + M_RINV);
    int* cnt = (int*)(p.ws + WS_CTL) + CW_CNT;
    const int row = lane & 15, kq = lane >> 4;
    for (int it = gw; it < TOK / 16; it += NGW) {
        const int m0 = it * 16; const float* xr = p.out + (size_t)(m0 + row) * DM;
        f32x4 acc[3]; acc[0] = (f32x4){0.f, 0.f, 0.f, 0.f}; acc[1] = acc[0]; acc[2] = acc[0]; float ss = 0.f;
        for (int s = 0; s < 32; ++s) { const int k0 = 32 * s + 8 * kq;
            const f32x4 x0 = *(const f32x4*)(xr + k0), x1 = *(const f32x4*)(xr + k0 + 4); const f32x4 g0 = *(const f32x4*)(p.ffn_norm + k0), g1 = *(const f32x4*)(p.ffn_norm + k0 + 4);
            ss += (x0.x * x0.x + x0.y * x0.y) + (x0.z * x0.z + x0.w * x0.w) + (x1.x * x1.x + x1.y * x1.y) + (x1.z * x1.z + x1.w * x1.w);
            const f32x4 y0 = x0 * g0, y1 = x1 * g1; bf16x8_t ah, al;
#pragma unroll
            for (int j = 0; j < 4; ++j) { unsigned h = f2bf(y0[j]); ah[j] = (short)h; al[j] = (short)f2bf(y0[j] - __builtin_bit_cast(float, h << 16)); h = f2bf(y1[j]); ah[4 + j] = (short)h; al[4 + j] = (short)f2bf(y1[j] - __builtin_bit_cast(float, h << 16)); }
#pragma unroll
            for (int ct = 0; ct < 3; ++ct) { const bf16x8_t bh = *(const bf16x8_t*)(Wh + (size_t)(16 * ct + row) * DM + k0), bl = *(const bf16x8_t*)(Wl + (size_t)(16 * ct + row) * DM + k0);
                acc[ct] = __builtin_amdgcn_mfma_f32_16x16x32_bf16(ah, bh, acc[ct], 0, 0, 0); acc[ct] = __builtin_amdgcn_mfma_f32_16x16x32_bf16(ah, bl, acc[ct], 0, 0, 0); acc[ct] = __builtin_amdgcn_mfma_f32_16x16x32_bf16(al, bh, acc[ct], 0, 0, 0); } }
        ss += __shfl_xor(ss, 16); ss += __shfl_xor(ss, 32);
        const float ri = 1.0f / sqrtf(ss * (1.0f / DM) + 1e-6f);
        WAVE_LDS_FENCE();
        if (kq == 0) rr[row] = ri;
#pragma unroll
        for (int ct = 0; ct < 3; ++ct)
#pragma unroll
            for (int e = 0; e < 4; ++e) lg[(4 * kq + e) * 48 + 16 * ct + row] = acc[ct][e];
        WAVE_LDS_FENCE();
        if (lane < 16) { const int m = m0 + lane; const float rv = rr[lane]; const float* L = lg + lane * 48;
            float gl[4]; int gs = 0;
#pragma unroll
            for (int i = 0; i < 4; ++i) gl[i] = L[i] * rv + p.b_grp[i];
            float gm = gl[0];
#pragma unroll
            for (int i = 1; i < 4; ++i) if (gl[i] > gm) { gm = gl[i]; gs = i; }
            float den = 0.f;
#pragma unroll
            for (int i = 0; i < 4; ++i) den += expf(gl[i] - gm);
            const float gp = 1.0f / den;
            float el[8];
#pragma unroll
            for (int i = 0; i < 8; ++i) el[i] = L[4 + gs * 8 + i] * rv + p.b_rtr[gs * 8 + i];
            int i0 = 0; float b0 = el[0];
#pragma unroll
            for (int i = 1; i < 8; ++i) if (el[i] > b0) { b0 = el[i]; i0 = i; }
            int i1 = -1; float b1 = -3.0e38f;
#pragma unroll
            for (int i = 0; i < 8; ++i) if (i != i0 && el[i] > b1) { b1 = el[i]; i1 = i; }
            const float e1 = expf(b1 - b0); const float w0 = 1.0f / (1.0f + e1), w1 = e1 / (1.0f + e1);
            const int ea = gs * 8 + i0, eb = gs * 8 + i1;
            eid[m * 2] = ea; eid[m * 2 + 1] = eb; ew[m * 2] = w0 * gp; ew[m * 2 + 1] = w1 * gp; rinv[m] = rv;
            slot[m * 2] = atomicAdd(&cnt[ea], 1); slot[m * 2 + 1] = atomicAdd(&cnt[eb], 1); }
    }
}
__device__ __forceinline__ void f_fill(const Params& p, volatile LAS unsigned* MISC, int tid, int lane, int gw, int NGW) {
    const int* cnt = (const int*)(p.ws + WS_CTL) + CW_CNT;
    if (tid == 0) { unsigned a = 0; for (int q = 0; q < NE; ++q) { MISC[MISC_TP + q] = a; a += ((unsigned)__hip_atomic_load(cnt + q, __ATOMIC_RELAXED, __HIP_MEMORY_SCOPE_AGENT) + 255u) >> 8; } MISC[MISC_TP + NE] = a; }
    __syncthreads();
    const int* eid = (const int*)(p.ws + WS_MISC + M_EID); const int* slot = (const int*)(p.ws + WS_MISC + M_SLOT); int* pos = (int*)(p.ws + WS_MISC + M_POS);
    const float* rinv = (const float*)(p.ws + WS_MISC + M_RINV); float* rs = (float*)(p.ws + WS_MISC + M_RS); bf16* H2S = (bf16*)(p.ws + WS_H2S);
    for (int m = gw; m < TOK; m += NGW) {
        const int ra = (int)MISC[MISC_TP + eid[2 * m]] * 256 + slot[2 * m], rb = (int)MISC[MISC_TP + eid[2 * m + 1]] * 256 + slot[2 * m + 1];
        if (lane == 0) { pos[2 * m] = ra; pos[2 * m + 1] = rb; const float rv = rinv[m]; rs[ra] = rv; rs[rb] = rv; }
        const f32x4* xr = (const f32x4*)(p.out + (size_t)m * DM) + lane; const f32x4* gr = (const f32x4*)p.ffn_norm + lane;
        unsigned long long* oa = (unsigned long long*)(H2S + (size_t)ra * DM) + lane; unsigned long long* ob = (unsigned long long*)(H2S + (size_t)rb * DM) + lane;
#pragma unroll
        for (int j = 0; j < 4; ++j) { const f32x4 v = xr[64 * j] * gr[64 * j]; const unsigned long long w = (unsigned long long)pk2(v.x, v.y) | ((unsigned long long)pk2(v.z, v.w) << 32); oa[64 * j] = w; ob[64 * j] = w; }
    }
}
__device__ __forceinline__ void f_final(const Params& p, int lane, int gw, int NGW) {
    const bf16* Y = (const bf16*)(p.ws + WS_YB); const int* eid = (const int*)(p.ws + WS_MISC + M_EID); const float* ew = (const float*)(p.ws + WS_MISC + M_EW); const int* pos = (const int*)(p.ws + WS_MISC + M_POS);
    for (int t = gw; t < TOK; t += NGW) {
        int a = 0, b = 1; if (eid[t * 2 + 1] < eid[t * 2]) { a = 1; b = 0; }
        const float wa = ew[t * 2 + a], wb = ew[t * 2 + b];
        const unsigned long long* ya = (const unsigned long long*)(Y + (size_t)pos[t * 2 + a] * DM) + lane; const unsigned long long* yb = (const unsigned long long*)(Y + (size_t)pos[t * 2 + b] * DM) + lane;
        f32x4* xr = (f32x4*)(p.out + (size_t)t * DM) + lane; const f32x4* gr = (const f32x4*)p.final_norm + lane;
        f32x4 v[4]; float s = 0.f;
#pragma unroll
        for (int j = 0; j < 4; ++j) { const unsigned long long qa = ya[64 * j], qb = yb[64 * j]; const unsigned a0 = (unsigned)qa, a1 = (unsigned)(qa >> 32), b0 = (unsigned)qb, b1 = (unsigned)(qb >> 32);
            f32x4 fa, fb; fa.x = __builtin_bit_cast(float, a0 << 16); fa.y = __builtin_bit_cast(float, a0 & 0xffff0000u); fa.z = __builtin_bit_cast(float, a1 << 16); fa.w = __builtin_bit_cast(float, a1 & 0xffff0000u);
            fb.x = __builtin_bit_cast(float, b0 << 16); fb.y = __builtin_bit_cast(float, b0 & 0xffff0000u); fb.z = __builtin_bit_cast(float, b1 << 16); fb.w = __builtin_bit_cast(float, b1 & 0xffff0000u);
            v[j] = xr[64 * j] + (fa * wa + fb * wb); s += (v[j].x * v[j].x + v[j].y * v[j].y) + (v[j].z * v[j].z + v[j].w * v[j].w); }
        float r = 1.0f / sqrtf(wave_sum(s) * (1.0f / DM) + 1e-6f);
        if (DBG_MODE == 4) { const unsigned long long* tsb = (const unsigned long long*)(p.ws + WS_CTL) + 12288; r *= 1.0f + 10.0f * (float)(tsb[TS_B] - tsb[TS_A]) * (1.0f / 200000.0f); }
        else if (DBG_MODE) { const float* dp = (const float*)(p.ws + WS_CTL) + CW_DBG; float num = 0.f, den = 0.f; for (int q = 0; q < 256; ++q) { num += dp[2 * q]; den += dp[2 * q + 1]; } r *= 1.0f + 10.0f * sqrtf(num / den); }
#pragma unroll
        for (int j = 0; j < 4; ++j) { const f32x4 g = gr[64 * j]; f32x4 w; w.x = v[j].x * r * g.x; w.y = v[j].y * r * g.y; w.z = v[j].z * r * g.z; w.w = v[j].w * r * g.w; xr[64 * j] = w; }
    }
}

struct Args { Params p; int pad0, pad1; };
__global__ void __launch_bounds__(NWAVES * 64, 2) mk_fwd(Args args) {
    extern __shared__ __attribute__((aligned(16))) unsigned char lds[];
    const Params& p = args.p;
    const int tid = threadIdx.x, lane = tid & 63, wave = __builtin_amdgcn_readfirstlane(tid >> 6);
    const int G = gridDim.x; const int bx = blockIdx.x; const int vcu = (G % 8 == 0) ? (bx % 8) * (G / 8) + bx / 8 : bx;
    const int gw = vcu * NWAVES + wave, NGW = G * NWAVES, gtid = bx * (NWAVES * 64) + tid, NGT = G * NWAVES * 64;
    volatile LAS unsigned* MISC = (volatile LAS unsigned*)((LAS unsigned char*)lds + MISC_OFF);
    for (int u = tid; u < (LDS_BYTES - MISC_OFF) / 4; u += NWAVES * 64) ((LAS unsigned*)((LAS unsigned char*)lds + MISC_OFF))[u] = 0u;
    __syncthreads();
    gu32* ctl = (gu32*)(p.ws + WS_CTL);
    XcdBarrier bar = xcd_barrier_post((unsigned*)(ctl + CW_BAR), MISC + 8);
#if DBG_MODE == 4
    int ts_n = 0; unsigned long long* tsb = (unsigned long long*)(p.ws + WS_CTL) + 12288;
#define STAMP() do { if (bx == 0 && tid == 0) tsb[ts_n] = __builtin_amdgcn_s_memrealtime(); ++ts_n; } while (0)
#else
#define STAMP() do {} while (0)
#endif
#define GRID_BAR() do { xcd_barrier(bar); STAMP(); } while (0)
    STAMP();

    REP(1) p0_prologue(p, lds, wave, lane, gw, NGW, gtid, NGT);
    GRID_BAR();
    REP(2) {
        pg8::Gemm g{(const pg8::bf16_t*)(p.ws + WS_XN), (const pg8::bf16_t*)(p.ws + WS_WIN), TOK, NPROJ, DM, nullptr, nullptr}; pg8::StaticOrder S; S.init(TOK, NPROJ, G, bx);
        pg8::EpiProj E{(pg8::bf16_t*)(p.ws + WS_Q), (pg8::bf16_t*)(p.ws + WS_KV), (pg8::bf16_t*)(p.ws + WS_HQ), (pg8::bf16_t*)(p.ws + WS_HI), (pg8::bf16_t*)(p.ws + WS_HGS), (pg8::bf16_t*)p.out,
                       (float*)(p.ws + WS_HF), (float*)(p.ws + WS_GT), (const float*)(p.ws + WS_SMALL), (const float*)(p.ws + WS_SMALL + 65536)};
        pg8::gemm_phase<pg8::EpiProj, pg8::StaticOrder, true, true>((LAS unsigned char*)lds, g, S, E);
    }
    GRID_BAR();
#define DBG_REDUCE(dn, dd) do { dn = wave_sum(dn); dd = wave_sum(dd); float* red = (float*)lds; __syncthreads(); if (lane == 0) { red[2 * wave] = dn; red[2 * wave + 1] = dd; } __syncthreads(); \
      if (tid == 0) { float a_ = 0.f, b_ = 0.f; for (int q = 0; q < 8; ++q) { a_ += red[2 * q]; b_ += red[2 * q + 1]; } float* dp = (float*)(p.ws + WS_CTL) + CW_DBG; dp[2 * bx] = a_; dp[2 * bx + 1] = b_; } __syncthreads(); } while (0)
#if DBG_MODE == 0 || DBG_MODE == 4
    REP(3) { f_compress(p, lds, tid, wave, lane, bx, G);
    hg_local(p, lds, tid, wave, lane, bx, G); }
    GRID_BAR();
    hg_scan(p, gtid, NGT);
    REP(4) { float dn = 0.f, dd = 0.f; f_nsa<0>(p, lds, tid, wave, lane, bx, G, dn, dd); }
    GRID_BAR();
    REP(5) { float dn = 0.f, dd = 0.f; hg_out<false>(p, lds, tid, wave, lane, bx, G, dn, dd); }
    GRID_BAR();
#else
    s_compress(p, lane, gw, NGW);
    hg_local(p, lds, tid, wave, lane, bx, G);
    GRID_BAR();
    hg_scan(p, gtid, NGT);
    if (DBG_MODE == 1 && bx < 8) s_hgrn(p, lds, tid, bx);
    __syncthreads();
    s_cmp_attn(p, lds, wave, lane, gw, NGW);
    GRID_BAR();
    s_sparse_attn<0>(p, lds, wave, lane, gw, NGW);
    __syncthreads();
    if (DBG_MODE != 1) { float dn = 0.f, dd = 0.f; hg_out<false>(p, lds, tid, wave, lane, bx, G, dn, dd); }
    GRID_BAR();
    s_sparse_attn<1>(p, lds, wave, lane, gw, NGW);
    if (DBG_MODE == 1) s_hg_post(p, lane, gw, NGW);
    GRID_BAR();
    if (DBG_MODE == 1) { float dn = 0.f, dd = 0.f; hg_out<true>(p, lds, tid, wave, lane, bx, G, dn, dd); DBG_REDUCE(dn, dd); }
    if (DBG_MODE >= 2) { f_compress(p, lds, tid, wave, lane, bx, G); GRID_BAR(); float dn = 0.f, dd = 0.f; f_nsa<DBG_MODE>(p, lds, tid, wave, lane, bx, G, dn, dd); DBG_REDUCE(dn, dd); }
    GRID_BAR();
#endif
    REP(6) {
        pg8::Gemm g{(const pg8::bf16_t*)(p.ws + WS_ONSAB), (const pg8::bf16_t*)(p.ws + WS_WBRN), TOK, DM, 512, (const pg8::bf16_t*)(p.ws + WS_OHGB), (const pg8::bf16_t*)(p.ws + WS_WBRH)};
        pg8::MergeOrder S; S.init(TOK, DM, G, bx); pg8::EpiMerge E{(const pg8::bf16_t*)p.out, (pg8::bf16_t*)(p.ws + WS_MIX)};
        pg8::gemm_phase<pg8::EpiMerge, pg8::MergeOrder, true, true>((LAS unsigned char*)lds, g, S, E);
    }
    GRID_BAR();
    REP(7) {
        pg8::Gemm g{(const pg8::bf16_t*)(p.ws + WS_MIX), (const pg8::bf16_t*)(p.ws + WS_WOUT), TOK, DM, DM, nullptr, nullptr};
        pg8::StaticOrder S; S.init(TOK, DM, G, bx); pg8::EpiOut E{p.x, p.out};
        pg8::gemm_phase<pg8::EpiOut, pg8::StaticOrder, true, true>((LAS unsigned char*)lds, g, S, E);
    }
    GRID_BAR();
    f_router(p, lds, wave, lane, gw, NGW);
    GRID_BAR();
    REP(9) f_fill(p, MISC, tid, lane, gw, NGW);
    GRID_BAR();
    {
        pg8::MoeOrder S{(const volatile PG8_LAS int*)(MISC + MISC_TP), G, bx};
        REP(10) { pg8::Gemm g{(const pg8::bf16_t*)(p.ws + WS_H2S), (const pg8::bf16_t*)(p.ws + WS_WGU), R_PAD, NE * 1024, DM, nullptr, nullptr};
          pg8::EpiGU E{(const float*)(p.ws + WS_MISC + M_RS), (pg8::bf16_t*)(p.ws + WS_HID)};
          pg8::gemm_phase<pg8::EpiGU, pg8::MoeOrder, true, true>((LAS unsigned char*)lds, g, S, E); }
        GRID_BAR();
        REP(11) { pg8::Gemm g{(const pg8::bf16_t*)(p.ws + WS_HID), (const pg8::bf16_t*)(p.ws + WS_WD), R_PAD, NE * 1024, FF, nullptr, nullptr};
          pg8::EpiDown E{(pg8::bf16_t*)(p.ws + WS_YB)};
          pg8::gemm_phase<pg8::EpiDown, pg8::MoeOrder, true, true>((LAS unsigned char*)lds, g, S, E); }
    }
    GRID_BAR();
#if DBG_MODE == 4
    GRID_BAR();
#endif
    f_final(p, lane, gw, NGW);
}

extern "C" void kernel_launch(void* const* d_in, const int* in_sizes, int n_in, void* d_out, int out_size, void* d_ws, size_t ws_size, hipStream_t stream) {
    static int grid = 0;
    if (grid == 0) {
        if (n_in != 20 || out_size != TOK * DM || ws_size < WS_END) { fprintf(stderr, "kernel_launch: unexpected problem (n_in %d, out %d, ws %zu)\n", n_in, out_size, ws_size); grid = -1; return; }
        int dev = 0, cus = 0, per_cu = 0;
        if (hipGetDevice(&dev) != hipSuccess || hipDeviceGetAttribute(&cus, hipDeviceAttributeMultiprocessorCount, dev) != hipSuccess) { grid = -1; return; }
        if (hipFuncSetAttribute((const void*)mk_fwd, hipFuncAttributeMaxDynamicSharedMemorySize, LDS_BYTES) != hipSuccess) { fprintf(stderr, "kernel_launch: hipFuncSetAttribute failed\n"); grid = -1; return; }
        if (hipOccupancyMaxActiveBlocksPerMultiprocessor(&per_cu, (const void*)mk_fwd, NWAVES * 64, LDS_BYTES) != hipSuccess || per_cu < 1) { fprintf(stderr, "kernel_launch: occupancy query says %d\n", per_cu); }
        (void)hipGetLastError();
        grid = cus;
    }
    if (grid < 0) return;
    if (hipMemsetAsync((char*)d_ws + WS_CTL, 0, CTL_ZERO_BYTES, stream) != hipSuccess) { fprintf(stderr, "kernel_launch: memset failed\n"); return; }
    Args a{};
    Params& p = a.p;
    p.x = (const float*)d_in[0]; p.attn_norm = (const float*)d_in[1]; p.w_in = (const float*)d_in[2]; p.w_cmp_k = (const float*)d_in[3]; p.w_cmp_v = (const float*)d_in[4]; p.cmp_pos = (const float*)d_in[5];
    p.hg_lb = (const float*)d_in[6]; p.hg_norm = (const float*)d_in[7]; p.w_br_nsa = (const float*)d_in[8]; p.w_br_hg = (const float*)d_in[9]; p.w_out = (const float*)d_in[10]; p.ffn_norm = (const float*)d_in[11];
    p.w_grp = (const float*)d_in[12]; p.b_grp = (const float*)d_in[13]; p.w_rtr = (const float*)d_in[14]; p.b_rtr = (const float*)d_in[15]; p.w_gate = (const float*)d_in[16]; p.w_up = (const float*)d_in[17];
    p.w_down = (const float*)d_in[18]; p.final_norm = (const float*)d_in[19]; p.out = (float*)d_out; p.ws = (unsigned char*)d_ws;
    hipLaunchKernelGGL(mk_fwd, dim3(grid), dim3(NWAVES * 64), LDS_BYTES, stream, a);
}
```
